# Optimizing an MI355X kernel written in HIP

```python
import jax, jax.numpy as jnp
from jax import lax
import numpy as np

D_MODEL = 2048
BATCH = 2
SEQ = 16384
DEPTH = 2

GRID_W = 64
CTX_LEN = 256
HEAD_DIM = 128
N_HEAD_SLOTS = D_MODEL // HEAD_DIM
NA_HEADS = N_HEAD_SLOTS // 4
NA_KH = 8
NA_KW = 16
GLA_HEADS = N_HEAD_SLOTS // 4
GLA_DV = HEAD_DIM
GLA_DK = HEAD_DIM // 2
GLA_GATE_RANK = 16
GLA_GATE_NORM = 16.0
GLA_CHUNK = 64
SWA_Q_HEADS = N_HEAD_SLOTS // 2
SWA_KV_HEADS = SWA_Q_HEADS // 4
SWA_WINDOW = 128
SWA_BLOCK = 128
ROPE_THETA = 10000.0
ROPE_AXIS_DIM = HEAD_DIM // 2
NA_W = NA_HEADS * HEAD_DIM
GLA_QK_W = GLA_HEADS * GLA_DK
GLA_V_W = GLA_HEADS * GLA_DV
SWA_Q_W = SWA_Q_HEADS * HEAD_DIM
SWA_KV_W = SWA_KV_HEADS * HEAD_DIM
D_MIX = NA_W + GLA_V_W + SWA_Q_W
IN_SPLITS = (NA_W, NA_W, NA_W,
             GLA_QK_W, GLA_QK_W, GLA_V_W, GLA_V_W, GLA_GATE_RANK, GLA_GATE_RANK,
             SWA_Q_W, SWA_KV_W, SWA_KV_W)
D_IN = sum(IN_SPLITS)
D_FF = 4 * D_MODEL
EPS = 1e-6
NEG_INF = -1e30

kernel_name = "hybrid_natten_gla_swa_dit_block"


def _rmsnorm(x, g):
    xf = x.astype(jnp.float32)
    y = xf * lax.rsqrt(jnp.mean(xf * xf, axis=-1, keepdims=True) + EPS)
    return (y * g.astype(jnp.float32)).astype(x.dtype)


def _heads(t, h):
    return t.reshape(t.shape[:-1] + (h, t.shape[-1] // h))


def _split_cols(z):
    idx = [int(v) for v in np.cumsum(IN_SPLITS)[:-1]]
    return jnp.split(z, idx, axis=-1)


def _axial_rope(L):
    t = jnp.arange(L, dtype=jnp.int32)
    row = (t // GRID_W).astype(jnp.float32)
    col = (t % GRID_W).astype(jnp.float32)
    n_freq = ROPE_AXIS_DIM // 2
    inv = ROPE_THETA ** (-jnp.arange(n_freq, dtype=jnp.float32) / n_freq)
    ar = row[:, None] * inv[None]
    ac = col[:, None] * inv[None]
    return (jnp.cos(ar)[:, None, :], jnp.sin(ar)[:, None, :],
            jnp.cos(ac)[:, None, :], jnp.sin(ac)[:, None, :])


def _apply_rope(x, tabs):
    cr, sr, cc, sc = tabs
    xf = x.astype(jnp.float32)
    xr, xcol = jnp.split(xf, 2, axis=-1)

    def rot(u, cos, sin):
        u1, u2 = jnp.split(u, 2, axis=-1)
        return jnp.concatenate([u1 * cos - u2 * sin, u2 * cos + u1 * sin], axis=-1)

    return jnp.concatenate([rot(xr, cr, sr), rot(xcol, cc, sc)], axis=-1).astype(x.dtype)


def _dense_attention(q, k, v, sink):
    B, M, Hq, hd = q.shape
    Hkv = k.shape[2]
    G = Hq // Hkv
    qg = q.reshape(B, M, Hkv, G, hd)
    s = jnp.einsum('bqhgd,bkhd->bhgqk', qg, k, preferred_element_type=jnp.float32) * (hd ** -0.5)
    if sink is not None:
        snk = jnp.broadcast_to(sink.astype(jnp.float32).reshape(1, Hkv, G, 1, 1), s.shape[:-1] + (1,))
        s = jnp.concatenate([s, snk], axis=-1)
    p = jax.nn.softmax(s, axis=-1)
    if sink is not None:
        p = p[..., :-1]
    o = jnp.einsum('bhgqk,bkhd->bqhgd', p.astype(v.dtype), v)
    return o.reshape(B, M, Hq, hd)


def _neighbourhood_attention(q, k, v, kc, vc, rpb):
    B, L, H, hd = q.shape
    rows = L // GRID_W
    kh = min(NA_KH, rows)
    scale = hd ** -0.5
    qg = q.reshape(B, rows, GRID_W, H, hd).transpose(1, 0, 2, 3, 4)
    kg = k.reshape(B, rows, GRID_W, H, hd)
    vg = v.reshape(B, rows, GRID_W, H, hd)
    cols = np.arange(GRID_W)
    col_start = np.clip(cols - NA_KW // 2, 0, GRID_W - NA_KW)
    col_idx = col_start[:, None] + np.arange(NA_KW)[None, :]
    col_bias_idx = col_idx - cols[:, None] + NA_KW - 1
    n_loc = kh * NA_KW

    def one_row(args):
        r, q_row = args
        rs = jnp.clip(r - kh // 2, 0, rows - kh)
        k_rows = lax.dynamic_slice_in_dim(kg, rs, kh, axis=1)
        v_rows = lax.dynamic_slice_in_dim(vg, rs, kh, axis=1)
        k_win = k_rows[:, :, col_idx]
        v_win = v_rows[:, :, col_idx]
        s_loc = jnp.einsum('bchd,bicjhd->bhcij', q_row, k_win, preferred_element_type=jnp.float32) * scale
        row_bias_idx = rs + jnp.arange(kh) - r + NA_KH - 1
        bias = rpb[:, row_bias_idx[None, :, None], col_bias_idx[:, None, :]]
        s_loc = (s_loc + bias[None].astype(jnp.float32)).reshape(B, H, GRID_W, n_loc)
        s_ctx = jnp.einsum('bchd,bmhd->bhcm', q_row, kc, preferred_element_type=jnp.float32) * scale
        p = jax.nn.softmax(jnp.concatenate([s_loc, s_ctx], axis=-1), axis=-1).astype(v.dtype)
        p_loc = p[..., :n_loc].reshape(B, H, GRID_W, kh, NA_KW)
        p_ctx = p[..., n_loc:]
        return (jnp.einsum('bhcij,bicjhd->bchd', p_loc, v_win)
                + jnp.einsum('bhcm,bmhd->bchd', p_ctx, vc))

    out = lax.map(one_row, (jnp.arange(rows), qg))
    return out.transpose(1, 0, 2, 3, 4).reshape(B, L, H, hd)


def _window_attention(q, k, v, kc, vc, sink):
    B, L, Hq, hd = q.shape
    Hkv = k.shape[2]
    G = Hq // Hkv
    nb = L // SWA_BLOCK
    band = 3 * SWA_BLOCK
    scale = hd ** -0.5
    pad = ((0, 0), (SWA_BLOCK, SWA_BLOCK), (0, 0), (0, 0))
    kp = jnp.pad(k, pad)
    vp = jnp.pad(v, pad)
    qb = q.reshape(B, nb, SWA_BLOCK, Hkv, G, hd).transpose(1, 0, 2, 3, 4, 5)
    rel = jnp.arange(band)[None, :] - SWA_BLOCK - jnp.arange(SWA_BLOCK)[:, None]
    in_window = jnp.abs(rel) <= SWA_WINDOW
    sink_logit = sink.astype(jnp.float32).reshape(1, Hkv, G, 1, 1)

    def one_block(args):
        n, q_blk = args
        start = n * SWA_BLOCK
        k_blk = lax.dynamic_slice_in_dim(kp, start, band, axis=1)
        v_blk = lax.dynamic_slice_in_dim(vp, start, band, axis=1)
        kpos = start - SWA_BLOCK + jnp.arange(band)
        valid = in_window & ((kpos >= 0) & (kpos < L))[None, :]
        s_loc = jnp.einsum('bqhgd,bkhd->bhgqk', q_blk, k_blk, preferred_element_type=jnp.float32) * scale
        s_loc = jnp.where(valid, s_loc, NEG_INF)
        s_ctx = jnp.einsum('bqhgd,bmhd->bhgqm', q_blk, kc, preferred_element_type=jnp.float32) * scale
        s_snk = jnp.broadcast_to(sink_logit, (B, Hkv, G, SWA_BLOCK, 1))
        p = jax.nn.softmax(jnp.concatenate([s_loc, s_ctx, s_snk], axis=-1), axis=-1).astype(v.dtype)
        p_loc = p[..., :band]
        p_ctx = p[..., band:band + kc.shape[1]]
        return (jnp.einsum('bhgqk,bkhd->bqhgd', p_loc, v_blk)
                + jnp.einsum('bhgqm,bmhd->bqhgd', p_ctx, vc))

    out = lax.map(one_block, (jnp.arange(nb), qb))
    return out.transpose(1, 0, 2, 3, 4, 5).reshape(B, L, Hq, hd)


def _gla_chunk_scan(q, k, v, g, s0):
    B, L, H, dk = q.shape
    dv = v.shape[-1]
    C = GLA_CHUNK
    n = L // C

    def to_chunks(t):
        return t.astype(jnp.float32).reshape(B, n, C, H, t.shape[-1]).transpose(1, 0, 3, 2, 4)

    causal = jnp.tril(jnp.ones((C, C), dtype=bool))[None, None, :, :, None]

    def step(S, inp):
        qc, kc, vc, gc = inp
        b = jnp.cumsum(gc, axis=2)
        o_inter = jnp.einsum('bhik,bhkv->bhiv', qc * jnp.exp(b), S)
        diff = b[:, :, :, None, :] - b[:, :, None, :, :]
        decay = jnp.exp(jnp.where(causal, diff, -jnp.inf))
        a = jnp.einsum('bhik,bhjk,bhijk->bhij', qc, kc, decay)
        o = o_inter + jnp.einsum('bhij,bhjv->bhiv', a, vc)
        b_last = b[:, :, -1:, :]
        S_new = (jnp.exp(b_last[:, :, 0, :])[..., None] * S
                 + jnp.einsum('bhjk,bhjv->bhkv', kc * jnp.exp(b_last - b), vc))
        return S_new, o

    S_fin, o = lax.scan(step, s0, (to_chunks(q), to_chunks(k), to_chunks(v), to_chunks(g)))
    o = o.transpose(1, 0, 3, 2, 4).reshape(B, L, H, dv)
    return o, S_fin


def _gla_bidirectional(q, k, v, gf, gb, q_c, k_c, v_c, gf_c, gb_c):
    B, _, H, dk = q.shape
    dv = v.shape[-1]
    s0 = jnp.zeros((B, H, dk, dv), jnp.float32)
    fl = lambda t: jnp.flip(t, axis=1)
    oc_f, sc_f = _gla_chunk_scan(q_c, k_c, v_c, gf_c, s0)
    oc_b, sc_b = _gla_chunk_scan(fl(q_c), fl(k_c), fl(v_c), fl(gb_c), s0)
    ol_f, _ = _gla_chunk_scan(q, k, v, gf, sc_f)
    ol_b, _ = _gla_chunk_scan(fl(q), fl(k), fl(v), fl(gb), sc_b)
    return ol_f + fl(ol_b), oc_f + fl(oc_b)


def _gla_output(o, r, g):
    of = o.astype(jnp.float32)
    of = of * lax.rsqrt(jnp.mean(of * of, axis=-1, keepdims=True) + EPS) * g.astype(jnp.float32)
    of = of.reshape(r.shape)
    return (of * jax.nn.silu(r.astype(jnp.float32))).astype(r.dtype)


def _squared_relu_mlp(h, w1, w2):
    return jnp.square(jax.nn.relu(h @ w1)) @ w2


def _mixers(z, zc, rpb, wg_f, bg_f, wg_b, bg_b, gla_g, sink, rope, with_ctx):
    qa, ka, va, qg, kg, vg, rg, gfl, gbl, qs, ks, vs = _split_cols(z)
    qa_c, ka_c, va_c, qg_c, kg_c, vg_c, rg_c, gfl_c, gbl_c, qs_c, ks_c, vs_c = _split_cols(zc)
    B, L = z.shape[0], z.shape[1]
    M = zc.shape[1]
    ka_ch, va_ch = _heads(ka_c, NA_HEADS), _heads(va_c, NA_HEADS)
    ya = _neighbourhood_attention(_heads(qa, NA_HEADS), _heads(ka, NA_HEADS), _heads(va, NA_HEADS),
                                  ka_ch, va_ch, rpb)
    gate = lambda u, w, b: _heads(jax.nn.log_sigmoid((u @ w + b).astype(jnp.float32)) / GLA_GATE_NORM, GLA_HEADS)
    qscale = GLA_DK ** -0.5
    ob, ob_c = _gla_bidirectional(
        _heads(qg, GLA_HEADS) * qscale, _heads(kg, GLA_HEADS), _heads(vg, GLA_HEADS),
        gate(gfl, wg_f, bg_f), gate(gbl, wg_b, bg_b),
        _heads(qg_c, GLA_HEADS) * qscale, _heads(kg_c, GLA_HEADS), _heads(vg_c, GLA_HEADS),
        gate(gfl_c, wg_f, bg_f), gate(gbl_c, wg_b, bg_b))
    yb = _gla_output(ob, rg, gla_g)
    ks_ch, vs_ch = _heads(ks_c, SWA_KV_HEADS), _heads(vs_c, SWA_KV_HEADS)
    ys = _window_attention(_apply_rope(_heads(qs, SWA_Q_HEADS), rope), _apply_rope(_heads(ks, SWA_KV_HEADS), rope),
                           _heads(vs, SWA_KV_HEADS), ks_ch, vs_ch, sink)
    y = jnp.concatenate([ya.reshape(B, L, NA_W), yb, ys.reshape(B, L, SWA_Q_W)], axis=-1)
    if not with_ctx:
        return y, None
    ya_c = _dense_attention(_heads(qa_c, NA_HEADS), ka_ch, va_ch, None)
    yb_c = _gla_output(ob_c, rg_c, gla_g)
    ys_c = _dense_attention(_heads(qs_c, SWA_Q_HEADS), ks_ch, vs_ch, sink)
    yc = jnp.concatenate([ya_c.reshape(B, M, NA_W), yb_c, ys_c.reshape(B, M, SWA_Q_W)], axis=-1)
    return y, yc


def _layer(x, xc, c_act, cc_act, w_mod, b_mod, n1, n2, w_in, rpb, wg_f, bg_f, wg_b, bg_b, gla_g, sink,
           w_out, w_ff1, w_ff2, rope, with_ctx):
    mod = (c_act @ w_mod + b_mod)[:, None, :]
    modc = (cc_act @ w_mod + b_mod)[None, None, :]
    sh1, sc1, ga1, sh2, sc2, ga2 = jnp.split(mod, 6, axis=-1)
    csh1, csc1, cga1, csh2, csc2, cga2 = jnp.split(modc, 6, axis=-1)
    h = _rmsnorm(x, n1) * (1 + sc1) + sh1
    hc = _rmsnorm(xc, n1) * (1 + csc1) + csh1
    y, yc = _mixers(h @ w_in, hc @ w_in, rpb, wg_f, bg_f, wg_b, bg_b, gla_g, sink, rope, with_ctx)
    x = x + ga1 * (y @ w_out)
    h2 = _rmsnorm(x, n2) * (1 + sc2) + sh2
    x = x + ga2 * _squared_relu_mlp(h2, w_ff1, w_ff2)
    if with_ctx:
        xc = xc + cga1 * (yc @ w_out)
        hc2 = _rmsnorm(xc, n2) * (1 + csc2) + csh2
        xc = xc + cga2 * _squared_relu_mlp(hc2, w_ff1, w_ff2)
    return x, xc


def setup_inputs(seed: int = 0) -> dict:
    key = jax.random.key(seed)
    ks = jax.random.split(key, 20)
    f32 = jnp.float32
    nrm = lambda k, shape, s: jax.random.normal(k, shape, f32) * s
    return {
        "x": nrm(ks[0], (BATCH, SEQ, D_MODEL), 1.0),
        "c": nrm(ks[1], (BATCH, D_MODEL), 1.0),
        "ctx": nrm(ks[2], (BATCH, CTX_LEN, D_MODEL), 1.0),
        "c_ctx": nrm(ks[3], (D_MODEL,), 1.0),
        "w_mod": nrm(ks[4], (DEPTH, D_MODEL, 6 * D_MODEL), 0.5 * D_MODEL ** -0.5),
        "b_mod": nrm(ks[5], (DEPTH, 6 * D_MODEL), 0.02),
        "norm1_g": 1.0 + nrm(ks[6], (DEPTH, D_MODEL), 0.02),
        "norm2_g": 1.0 + nrm(ks[7], (DEPTH, D_MODEL), 0.02),
        "w_in": nrm(ks[8], (DEPTH, D_MODEL, D_IN), D_MODEL ** -0.5),
        "na_rpb": nrm(ks[9], (DEPTH, NA_HEADS, 2 * NA_KH - 1, 2 * NA_KW - 1), 0.1),
        "gla_wg_fwd": nrm(ks[10], (DEPTH, GLA_GATE_RANK, GLA_QK_W), GLA_GATE_RANK ** -0.5),
        "gla_bg_fwd": nrm(ks[11], (DEPTH, GLA_QK_W), 0.1),
        "gla_wg_bwd": nrm(ks[12], (DEPTH, GLA_GATE_RANK, GLA_QK_W), GLA_GATE_RANK ** -0.5),
        "gla_bg_bwd": nrm(ks[13], (DEPTH, GLA_QK_W), 0.1),
        "gla_norm_g": 1.0 + nrm(ks[14], (DEPTH, GLA_DV), 0.02),
        "swa_sink": nrm(ks[15], (DEPTH, SWA_Q_HEADS), 0.5),
        "w_out": nrm(ks[16], (DEPTH, D_MIX, D_MODEL), D_MIX ** -0.5),
        "w_ff1": nrm(ks[17], (DEPTH, D_MODEL, D_FF), D_MODEL ** -0.5),
        "w_ff2": nrm(ks[18], (DEPTH, D_FF, D_MODEL), D_FF ** -0.5),
        "final_norm_g": 1.0 + nrm(ks[19], (D_MODEL,), 0.02),
    }


def reference(x, c, ctx, c_ctx, w_mod, b_mod, norm1_g, norm2_g, w_in, na_rpb, gla_wg_fwd, gla_bg_fwd,
              gla_wg_bwd, gla_bg_bwd, gla_norm_g, swa_sink, w_out, w_ff1, w_ff2, final_norm_g):
    rope = _axial_rope(x.shape[1])
    c_act = jax.nn.silu(c)
    cc_act = jax.nn.silu(c_ctx)
    xc = ctx
    for i in range(DEPTH):
        x, xc = _layer(x, xc, c_act, cc_act, w_mod[i], b_mod[i], norm1_g[i], norm2_g[i], w_in[i], na_rpb[i],
                       gla_wg_fwd[i], gla_bg_fwd[i], gla_wg_bwd[i], gla_bg_bwd[i], gla_norm_g[i], swa_sink[i],
                       w_out[i], w_ff1[i], w_ff2[i], rope, i < DEPTH - 1)
    return _rmsnorm(x, final_norm_g)
```

```cpp
#include <hip/hip_runtime.h>
#include <hip/hip_cooperative_groups.h>
#include <cstdio>
namespace cg = cooperative_groups;

#define LAS __attribute__((address_space(3)))
typedef unsigned short bf16_t;
typedef short bf16x8 __attribute__((ext_vector_type(8)));
typedef float f32x4 __attribute__((ext_vector_type(4)));
typedef unsigned u32x4 __attribute__((ext_vector_type(4)));

constexpr int DM = 2048, LSEQ = 16384, NLAT = 32768, NCTX = 512, NTOK = 33280, DFF = 8192;
constexpr int ZLD = 4640, ZN = 4864;
constexpr int C_NAQ = 0, C_NAK = 512, C_NAV = 1024, C_GQ = 1536, C_GK = 1792, C_GV = 2048, C_GR = 2560;
constexpr int C_SQ = 3072, C_SK = 4096, C_SV = 4352, C_GFL = 4608;
constexpr float LOG2E = 1.4426950408889634f;
constexpr float QSCALE = 0.08838834764831845f * 1.4426950408889634f;
constexpr int LDS_BYTES = 131072 + 16;

constexpr size_t SZ_WIN = (size_t)ZN * DM * 2, SZ_WOUT = (size_t)DM * DM * 2, SZ_WFF = (size_t)DFF * DM * 2;
constexpr size_t SZ_WL = SZ_WIN + SZ_WOUT + 2 * SZ_WFF;
constexpr size_t WS_W = 0;
constexpr size_t WS_ABUF = WS_W + 2 * SZ_WL;
constexpr size_t WS_H = WS_ABUF + (size_t)NTOK * DM * 2;
constexpr size_t SZ_Z = (size_t)NTOK * ZLD * 2;
constexpr size_t WS_ST = WS_H + SZ_Z;
constexpr size_t SZ_ST = (size_t)2 * 2 * 260 * 4 * 8192 * 4;
constexpr size_t WS_DEC = WS_ST + SZ_ST;
constexpr size_t SZ_DEC = (size_t)2 * 2 * 260 * 4 * 64 * 4;
constexpr size_t WS_XC = WS_H + (size_t)NTOK * DFF * 2;
constexpr size_t WS_MOD = WS_XC + (size_t)NCTX * DM * 4;
constexpr size_t WS_ROPE = WS_MOD + (size_t)2 * 3 * 12288 * 4;
constexpr size_t WS_ABUF2 = WS_ROPE + 2 * 256 * 32 * 4;
constexpr size_t WS_QKI = WS_ABUF2;
constexpr size_t WS_SBF = WS_ABUF2 + (size_t)2080 * 32768;
static_assert((size_t)2080 * 32768 * 2 <= (size_t)NTOK * DM * 2, "gla overlay");
constexpr size_t WS_SSQ = WS_ABUF2 + (size_t)NTOK * DM * 2;
constexpr size_t WS_CVEC = WS_SSQ + (size_t)3 * NTOK * 4;
constexpr int CV_L = 3 * (ZN + DFF);
constexpr size_t WS_BAR = WS_CVEC + (size_t)2 * CV_L * 4;
constexpr size_t WS_END = WS_BAR + 16384;
static_assert(WS_DEC + SZ_DEC <= WS_XC, "overlay");

struct P {
    const float *x, *c, *ctx, *c_ctx, *w_mod, *b_mod, *n1g, *n2g, *w_in, *rpb, *wgf, *bgf, *wgb, *bgb, *glag, *sink, *w_out, *w_ff1, *w_ff2, *fng;
    float* out;
    unsigned char* ws;
    long ph_lo, ph_hi;
};

__device__ __forceinline__ unsigned cvt_pk_bf16(float lo, float hi) { unsigned r; asm volatile("v_cvt_pk_bf16_f32 %0, %1, %2" : "=v"(r) : "v"(lo), "v"(hi)); return r; }
__device__ __forceinline__ float bf2f(bf16_t b) { return __uint_as_float(((unsigned)b) << 16); }
__device__ __forceinline__ float bflo(unsigned u) { return __uint_as_float(u << 16); }
__device__ __forceinline__ float bfhi(unsigned u) { return __uint_as_float(u & 0xffff0000u); }
__device__ __forceinline__ float wave_sum(float v) { for (int o = 32; o > 0; o >>= 1) v += __shfl_xor(v, o); return v; }
__device__ __forceinline__ float wave_max(float v) { for (int o = 32; o > 0; o >>= 1) v = fmaxf(v, __shfl_xor(v, o)); return v; }
__device__ __forceinline__ float dot8(u32x4 a, u32x4 b) {
    float s = bflo(a.x) * bflo(b.x); s += bfhi(a.x) * bfhi(b.x); s += bflo(a.y) * bflo(b.y); s += bfhi(a.y) * bfhi(b.y);
    s += bflo(a.z) * bflo(b.z); s += bfhi(a.z) * bfhi(b.z); s += bflo(a.w) * bflo(b.w); s += bfhi(a.w) * bfhi(b.w); return s;
}

namespace pg8 {
constexpr int BM = 256, BK = 64, HALF = 128, HTB = HALF * BK * 2, NXCD = 8, WGM = 4;
__device__ __forceinline__ int lds_byte(int r, int c) { const int st = (r >> 4) * 2 + (c >> 5), rr = r & 15, cc = c & 31, ob = rr * 64 + cc * 2; return st * 1024 + (ob ^ (((ob >> 9) & 1) << 5)); }
__device__ __forceinline__ void stage_rc(int b, int& R, int& C) { const int st = b / 1024, sb = b % 1024, swz = sb ^ (((sb >> 9) & 1) << 5); R = (st >> 1) * 16 + swz / 64; C = (st & 1) * 32 + (swz % 64) / 2; }
__device__ __forceinline__ int perm32(int rho) { const int n = rho >> 4, i = rho & 15; return 8 * (i >> 2) + 4 * n + (i & 3); }
struct Unit { int pm, pn, k0, nt; };
struct Gemm { const bf16_t* A; const bf16_t* Bt; int M, N, K; };
struct StaticOrder {
    int nM, nN, nwg, G, c;
    __device__ void init(int M, int N, int K, int G_, int c_) { nM = M / BM; nN = N / BM; nwg = nM * nN; G = G_; c = c_; ntfull = K / BK; nsplit = 0; ks = 1; nt_split = 0; pm_split0 = 0; }
    int ntfull, nsplit, ks, nt_split, pm_split0;
    __device__ __forceinline__ bool next(int i, Unit& u) const {
        const long L = (long)i * G + c;
        const bool full = L < nwg; const int sidx = (int)(L - nwg);
        if (!full && sidx >= nsplit) return false;
        int wgid = full ? (int)L : 0; { const int q = nwg / NXCD, r = nwg % NXCD, xcd = wgid % NXCD, off = wgid / NXCD; wgid = (xcd < r ? xcd * (q + 1) : r * (q + 1) + (xcd - r) * q) + off; }
        const int nig = WGM * nN, gid = wgid / nig, fm = gid * WGM, gsz = (nM - fm) < WGM ? (nM - fm) : WGM;
        const int fpm = fm + ((wgid % nig) % gsz), fpn = (wgid % nig) / gsz;
        const int tl = sidx / ks, spm = pm_split0 + tl / nN, spn = tl % nN, sk0 = (sidx % ks) * nt_split * BK;
        u.pm = full ? fpm : spm; u.pn = full ? fpn : spn; u.k0 = full ? 0 : sk0; u.nt = full ? ntfull : nt_split;
        return true;
    }
};

template <class Epi>
__device__ __forceinline__ void gemm_phase(int tid_, LAS unsigned char* lds, const Gemm g, const StaticOrder& S, const Epi& E) {
    const int tid = tid_, wid = __builtin_amdgcn_readfirstlane(tid >> 6), lane = tid & 63, wr = wid >> 2, wc = wid & 3, fr = lane & 15, fq = lane >> 4;
    const int K = g.K;
    unsigned voffA[2], voffB[2];
#pragma unroll
    for (int i = 0; i < 2; ++i) { int R, C; stage_rc(tid * 16 + i * 8192, R, C); const int Rb = E.perm ? ((R & ~31) + perm32(R & 31)) : R;
        voffA[i] = (unsigned)(R * K + C) * 2u; voffB[i] = (unsigned)(Rb * K + C) * 2u; }
    const size_t kstep = (size_t)(BK * 2);
    const size_t hstep = (size_t)HALF * K * 2;
    const size_t tstep = 2 * hstep;
    const unsigned ldsw = (unsigned)wid * 1024u;
    const int aoff = lds_byte(wr * 64 + fr, fq * 8), boff = lds_byte(wc * 32 + fr, fq * 8);
#define PG8_SA(b, h) (((b) * 2 + (h)) * HTB)
#define PG8_SB(b, h) ((4 + (b) * 2 + (h)) * HTB)
#define PG8_STAGE(bufoff, gbase, voff) do { _Pragma("unroll") for (int _i = 0; _i < 2; ++_i) \
        __builtin_amdgcn_global_load_lds((const unsigned*)((const char*)(gbase) + (voff)[_i]), (LAS unsigned*)(lds + (bufoff) + ldsw + _i * 8192), 16, 0, 0); } while (0)
#define PG8_LDA(dst, b, h) do { _Pragma("unroll") for (int m = 0; m < 4; ++m) _Pragma("unroll") for (int k = 0; k < 2; ++k) dst[m][k] = *(const LAS bf16x8*)(lds + PG8_SA(b, h) + aoff + m * 2048 + k * 1024); } while (0)
#define PG8_LDB(dst, b, h) do { _Pragma("unroll") for (int n = 0; n < 2; ++n) _Pragma("unroll") for (int k = 0; k < 2; ++k) dst[n][k] = *(const LAS bf16x8*)(lds + PG8_SB(b, h) + boff + n * 2048 + k * 1024); } while (0)
#define PG8_MMA(ai, bj, At, Bt) do { __builtin_amdgcn_s_setprio(1); _Pragma("unroll") for (int m = 0; m < 4; ++m) _Pragma("unroll") for (int n = 0; n < 2; ++n) _Pragma("unroll") for (int k = 0; k < 2; ++k) \
        acc[ai][bj][m][n] = __builtin_amdgcn_mfma_f32_16x16x32_bf16(Bt[n][k], At[m][k], acc[ai][bj][m][n], 0, 0, 0); __builtin_amdgcn_s_setprio(0); } while (0)
#define PG8_WAIT_V(n) asm volatile("s_waitcnt vmcnt(" #n ")" ::: "memory")
#define PG8_WAIT_L(n) asm volatile("s_waitcnt lgkmcnt(" #n ")" ::: "memory")
#define PG8_BAR __builtin_amdgcn_s_barrier()
#define PG8_SCHED __builtin_amdgcn_sched_barrier(0)
    Unit cur, nxt; int ui = 0;
    if (!S.next(0, cur)) return;
    f32x4 acc[2][2][4][2];
#pragma unroll
    for (int a = 0; a < 2; ++a)
#pragma unroll
        for (int b = 0; b < 2; ++b)
#pragma unroll
            for (int m = 0; m < 4; ++m)
#pragma unroll
                for (int n = 0; n < 2; ++n) acc[a][b][m][n] = (f32x4){0.f, 0.f, 0.f, 0.f};
    bf16x8 At[4][2], B0[2][2], B1[2][2];
    const char* cA = (const char*)g.A + (size_t)cur.pm * tstep + (size_t)cur.k0 * 2; const char* cB = (const char*)g.Bt + (size_t)cur.pn * tstep + (size_t)cur.k0 * 2;
    PG8_STAGE(PG8_SB(0, 0), cB, voffB); PG8_STAGE(PG8_SA(0, 0), cA, voffA); PG8_STAGE(PG8_SB(0, 1), cB + hstep, voffB); PG8_STAGE(PG8_SA(0, 1), cA + hstep, voffA);
    if (wr == 1) PG8_BAR;
    PG8_WAIT_V(4); PG8_BAR;
    PG8_STAGE(PG8_SB(1, 0), cB + kstep, voffB); PG8_STAGE(PG8_SA(1, 0), cA + kstep, voffA); PG8_STAGE(PG8_SB(1, 1), cB + hstep + kstep, voffB);
    PG8_WAIT_V(6); PG8_BAR;
    for (;;) {
        const bool has_next = S.next(ui + 1, nxt);
        const char* nA = has_next ? (const char*)g.A + (size_t)nxt.pm * tstep + (size_t)nxt.k0 * 2 : cA; const char* nB = has_next ? (const char*)g.Bt + (size_t)nxt.pn * tstep + (size_t)nxt.k0 * 2 : cB;
        const int nt = cur.nt;
        for (int t = 0; t < nt; t += 2) {
            const bool last = (t == nt - 2);
            const char* a1 = cA + (size_t)(t + 1) * kstep;
            const char* a2 = last ? nA : cA + (size_t)(t + 2) * kstep; const char* b2 = last ? nB : cB + (size_t)(t + 2) * kstep;
            const char* a3 = a2 + kstep; const char* b3 = b2 + kstep;
            PG8_LDB(B0, 0, 0); PG8_SCHED; PG8_LDA(At, 0, 0); PG8_STAGE(PG8_SA(1, 1), a1 + hstep, voffA);
            PG8_WAIT_L(8); PG8_BAR; PG8_WAIT_L(0); PG8_MMA(0, 0, At, B0); PG8_BAR; PG8_SCHED;
            PG8_LDB(B1, 0, 1); PG8_STAGE(PG8_SB(0, 0), b2, voffB);
            PG8_BAR; PG8_WAIT_L(0); PG8_MMA(0, 1, At, B1); PG8_BAR;
            PG8_LDA(At, 0, 1); PG8_STAGE(PG8_SA(0, 0), a2, voffA);
            PG8_BAR; PG8_WAIT_L(0); PG8_MMA(1, 0, At, B0); PG8_BAR; PG8_SCHED;
            PG8_STAGE(PG8_SB(0, 1), b2 + hstep, voffB);
            PG8_WAIT_V(6); PG8_BAR; PG8_MMA(1, 1, At, B1); PG8_BAR;
            PG8_LDB(B0, 1, 0); PG8_SCHED; PG8_LDA(At, 1, 0); PG8_STAGE(PG8_SA(0, 1), a2 + hstep, voffA);
            PG8_WAIT_L(8); PG8_BAR; PG8_WAIT_L(0); PG8_MMA(0, 0, At, B0); PG8_BAR; PG8_SCHED;
            PG8_LDB(B1, 1, 1); PG8_STAGE(PG8_SB(1, 0), b3, voffB);
            PG8_BAR; PG8_WAIT_L(0); PG8_MMA(0, 1, At, B1); PG8_BAR;
            PG8_LDA(At, 1, 1); PG8_STAGE(PG8_SA(1, 0), a3, voffA);
            PG8_BAR; PG8_WAIT_L(0); PG8_MMA(1, 0, At, B0); PG8_BAR; PG8_SCHED;
            PG8_STAGE(PG8_SB(1, 1), b3 + hstep, voffB);
            PG8_WAIT_V(6); PG8_BAR; PG8_MMA(1, 1, At, B1); PG8_BAR;
        }
        E(acc, cur, wr, wc, fr, fq);
        if (!has_next) break;
#pragma unroll
        for (int a = 0; a < 2; ++a)
#pragma unroll
            for (int b = 0; b < 2; ++b)
#pragma unroll
                for (int m = 0; m < 4; ++m)
#pragma unroll
                    for (int n = 0; n < 2; ++n) acc[a][b][m][n] = (f32x4){0.f, 0.f, 0.f, 0.f};
        cur = nxt; cA = nA; cB = nB; ++ui;
    }
    PG8_WAIT_V(0);
    if (wr == 0) PG8_BAR;
    PG8_BAR;
#undef PG8_SA
#undef PG8_SB
#undef PG8_STAGE
#undef PG8_LDA
#undef PG8_LDB
#undef PG8_MMA
#undef PG8_WAIT_V
#undef PG8_WAIT_L
#undef PG8_BAR
#undef PG8_SCHED
}
}

struct EpiIn {
    static constexpr bool PERM = true;
    bf16_t* Z; const float* rcos; const float* rsin; const float* ssq; const float* cvec;
    __device__ __forceinline__ void operator()(const f32x4 (&acc)[2][2][4][2], const pg8::Unit& u, int wr, int wc, int fr, int fq) const {
        const int row0 = u.pm * 256 + wr * 64 + fr, col0 = u.pn * 256 + wc * 32 + 8 * fq;
        const bool rope = (u.pn >= 12) && (u.pn <= 16) && (u.pm < 128);
        const int modsel = u.pm < 64 ? 0 : (u.pm < 128 ? 1 : 2);
        f32x4 cv[2][2];
#pragma unroll
        for (int bj = 0; bj < 2; ++bj) { cv[bj][0] = (f32x4){0.f, 0.f, 0.f, 0.f}; cv[bj][1] = (f32x4){0.f, 0.f, 0.f, 0.f};
            if (ssq) { cv[bj][0] = *(const f32x4*)(cvec + modsel * ZN + col0 + bj * 128); cv[bj][1] = *(const f32x4*)(cvec + modsel * ZN + col0 + bj * 128 + 4); } }
#pragma unroll
        for (int ai = 0; ai < 2; ++ai)
#pragma unroll
            for (int m = 0; m < 4; ++m) {
                const int row = row0 + ai * 128 + m * 16;
                const float rs = ssq ? rsqrtf(ssq[row] * (1.f / DM) + 1e-6f) : 1.f;
                f32x4 cs = {1.f, 1.f, 1.f, 1.f}, sn = {0.f, 0.f, 0.f, 0.f};
                if (rope) { const int tok = row & (LSEQ - 1); const int pos = (wc < 2) ? (tok >> 6) : (tok & 63); const int f0 = 16 * (wc & 1) + 4 * fq;
                    cs = *(const f32x4*)(rcos + pos * 32 + f0); sn = *(const f32x4*)(rsin + pos * 32 + f0); }
#pragma unroll
                for (int bj = 0; bj < 2; ++bj) {
                    const int c = col0 + bj * 128;
                    if (c < ZLD) {
                        f32x4 v0 = acc[ai][bj][m][0] * rs + cv[bj][0], v1 = acc[ai][bj][m][1] * rs + cv[bj][1];
                        if (rope) { const f32x4 n0 = v0 * cs - v1 * sn, n1 = v1 * cs + v0 * sn; v0 = n0; v1 = n1; }
                        u32x4 w; w.x = cvt_pk_bf16(v0[0], v0[1]); w.y = cvt_pk_bf16(v0[2], v0[3]); w.z = cvt_pk_bf16(v1[0], v1[1]); w.w = cvt_pk_bf16(v1[2], v1[3]);
                        *(u32x4*)(Z + (size_t)row * ZLD + c) = w;
                    }
                }
            }
    }
};
struct EpiSq {
    static constexpr bool PERM = true;
    bf16_t* O; int ldc; const float* ssq; const float* cvec;
    __device__ __forceinline__ void operator()(const f32x4 (&acc)[2][2][4][2], const pg8::Unit& u, int wr, int wc, int fr, int fq) const {
        const int row0 = u.pm * 256 + wr * 64 + fr, col0 = u.pn * 256 + wc * 32 + 8 * fq;
        const int modsel = u.pm < 64 ? 0 : (u.pm < 128 ? 1 : 2);
        f32x4 cv[2][2];
#pragma unroll
        for (int bj = 0; bj < 2; ++bj) { cv[bj][0] = *(const f32x4*)(cvec + modsel * DFF + col0 + bj * 128); cv[bj][1] = *(const f32x4*)(cvec + modsel * DFF + col0 + bj * 128 + 4); }
#pragma unroll
        for (int ai = 0; ai < 2; ++ai)
#pragma unroll
            for (int m = 0; m < 4; ++m) { const int row = row0 + ai * 128 + m * 16; bf16_t* rowp = O + (size_t)row * ldc + col0;
                const float rs = rsqrtf(ssq[row] * (1.f / DM) + 1e-6f);
#pragma unroll
                for (int bj = 0; bj < 2; ++bj) { f32x4 v0 = acc[ai][bj][m][0] * rs + cv[bj][0], v1 = acc[ai][bj][m][1] * rs + cv[bj][1];
#pragma unroll
                    for (int j = 0; j < 4; ++j) { float a = fmaxf(v0[j], 0.f), b = fmaxf(v1[j], 0.f); v0[j] = a * a; v1[j] = b * b; }
                    u32x4 w; w.x = cvt_pk_bf16(v0[0], v0[1]); w.y = cvt_pk_bf16(v0[2], v0[3]); w.z = cvt_pk_bf16(v1[0], v1[1]); w.w = cvt_pk_bf16(v1[2], v1[3]);
                    *(u32x4*)(rowp + bj * 128) = w; } }
    }
};
struct EpiRes {
    static constexpr bool PERM = false;
    const float* lat_res; const float* ctx_res; float* lat_out; float* ctx_out; const float* gate;
    float* part; int ntfull;
    bf16_t* aout; const float* ng; const float* nsc; float* ssq;
    __device__ __forceinline__ void operator()(const f32x4 (&acc)[2][2][4][2], const pg8::Unit& u, int wr, int wc, int fr, int fq) const {
        const int row0 = u.pm * 256 + wr * 64 + fr, col0 = u.pn * 256 + wc * 32 + 4 * fq;
        if (u.nt != ntfull) {
            float* pp = part + (size_t)(u.k0 / (u.nt * 64)) * NCTX * DM;
#pragma unroll
            for (int ai = 0; ai < 2; ++ai)
#pragma unroll
                for (int m = 0; m < 4; ++m) { float* op = pp + (size_t)(row0 + ai * 128 + m * 16 - NLAT) * DM;
#pragma unroll
                    for (int bj = 0; bj < 2; ++bj)
#pragma unroll
                        for (int n = 0; n < 2; ++n) *(f32x4*)(op + col0 + bj * 128 + n * 16) = acc[ai][bj][m][n]; }
            return;
        }
        const int modsel = u.pm < 64 ? 0 : (u.pm < 128 ? 1 : 2);
        f32x4 gv[2][2];
#pragma unroll
        for (int bj = 0; bj < 2; ++bj)
#pragma unroll
            for (int n = 0; n < 2; ++n) gv[bj][n] = *(const f32x4*)(gate + modsel * 12288 + col0 + bj * 128 + n * 16);
        f32x4 gm[2][2];
        if (aout) {
#pragma unroll
            for (int bj = 0; bj < 2; ++bj)
#pragma unroll
                for (int n = 0; n < 2; ++n) { const int c = col0 + bj * 128 + n * 16; gm[bj][n] = *(const f32x4*)(ng + c) * (*(const f32x4*)(nsc + modsel * 12288 + c) + 1.f); }
        }
#pragma unroll
        for (int ai = 0; ai < 2; ++ai)
#pragma unroll
            for (int m = 0; m < 4; ++m) {
                const int row = row0 + ai * 128 + m * 16;
                const float* rp; float* op;
                if (row < NLAT) { rp = lat_res + (size_t)row * DM; op = lat_out + (size_t)row * DM; } else { rp = ctx_res + (size_t)(row - NLAT) * DM; op = ctx_out + (size_t)(row - NLAT) * DM; }
                float ss = 0.f;
#pragma unroll
                for (int bj = 0; bj < 2; ++bj)
#pragma unroll
                    for (int n = 0; n < 2; ++n) { const int c = col0 + bj * 128 + n * 16; const f32x4 r4 = *(const f32x4*)(rp + c); const f32x4 o4 = r4 + gv[bj][n] * acc[ai][bj][m][n]; *(f32x4*)(op + c) = o4;
                        if (aout) { ss += o4[0] * o4[0] + o4[1] * o4[1] + o4[2] * o4[2] + o4[3] * o4[3]; const f32x4 a4 = o4 * gm[bj][n];
                            uint2 w; w.x = cvt_pk_bf16(a4[0], a4[1]); w.y = cvt_pk_bf16(a4[2], a4[3]); *(uint2*)(aout + (size_t)row * DM + c) = w; } }
                if (aout) { ss += __shfl_xor(ss, 16); ss += __shfl_xor(ss, 32); if (fq == 0) atomicAdd(ssq + row, ss); }
                __builtin_amdgcn_sched_barrier(0);
            }
    }
};

struct EpiAny {
    unsigned char* ws; float* out; const float* rlat; const float* rctx; const float* ng;
    int mode, l, ssq_idx, gate_idx, aout_sel, nsc_off, ntfull; bool perm;
    __device__ __forceinline__ void operator()(const f32x4 (&acc)[2][2][4][2], const pg8::Unit& u, int wr, int wc, int fr, int fq) const {
        const float* rope = (const float*)(ws + WS_ROPE); const float* CV = (const float*)(ws + WS_CVEC) + (size_t)l * CV_L;
        float* SSQ = (float*)(ws + WS_SSQ); const float* MODA = (const float*)(ws + WS_MOD);
        if (mode == 0) { const EpiIn e{(bf16_t*)(ws + WS_H), rope, rope + 8192, ssq_idx >= 0 ? SSQ + (size_t)ssq_idx * NTOK : nullptr, CV}; e(acc, u, wr, wc, fr, fq); }
        else if (mode == 1) { const EpiSq e{(bf16_t*)(ws + WS_H), DFF, SSQ + (size_t)ssq_idx * NTOK, CV + 3 * ZN}; e(acc, u, wr, wc, fr, fq); }
        else { const EpiRes e{rlat, rctx, out, (float*)(ws + WS_XC), MODA + (size_t)l * 3 * 12288 + gate_idx * DM, (float*)(ws + WS_ABUF2), ntfull,
                              aout_sel == 0 ? nullptr : (bf16_t*)(ws + (aout_sel == 1 ? WS_ABUF : WS_ABUF2)), ng, MODA + nsc_off, SSQ + (size_t)ssq_idx * NTOK}; e(acc, u, wr, wc, fr, fq); }
    }
};

__device__ __forceinline__ void map_col_in(int n, int& src, float& scale) {
    if (n < 3072) { src = n; scale = (n < 512) ? QSCALE : ((n >= 1536 && n < 1792) ? 0.125f : 1.f); }
    else if (n < 4352) { const bool isq = n < 4096; const int base = isq ? 3072 : 4096, sbase = isq ? 3104 : 4128; const int hh = (n - base) >> 7, pp = (n - base) & 127;
        const int i = 4 * (pp >> 3) + (pp & 3), half = (pp >> 2) & 1; const int od = (i < 32 ? i : i + 32) + 32 * half; src = sbase + hh * 128 + od; scale = isq ? QSCALE : 1.f; }
    else if (n < 4608) { src = 4384 + (n - 4352); scale = 1.f; }
    else if (n < 4640) { src = 3072 + (n - 4608); scale = 1.f; }
    else { src = -1; scale = 0.f; }
}
__device__ void conv_tile(int tid_, int bid_, const float* __restrict__ w, int Nsrc, int K, bf16_t* __restrict__ Bt, int n0, int k0, int mode, LAS float* tile) {
    const int t = tid_;
    { const int n = t & 127, kq = t >> 7; int src = n0 + n; float scale = 1.f; if (mode) map_col_in(n0 + n, src, scale);
        float v[32];
#pragma unroll
        for (int i = 0; i < 32; ++i) v[i] = (src >= 0) ? w[(size_t)(k0 + kq + 4 * i) * Nsrc + src] : 0.f;
#pragma unroll
        for (int i = 0; i < 32; ++i) tile[(kq + 4 * i) * 129 + n] = v[i] * scale; }
    __syncthreads();
    { const int n2 = t >> 2, kc = t & 3;
#pragma unroll
        for (int u = 0; u < 4; ++u) { float v[8];
#pragma unroll
            for (int j = 0; j < 8; ++j) v[j] = tile[(32 * kc + 8 * u + j) * 129 + n2];
            u32x4 pk; pk.x = cvt_pk_bf16(v[0], v[1]); pk.y = cvt_pk_bf16(v[2], v[3]); pk.z = cvt_pk_bf16(v[4], v[5]); pk.w = cvt_pk_bf16(v[6], v[7]);
            *(u32x4*)(Bt + (size_t)(n0 + n2) * K + k0 + 32 * kc + 8 * u) = pk; } }
    __syncthreads();
}
__device__ void phase0(int tid_, int bid_, const P& p, LAS unsigned char* lds) {
    LAS float* tile = (LAS float*)lds;
    LAS float* act = (LAS float*)(lds + 66560);
    LAS float* red = (LAS float*)(lds + 66560 + 24576);
    const int t = tid_;
    for (int i = t; i < 3 * 2048; i += 512) { const int v = i >> 11, k = i & 2047; const float xv = v < 2 ? p.c[v * 2048 + k] : p.c_ctx[k]; act[i] = xv / (1.f + __expf(-xv)); }
    { const int idx = bid_ * 512 + t; if (idx < 8192) { const int pos = idx >> 5, f = idx & 31; const double inv = pow(10000.0, -(double)f / 32.0); const double a = (double)pos * inv;
            float* rc = (float*)(p.ws + WS_ROPE); rc[idx] = (float)cos(a); rc[8192 + idx] = (float)sin(a); } }
    { float* sq = (float*)(p.ws + WS_SSQ); for (int i = bid_ * 512 + t; i < 3 * NTOK; i += gridDim.x * 512) sq[i] = 0.f; }
    __syncthreads();
    const int NGEMV = 768, NCONV = 2912;
    for (int it = bid_; it < NGEMV + 2 * NCONV; it += gridDim.x) {
        if (it < NGEMV) {
            const int l = it / 384, c0 = (it % 384) * 32; const int cq = t & 7, kg = t >> 3;
            float a0[4] = {0, 0, 0, 0}, a1[4] = {0, 0, 0, 0}, a2[4] = {0, 0, 0, 0};
            const float* wp = p.w_mod + (size_t)l * 2048 * 12288 + c0 + 4 * cq;
#pragma unroll 8
            for (int kk = 0; kk < 32; ++kk) { const int k = kg * 32 + kk; const f32x4 w4 = *(const f32x4*)(wp + (size_t)k * 12288); const float x0 = act[k], x1 = act[2048 + k], x2 = act[4096 + k];
#pragma unroll
                for (int j = 0; j < 4; ++j) { a0[j] += x0 * w4[j]; a1[j] += x1 * w4[j]; a2[j] += x2 * w4[j]; } }
#pragma unroll
            for (int j = 0; j < 4; ++j) { red[(kg * 3 + 0) * 32 + 4 * cq + j] = a0[j]; red[(kg * 3 + 1) * 32 + 4 * cq + j] = a1[j]; red[(kg * 3 + 2) * 32 + 4 * cq + j] = a2[j]; }
            __syncthreads();
            if (t < 96) { const int v = t >> 5, cc = t & 31; float s = 0.f; for (int g = 0; g < 64; ++g) s += red[(g * 3 + v) * 32 + cc];
                ((float*)(p.ws + WS_MOD))[(size_t)(l * 3 + v) * 12288 + c0 + cc] = s + p.b_mod[l * 12288 + c0 + cc]; }
            __syncthreads();
        } else {
            int r = it - NGEMV; const int l = r / NCONV; r -= l * NCONV;
            bf16_t* wb = (bf16_t*)(p.ws + WS_W + (size_t)l * SZ_WL);
            if (r < 608) { conv_tile(tid_, bid_, p.w_in + (size_t)l * DM * ZLD, ZLD, DM, wb, (r / 16) * 128, (r % 16) * 128, 1, tile); }
            else if (r < 864) { r -= 608; conv_tile(tid_, bid_, p.w_out + (size_t)l * DM * DM, DM, DM, wb + (size_t)ZN * DM, (r / 16) * 128, (r % 16) * 128, 0, tile); }
            else if (r < 1888) { r -= 864; conv_tile(tid_, bid_, p.w_ff1 + (size_t)l * DM * DFF, DFF, DM, wb + (size_t)ZN * DM + (size_t)DM * DM, (r / 16) * 128, (r % 16) * 128, 0, tile); }
            else { r -= 1888; conv_tile(tid_, bid_, p.w_ff2 + (size_t)l * DFF * DM, DM, DFF, wb + (size_t)ZN * DM + (size_t)DM * DM + (size_t)DFF * DM, (r / 64) * 128, (r % 64) * 128, 0, tile); }
        }
    }
}

__device__ void phase_norm(int tid_, int bid_, const P& p, int l, int which, const float* lat_src, const float* ctx_src, int nrows) {
    const int lane = tid_ & 63, wid = tid_ >> 6;
    bf16_t* A = (bf16_t*)(p.ws + WS_ABUF);
    const float* g = (which == 1 ? p.n1g : p.n2g) + l * DM;
    const float* mod = (const float*)(p.ws + WS_MOD) + (size_t)l * 3 * 12288;
    for (int row = bid_ * 8 + wid; row < nrows; row += gridDim.x * 8) {
        const float* xr = row < NLAT ? lat_src + (size_t)row * DM : ctx_src + (size_t)(row - NLAT) * DM;
        f32x4 v[8]; float ss = 0.f;
#pragma unroll
        for (int i = 0; i < 8; ++i) { v[i] = ((const f32x4*)xr)[lane + 64 * i]; ss += v[i][0] * v[i][0] + v[i][1] * v[i][1] + v[i][2] * v[i][2] + v[i][3] * v[i][3]; }
        ss = wave_sum(ss);
        const float rstd = rsqrtf(ss * (1.f / DM) + 1e-6f);
        const int modsel = row < LSEQ ? 0 : (row < NLAT ? 1 : 2);
        const float* sh = mod + modsel * 12288 + (which == 1 ? 0 : 3) * DM; const float* sc = sh + DM;
#pragma unroll
        for (int i = 0; i < 8; ++i) { const int c = 4 * (lane + 64 * i); const f32x4 g4 = *(const f32x4*)(g + c), s4 = *(const f32x4*)(sh + c), c4 = *(const f32x4*)(sc + c);
            float o[4];
#pragma unroll
            for (int j = 0; j < 4; ++j) o[j] = v[i][j] * rstd * g4[j] * (1.f + c4[j]) + s4[j];
            uint2 w; w.x = cvt_pk_bf16(o[0], o[1]); w.y = cvt_pk_bf16(o[2], o[3]); *(uint2*)(A + (size_t)row * DM + c) = w; }
    }
}
__device__ void phase_cvec(int tid_, int bid_, const P& p, LAS unsigned char* lds) {
    const int lane = tid_ & 63, wid = tid_ >> 6;
    LAS float* shv = (LAS float*)lds;
    const float* MOD = (const float*)(p.ws + WS_MOD);
    for (int i = tid_; i < 9 * 2048; i += 512) { const int set = i / 6144, r = i - set * 6144, v = r >> 11, k = r & 2047; const int l = set == 0 ? 0 : 1, idx = set == 1 ? 0 : 3;
        shv[i] = MOD[(size_t)(l * 3 + v) * 12288 + idx * 2048 + k]; }
    __syncthreads();
    float* CV = (float*)(p.ws + WS_CVEC);
    const int NR = DFF + ZN + DFF;
    for (int rr = bid_ * 8 + wid; rr < NR; rr += gridDim.x * 8) {
        int set, n, l, ncols; const bf16_t* wrow; float* outp;
        const bf16_t* wb0 = (const bf16_t*)(p.ws + WS_W); const bf16_t* wb1 = (const bf16_t*)(p.ws + WS_W + SZ_WL);
        if (rr < DFF) { set = 0; n = rr; l = 0; wrow = wb0 + (size_t)ZN * DM + (size_t)DM * DM + (size_t)n * DM; outp = CV + 3 * ZN + n; ncols = DFF; }
        else if (rr < DFF + ZN) { set = 1; n = rr - DFF; l = 1; wrow = wb1 + (size_t)n * DM; outp = CV + CV_L + n; ncols = ZN; }
        else { set = 2; n = rr - DFF - ZN; l = 1; wrow = wb1 + (size_t)ZN * DM + (size_t)DM * DM + (size_t)n * DM; outp = CV + CV_L + 3 * ZN + n; ncols = DFF; }
        float a0 = 0.f, a1 = 0.f, a2 = 0.f;
#pragma unroll
        for (int i = 0; i < 4; ++i) { const int k0 = lane * 8 + 512 * i; const u32x4 w = *(const u32x4*)(wrow + k0);
            const float wf[8] = {bflo(w.x), bfhi(w.x), bflo(w.y), bfhi(w.y), bflo(w.z), bfhi(w.z), bflo(w.w), bfhi(w.w)};
            const LAS float* s0 = shv + set * 6144 + k0;
#pragma unroll
            for (int j = 0; j < 8; ++j) { a0 += wf[j] * s0[j]; a1 += wf[j] * s0[2048 + j]; a2 += wf[j] * s0[4096 + j]; } }
        a0 = wave_sum(a0); a1 = wave_sum(a1); a2 = wave_sum(a2);
        if (lane == 0) { outp[0] = a0; outp[ncols] = a1; outp[2 * ncols] = a2; }
    }
}
__device__ void phase_ctxfix(int tid_, int bid_, const P& p) {
    const int lane = tid_ & 63, wid = tid_ >> 6;
    float* XC = (float*)(p.ws + WS_XC); const float* PART = (const float*)(p.ws + WS_ABUF2); bf16_t* A = (bf16_t*)(p.ws + WS_ABUF); float* SSQ = (float*)(p.ws + WS_SSQ) + NTOK;
    const float* MOD = (const float*)(p.ws + WS_MOD);
    const float* ga2 = MOD + (size_t)2 * 12288 + 5 * DM;
    const float* sc1 = MOD + (size_t)(3 + 2) * 12288 + 1 * DM;
    const float* g1 = p.n1g + DM;
    for (int idx = bid_ * 8 + wid; idx < NCTX * 4; idx += gridDim.x * 8) {
        const int r = idx >> 2, c0 = (idx & 3) * 512 + lane * 8;
        f32x4 s0 = {0.f, 0.f, 0.f, 0.f}, s1 = {0.f, 0.f, 0.f, 0.f};
#pragma unroll
        for (int sl = 0; sl < 16; ++sl) { const float* pp = PART + ((size_t)sl * NCTX + r) * DM + c0; s0 += *(const f32x4*)pp; s1 += *(const f32x4*)(pp + 4); }
        float* xp = XC + (size_t)r * DM + c0;
        const f32x4 x0 = *(const f32x4*)xp + *(const f32x4*)(ga2 + c0) * s0, x1 = *(const f32x4*)(xp + 4) + *(const f32x4*)(ga2 + c0 + 4) * s1;
        *(f32x4*)xp = x0; *(f32x4*)(xp + 4) = x1;
        float ss = x0[0] * x0[0] + x0[1] * x0[1] + x0[2] * x0[2] + x0[3] * x0[3] + x1[0] * x1[0] + x1[1] * x1[1] + x1[2] * x1[2] + x1[3] * x1[3];
        const f32x4 a0 = x0 * (*(const f32x4*)(g1 + c0)) * (*(const f32x4*)(sc1 + c0) + 1.f), a1 = x1 * (*(const f32x4*)(g1 + c0 + 4)) * (*(const f32x4*)(sc1 + c0 + 4) + 1.f);
        u32x4 w; w.x = cvt_pk_bf16(a0[0], a0[1]); w.y = cvt_pk_bf16(a0[2], a0[3]); w.z = cvt_pk_bf16(a1[0], a1[1]); w.w = cvt_pk_bf16(a1[2], a1[3]);
        *(u32x4*)(A + (size_t)(NLAT + r) * DM + c0) = w;
        ss = wave_sum(ss); if (lane == 0) atomicAdd(SSQ + NLAT + r, ss);
    }
}
__device__ void phase_final(int tid_, int bid_, const P& p) {
    const int lane = tid_ & 63, wid = tid_ >> 6;
    for (int row = bid_ * 8 + wid; row < NLAT; row += gridDim.x * 8) {
        float* xr = p.out + (size_t)row * DM;
        f32x4 v[8]; float ss = 0.f;
#pragma unroll
        for (int i = 0; i < 8; ++i) { v[i] = ((const f32x4*)xr)[lane + 64 * i]; ss += v[i][0] * v[i][0] + v[i][1] * v[i][1] + v[i][2] * v[i][2] + v[i][3] * v[i][3]; }
        ss = wave_sum(ss);
        const float rstd = rsqrtf(ss * (1.f / DM) + 1e-6f);
#pragma unroll
        for (int i = 0; i < 8; ++i) { const int c = 4 * (lane + 64 * i); const f32x4 g4 = *(const f32x4*)(p.fng + c); ((f32x4*)xr)[lane + 64 * i] = v[i] * rstd * g4; }
    }
}

__device__ void attn_simple(int tid_, int bid_, const P& p, int l, bool with_ctx, LAS unsigned char* lds) {
    const int lane = tid_ & 63, wid = tid_ >> 6;
    const bf16_t* Z = (const bf16_t*)(p.ws + WS_H);
    bf16_t* Y = (bf16_t*)(p.ws + WS_ABUF);
    LAS float* sc = (LAS float*)lds + wid * 576;
    const int nq_lat = NLAT * 12; const int nq = nq_lat + (with_ctx ? NCTX * 12 : 0);
    const int gw = bid_ * 8 + wid, nw = gridDim.x * 8;
    for (int it = gw; it < nq; it += nw) {
        int tok, hs; bool isctx;
        if (it < nq_lat) { tok = it / 12; hs = it - tok * 12; isctx = false; } else { const int r = it - nq_lat; tok = NLAT + r / 12; hs = r % 12; isctx = true; }
        const int b = isctx ? ((tok - NLAT) >> 8) : (tok >> 14);
        const bool na = hs < 4;
        int qcol, kcol, vcol, ycol;
        if (na) { qcol = C_NAQ + hs * 128; kcol = C_NAK + hs * 128; vcol = C_NAV + hs * 128; ycol = hs * 128; }
        else { const int h = hs - 4; qcol = C_SQ + h * 128; kcol = C_SK + (h >> 2) * 128; vcol = C_SV + (h >> 2) * 128; ycol = 1024 + h * 128; }
        int nloc = 0, lo = 0, rs = 0, cs = 0, r = 0, cpos = 0;
        if (!isctx) { const int t = tok & (LSEQ - 1);
            if (na) { r = t >> 6; cpos = t & 63; rs = min(max(r - 4, 0), 248); cs = min(max(cpos - 8, 0), 48); nloc = 128; }
            else { lo = max(t - 128, 0); const int hi = min(t + 128, LSEQ - 1); nloc = hi - lo + 1; } }
        const int nk = nloc + 256; const int ctxbase = NLAT + b * 256, latbase = b * LSEQ;
        u32x4 q[16]; { const u32x4* qp = (const u32x4*)(Z + (size_t)tok * ZLD + qcol);
#pragma unroll
            for (int i = 0; i < 16; ++i) q[i] = qp[i]; }
        const float* rp = p.rpb + (size_t)l * 4 * 465 + (na ? hs : 0) * 465;
        float mx = -3.0e38f;
        for (int j = lane; j < nk; j += 64) {
            int kt; float bias = 0.f;
            if (j < nloc) { if (na) { const int kr = rs + (j >> 4), kc = cs + (j & 15); kt = latbase + kr * 64 + kc; bias = rp[(kr - r + 7) * 31 + (kc - cpos + 15)] * LOG2E; } else kt = latbase + lo + j; }
            else kt = ctxbase + (j - nloc);
            const u32x4* kp = (const u32x4*)(Z + (size_t)kt * ZLD + kcol);
            float s = 0.f;
#pragma unroll
            for (int i = 0; i < 16; ++i) s += dot8(q[i], kp[i]);
            s += bias; sc[j] = s; mx = fmaxf(mx, s);
        }
        mx = wave_max(mx);
        float snk = 0.f; if (!na) { snk = p.sink[l * 8 + (hs - 4)] * LOG2E; mx = fmaxf(mx, snk); }
        float sum = 0.f;
        for (int j = lane; j < nk; j += 64) { const float pj = exp2f(sc[j] - mx); sc[j] = pj; sum += pj; }
        sum = wave_sum(sum); if (!na) sum += exp2f(snk - mx);
        float o0 = 0.f, o1 = 0.f;
#pragma unroll 4
        for (int j = 0; j < nk; ++j) {
            int kt;
            if (j < nloc) { if (na) kt = latbase + (rs + (j >> 4)) * 64 + cs + (j & 15); else kt = latbase + lo + j; } else kt = ctxbase + (j - nloc);
            const float pj = sc[j]; const unsigned vv = *(const unsigned*)(Z + (size_t)kt * ZLD + vcol + 2 * lane);
            o0 += pj * bflo(vv); o1 += pj * bfhi(vv);
        }
        const float inv = 1.f / sum;
        *(unsigned*)(Y + (size_t)tok * DM + ycol + 2 * lane) = cvt_pk_bf16(o0 * inv, o1 * inv);
    }
}

__device__ __forceinline__ float grp_max4(float v) {
    unsigned a = __float_as_uint(v); auto r = __builtin_amdgcn_permlane16_swap(a, a, false, false); v = fmaxf(__uint_as_float(r[0]), __uint_as_float(r[1]));
    a = __float_as_uint(v); auto r2 = __builtin_amdgcn_permlane32_swap(a, a, false, false); return fmaxf(__uint_as_float(r2[0]), __uint_as_float(r2[1]));
}
__device__ __forceinline__ float grp_sum4(float v) {
    unsigned a = __float_as_uint(v); auto r = __builtin_amdgcn_permlane16_swap(a, a, false, false); v = __uint_as_float(r[0]) + __uint_as_float(r[1]);
    a = __float_as_uint(v); auto r2 = __builtin_amdgcn_permlane32_swap(a, a, false, false); return __uint_as_float(r2[0]) + __uint_as_float(r2[1]);
}
typedef short s16x4 __attribute__((ext_vector_type(4)));
__device__ __forceinline__ unsigned att_koff(int row, int ch) { return (unsigned)(row * 256 + ((ch ^ ((row & 3) | (((row >> 3) & 3) << 2))) << 4)); }
__device__ __forceinline__ unsigned att_voff(int row, int ch) { return (unsigned)(row * 256 + ((ch ^ (((row & 3) << 2) | ((row >> 2) & 3))) << 4)); }
constexpr float ATT_MASKED = -1.0e30f, ATT_MINIT = -5.0e29f;
__device__ void attn_mfma(int tid_, int bid_, const P& p, int l, bool with_ctx, LAS unsigned char* lds) {
    const int lane = tid_ & 63, wid = __builtin_amdgcn_readfirstlane(tid_ >> 6), l15 = lane & 15, lg = lane >> 4;
    const bf16_t* Z = (const bf16_t*)(p.ws + WS_H);
    bf16_t* Y = (bf16_t*)(p.ws + WS_ABUF);
    LAS float* rpbs = (LAS float*)(lds + 65536);
    const int n_swa = 1024, n_na = 512, n_ctx = with_ctx ? 24 : 0;
    unsigned kx[4];
#pragma unroll
    for (int kk = 0; kk < 4; ++kk) kx[kk] = (unsigned)((8 * (l15 >> 2) + (l15 & 3)) * 256 + (((4 * kk + lg) ^ l15) << 4));
    const int vq = l15 >> 2, vp = lane & 3;
    unsigned vrow[2], vx[2];
#pragma unroll
    for (int t = 0; t < 2; ++t) { vrow[t] = (unsigned)((8 * lg + 4 * t + vq) * 256 + 8 * (vp & 1)); vx[t] = (unsigned)((vq << 2) | ((2 * lg + t) & 3)); }
    int st_row[2], st_ch[2];
#pragma unroll
    for (int i = 0; i < 2; ++i) { const int idx = tid_ + 512 * i; st_row[i] = idx >> 4; st_ch[i] = idx & 15; }

    for (int item = bid_; item < n_swa + n_na + n_ctx; item += gridDim.x) {
        int type, b, kcol, vcol, nloc = 0, loc_tok0 = 0, loc_pos0 = 0, qtok0, qcol, ycol, qpos0 = 0, r_na = 0, rs_lo = 0, rsr = 0, hbias = 0;
        bool has_sink = false; float sinkv = 0.f;
        if (item < n_swa) {
            type = 0; b = item >> 9; const int g = (item >> 8) & 1, m = item & 255; const int h = 4 * g + (wid >> 1);
            qpos0 = 64 * m + 32 * (wid & 1); qtok0 = b * LSEQ + qpos0; qcol = C_SQ + h * 128; ycol = 1024 + h * 128; kcol = C_SK + g * 128; vcol = C_SV + g * 128;
            const int c_lo = max(0, 2 - m), c_hi = min(4, 257 - m); nloc = c_hi - c_lo + 1; loc_pos0 = 64 * (m - 2 + c_lo); loc_tok0 = b * LSEQ + loc_pos0;
            has_sink = true; sinkv = p.sink[l * 8 + h] * LOG2E;
        } else if (item < n_swa + n_na) {
            type = 1; const int it = item - n_swa; b = it >> 8; const int h = (it >> 6) & 3, R4 = it & 63; r_na = 4 * R4 + (wid >> 1); qpos0 = 32 * (wid & 1);
            qtok0 = b * LSEQ + r_na * 64 + qpos0; qcol = C_NAQ + h * 128; ycol = h * 128; kcol = C_NAK + h * 128; vcol = C_NAV + h * 128; hbias = h;
            rs_lo = min(max(4 * R4 - 4, 0), 248); const int rs_hi = min(max(4 * R4 - 1, 0), 248) + 7; nloc = rs_hi - rs_lo + 1; loc_tok0 = b * LSEQ + rs_lo * 64;
            rsr = min(max(r_na - 4, 0), 248);
        } else {
            type = 2; int it = item - n_swa - n_na;
            if (it < 8) { b = it >> 2; const int h = it & 3; qcol = C_NAQ + h * 128; ycol = h * 128; kcol = C_NAK + h * 128; vcol = C_NAV + h * 128; }
            else { it -= 8; b = it >> 3; const int h = it & 7; qcol = C_SQ + h * 128; ycol = 1024 + h * 128; kcol = C_SK + (h >> 2) * 128; vcol = C_SV + (h >> 2) * 128; has_sink = true; sinkv = p.sink[l * 8 + h] * LOG2E; }
            qtok0 = NLAT + b * 256 + 32 * wid;
        }
        const int nch = nloc + 4; const int ctx_tok0 = NLAT + b * 256;
        if (type == 1) { for (int i = tid_; i < 465; i += 512) rpbs[i] = p.rpb[(size_t)(l * 4 + hbias) * 465 + i] * LOG2E; }
        bf16x8 Qf[2][4];
#pragma unroll
        for (int qt = 0; qt < 2; ++qt)
#pragma unroll
            for (int kk = 0; kk < 4; ++kk) Qf[qt][kk] = *(const bf16x8*)(Z + (size_t)(qtok0 + 16 * qt + l15) * ZLD + qcol + 32 * kk + 8 * lg);
        f32x4 O[8][2];
#pragma unroll
        for (int dt = 0; dt < 8; ++dt) { O[dt][0] = (f32x4){0.f, 0.f, 0.f, 0.f}; O[dt][1] = (f32x4){0.f, 0.f, 0.f, 0.f}; }
        float mrun[2] = {ATT_MINIT, ATT_MINIT}, lsum[2] = {0.f, 0.f};
        u32x4 kr[2], vr[2];
#define ATT_LOAD(tokb) do { _Pragma("unroll") for (int i = 0; i < 2; ++i) { const bf16_t* src = Z + (size_t)((tokb) + st_row[i]) * ZLD + st_ch[i] * 8; kr[i] = *(const u32x4*)(src + kcol); vr[i] = *(const u32x4*)(src + vcol); } } while (0)
#define ATT_STORE(buf) do { _Pragma("unroll") for (int i = 0; i < 2; ++i) { *(LAS u32x4*)(lds + (buf) * 16384 + att_koff(st_row[i], st_ch[i])) = kr[i]; *(LAS u32x4*)(lds + 32768 + (buf) * 16384 + att_voff(st_row[i], st_ch[i])) = vr[i]; } } while (0)
#define ATT_TOK(c) ((c) < nloc ? loc_tok0 + 64 * (c) : ctx_tok0 + 64 * ((c) - nloc))
        ATT_LOAD(ATT_TOK(0)); ATT_STORE(0); __syncthreads();
        for (int c = 0; c < nch; ++c) {
            if (c + 1 < nch) ATT_LOAD(ATT_TOK(c + 1));
            const bool is_loc = c < nloc;
            LAS unsigned char* Kb = lds + (c & 1) * 16384; LAS unsigned char* Vb = lds + 32768 + (c & 1) * 16384;
#pragma unroll 1
            for (int blk = 0; blk < 2; ++blk) {
                bool rel = true; int kb = 0, kr_na = 0;
                if (is_loc) { if (type == 0) { kb = loc_pos0 + 64 * c + 32 * blk; rel = (kb + 31 >= qpos0 - 128) && (kb <= qpos0 + 159); } else { kr_na = rs_lo + c; rel = (kr_na >= rsr) && (kr_na <= rsr + 7); } }
                if (!rel) continue;
                f32x4 s[2][2];
#pragma unroll
                for (int kt = 0; kt < 2; ++kt) { s[kt][0] = (f32x4){0.f, 0.f, 0.f, 0.f}; s[kt][1] = (f32x4){0.f, 0.f, 0.f, 0.f}; }
#pragma unroll
                for (int kk = 0; kk < 4; ++kk)
#pragma unroll
                    for (int kt = 0; kt < 2; ++kt) { const bf16x8 kf = *(const LAS bf16x8*)(Kb + kx[kk] + (32 * blk + 4 * kt) * 256);
                        s[kt][0] = __builtin_amdgcn_mfma_f32_16x16x32_bf16(kf, Qf[0][kk], s[kt][0], 0, 0, 0); s[kt][1] = __builtin_amdgcn_mfma_f32_16x16x32_bf16(kf, Qf[1][kk], s[kt][1], 0, 0, 0); }
                if (is_loc) {
                    if (type == 0) { if (!((kb >= qpos0 - 97) && (kb <= qpos0 + 97))) { const int dq = kb + 8 * lg - qpos0 - l15;
#pragma unroll
                        for (int kt = 0; kt < 2; ++kt)
#pragma unroll
                            for (int qt = 0; qt < 2; ++qt)
#pragma unroll
                                for (int j = 0; j < 4; ++j) { const int d = dq + 4 * kt + j - 16 * qt; s[kt][qt][j] = (d <= 128 && d >= -128) ? s[kt][qt][j] : ATT_MASKED; } }
                    } else { const int rowoff = (kr_na - r_na + 7) * 31;
#pragma unroll
                        for (int qt = 0; qt < 2; ++qt) { const int qc = qpos0 + 16 * qt + l15; const int cs = min(max(qc - 8, 0), 48);
#pragma unroll
                            for (int kt = 0; kt < 2; ++kt)
#pragma unroll
                                for (int j = 0; j < 4; ++j) { const int kc = 32 * blk + 8 * lg + 4 * kt + j; const bool valid = (kc >= cs) && (kc < cs + 16);
                                    const int bi = min(max(kc - qc + 15, 0), 30); const float bias = rpbs[rowoff + bi]; s[kt][qt][j] = valid ? s[kt][qt][j] + bias : ATT_MASKED; } }
                    }
                }
                bf16x8 pk[2];
#pragma unroll
                for (int qt = 0; qt < 2; ++qt) {
                    float ml = fmaxf(fmaxf(fmaxf(s[0][qt][0], s[0][qt][1]), fmaxf(s[0][qt][2], s[0][qt][3])), fmaxf(fmaxf(s[1][qt][0], s[1][qt][1]), fmaxf(s[1][qt][2], s[1][qt][3])));
                    ml = grp_max4(ml);
                    const float mn = fmaxf(mrun[qt], ml); const float alpha = __builtin_amdgcn_exp2f(mrun[qt] - mn); mrun[qt] = mn;
                    float ps = 0.f; float pv[8];
#pragma unroll
                    for (int kt = 0; kt < 2; ++kt)
#pragma unroll
                        for (int j = 0; j < 4; ++j) { const float e = __builtin_amdgcn_exp2f(s[kt][qt][j] - mn); pv[4 * kt + j] = e; ps += e; }
                    lsum[qt] = lsum[qt] * alpha + ps;
                    if (__any(alpha != 1.f)) {
#pragma unroll
                        for (int dt = 0; dt < 8; ++dt) O[dt][qt] *= alpha; }
                    u32x4 w; w.x = cvt_pk_bf16(pv[0], pv[1]); w.y = cvt_pk_bf16(pv[2], pv[3]); w.z = cvt_pk_bf16(pv[4], pv[5]); w.w = cvt_pk_bf16(pv[6], pv[7]);
                    pk[qt] = __builtin_bit_cast(bf16x8, w);
                }
#pragma unroll
                for (int dt = 0; dt < 8; ++dt) {
                    const s16x4 v0 = __builtin_amdgcn_ds_read_tr16_b64_v4i16((LAS s16x4*)(Vb + vrow[0] + blk * 8192 + ((((unsigned)(2 * dt + (vp >> 1))) ^ vx[0]) << 4)));
                    const s16x4 v1 = __builtin_amdgcn_ds_read_tr16_b64_v4i16((LAS s16x4*)(Vb + vrow[1] + blk * 8192 + ((((unsigned)(2 * dt + (vp >> 1))) ^ vx[1]) << 4)));
                    const bf16x8 vf = {v0[0], v0[1], v0[2], v0[3], v1[0], v1[1], v1[2], v1[3]};
                    O[dt][0] = __builtin_amdgcn_mfma_f32_16x16x32_bf16(vf, pk[0], O[dt][0], 0, 0, 0); O[dt][1] = __builtin_amdgcn_mfma_f32_16x16x32_bf16(vf, pk[1], O[dt][1], 0, 0, 0);
                }
            }
            if (c + 1 < nch) ATT_STORE((c + 1) & 1);
            __syncthreads();
        }
#undef ATT_LOAD
#undef ATT_STORE
#undef ATT_TOK
#pragma unroll
        for (int qt = 0; qt < 2; ++qt) {
            float lt = grp_sum4(lsum[qt]);
            if (has_sink) lt += exp2f(fminf(sinkv - mrun[qt], 126.f));
            const float inv = 1.f / lt;
            bf16_t* yp = Y + (size_t)(qtok0 + 16 * qt + l15) * DM + ycol + 4 * lg;
#pragma unroll
            for (int dt = 0; dt < 8; ++dt) { uint2 w; w.x = cvt_pk_bf16(O[dt][qt][0] * inv, O[dt][qt][1] * inv); w.y = cvt_pk_bf16(O[dt][qt][2] * inv, O[dt][qt][3] * inv); *(uint2*)(yp + 16 * dt) = w; }
        }
    }
}

__device__ __forceinline__ int gla_tokbase(int b, int s) { return s < 4 ? NLAT + b * 256 + s * 64 : b * LSEQ + (s - 4) * 64; }
constexpr int GLD = 68;
__device__ void gla_gates(int tid_, int bid_, const P& p, int l, int h, int tokbase, LAS float* B, LAS float* gl, LAS float* tot) {
    const int t = tid_; const bf16_t* Z = (const bf16_t*)(p.ws + WS_H);
    for (int i = t; i < 64 * 32; i += 512) { const int j = i >> 5, r = i & 31; gl[i] = bf2f(Z[(size_t)(tokbase + j) * ZLD + C_GFL + r]); }
    __syncthreads();
    const int dir = t >> 8, seg = (t >> 6) & 3, k = t & 63;
    const float* wg = (dir ? p.wgb : p.wgf) + l * 16 * 256 + h * 64 + k; float w[16];
#pragma unroll
    for (int r = 0; r < 16; ++r) w[r] = wg[r * 256];
    const float bg = (dir ? p.bgb : p.bgf)[l * 256 + h * 64 + k];
    float run = 0.f;
    for (int jj = 0; jj < 16; ++jj) { const int j = dir ? (seg * 16 + 15 - jj) : (seg * 16 + jj); float u = bg;
#pragma unroll
        for (int r = 0; r < 16; ++r) u += gl[j * 32 + dir * 16 + r] * w[r];
        const float g = -(fmaxf(-u, 0.f) + log1pf(__expf(-fabsf(u)))) * (1.f / 16.f); run += g; B[(dir * 64 + j) * GLD + k] = run; }
    tot[(dir * 4 + seg) * 64 + k] = run;
    __syncthreads();
}
__device__ __forceinline__ float gla_off(LAS const float* tot, int dir, int j, int k) {
    const int seg = j >> 4; float o = 0.f;
    if (!dir) { for (int s = 0; s < 3; ++s) if (s < seg) o += tot[s * 64 + k]; } else { for (int s = 1; s < 4; ++s) if (s > seg) o += tot[(4 + s) * 64 + k]; }
    return o;
}
__device__ void gla_g1(int tid_, int bid_, const P& p, int l, LAS unsigned char* lds) {
    LAS float* B = (LAS float*)lds;
    LAS float* V = (LAS float*)(lds + 36864);
    LAS float* gl = (LAS float*)(lds + 36864 + 32768);
    LAS float* tot = (LAS float*)(lds + 36864 + 32768 + 8192);
    const bf16_t* Z = (const bf16_t*)(p.ws + WS_H); float* ST = (float*)(p.ws + WS_ST); float* DEC = (float*)(p.ws + WS_DEC);
    const int t = tid_;
    for (int item = bid_; item < 520 * 4; item += gridDim.x) {
        const int h = item & 3, cs = item >> 2, b = cs / 260, s = cs - b * 260; const int tb = gla_tokbase(b, s);
        gla_gates(tid_, bid_, p, l, h, tb, B, gl, tot);
        for (int i = t; i < 64 * 16; i += 512) { const int j = i >> 4, c8 = (i & 15) * 8; const u32x4 u = *(const u32x4*)(Z + (size_t)(tb + j) * ZLD + C_GV + h * 128 + c8);
            LAS float* d = V + j * 128 + c8; d[0] = bflo(u.x); d[1] = bfhi(u.x); d[2] = bflo(u.y); d[3] = bfhi(u.y); d[4] = bflo(u.z); d[5] = bfhi(u.z); d[6] = bflo(u.w); d[7] = bfhi(u.w); }
        for (int e = t; e < 2 * 4096; e += 512) { const int dir = e >> 12, j = (e >> 6) & 63, k = e & 63;
            const float total = tot[(dir * 4 + 0) * 64 + k] + tot[(dir * 4 + 1) * 64 + k] + tot[(dir * 4 + 2) * 64 + k] + tot[(dir * 4 + 3) * 64 + k];
            const float bb = B[(dir * 64 + j) * GLD + k] + gla_off(tot, dir, j, k);
            const float kv = bf2f(Z[(size_t)(tb + j) * ZLD + C_GK + h * 64 + k]);
            B[(dir * 64 + j) * GLD + k] = kv * __expf(total - bb);
            if (j == 0) DEC[(size_t)(((dir * 2 + b) * 260 + s) * 4 + h) * 64 + k] = __expf(total); }
        __syncthreads();
        { const int vq = t & 31, kk = t >> 5; float af[4][4], ab[4][4];
#pragma unroll
            for (int a = 0; a < 4; ++a)
#pragma unroll
                for (int c = 0; c < 4; ++c) { af[a][c] = 0.f; ab[a][c] = 0.f; }
            for (int j = 0; j < 64; ++j) { const f32x4 v4 = *(const LAS f32x4*)(V + j * 128 + 4 * vq); const f32x4 kf = *(const LAS f32x4*)(B + j * GLD + 4 * kk), kb = *(const LAS f32x4*)(B + (64 + j) * GLD + 4 * kk);
#pragma unroll
                for (int a = 0; a < 4; ++a)
#pragma unroll
                    for (int c = 0; c < 4; ++c) { af[a][c] += kf[a] * v4[c]; ab[a][c] += kb[a] * v4[c]; } }
            float* sf = ST + (size_t)(((0 * 2 + b) * 260 + s) * 4 + h) * 8192; float* sb = ST + (size_t)(((1 * 2 + b) * 260 + s) * 4 + h) * 8192;
#pragma unroll
            for (int a = 0; a < 4; ++a) { *(f32x4*)(sf + (4 * kk + a) * 128 + 4 * vq) = (f32x4){af[a][0], af[a][1], af[a][2], af[a][3]}; *(f32x4*)(sb + (4 * kk + a) * 128 + 4 * vq) = (f32x4){ab[a][0], ab[a][1], ab[a][2], ab[a][3]}; } }
        __syncthreads();
    }
}
__device__ void gla_scan(int tid_, int bid_, const P& p) {
    const float* ST = (const float*)(p.ws + WS_ST); const float* DEC = (const float*)(p.ws + WS_DEC); bf16_t* SB = (bf16_t*)(p.ws + WS_SBF);
    for (int e = bid_ * 512 + tid_; e < 131072; e += gridDim.x * 512) {
        const int dir = e >> 16, b = (e >> 15) & 1, h = (e >> 13) & 3, kv = e & 8191, k = kv >> 7;
        const size_t sboff = (att_voff(k, (kv & 127) >> 3) >> 1) + (kv & 7);
        float S = 0.f;
        for (int st0 = 0; st0 < 260; st0 += 10) {
            float kvv[10], dd[10]; size_t idx[10];
#pragma unroll
            for (int u = 0; u < 10; ++u) { const int step = st0 + u; const int s = step < 4 ? (dir ? 3 - step : step) : (dir ? 263 - step : step);
                idx[u] = (size_t)(((dir * 2 + b) * 260 + s) * 4 + h); kvv[u] = ST[idx[u] * 8192 + kv]; dd[u] = DEC[idx[u] * 64 + k]; }
#pragma unroll
            for (int u = 0; u < 10; ++u) { SB[idx[u] * 8192 + sboff] = (bf16_t)(cvt_pk_bf16(S, 0.f) & 0xffffu); S = dd[u] * S + kvv[u]; }
        }
    }
}
__device__ void gla_g3(int tid_, int bid_, const P& p, int l, bool with_ctx, LAS unsigned char* lds) {
    LAS float* B = (LAS float*)lds;
    LAS float* Q = (LAS float*)(lds + 34816);
    LAS float* V = (LAS float*)(lds + 69632);
    LAS float* A = (LAS float*)(lds + 102400);
    LAS float* gl = (LAS float*)(lds + 119040);
    LAS float* tot = (LAS float*)(lds + 127232);
    const bf16_t* Z = (const bf16_t*)(p.ws + WS_H); const float* ST = (const float*)(p.ws + WS_ST); bf16_t* Y = (bf16_t*)(p.ws + WS_ABUF);
    const int t = tid_;
    for (int item = bid_; item < 520 * 4; item += gridDim.x) {
        const int h = item & 3, cs = item >> 2, b = cs / 260, s = cs - b * 260; if (s < 4 && !with_ctx) continue;
        const int tb = gla_tokbase(b, s);
        gla_gates(tid_, bid_, p, l, h, tb, B, gl, tot);
        for (int i = t; i < 64 * 16; i += 512) { const int j = i >> 4, c8 = (i & 15) * 8; const u32x4 u = *(const u32x4*)(Z + (size_t)(tb + j) * ZLD + C_GV + h * 128 + c8);
            LAS float* d = V + j * 128 + c8; d[0] = bflo(u.x); d[1] = bfhi(u.x); d[2] = bflo(u.y); d[3] = bfhi(u.y); d[4] = bflo(u.z); d[5] = bfhi(u.z); d[6] = bflo(u.w); d[7] = bfhi(u.w); }
        for (int e = t; e < 2 * 4096; e += 512) { const int dir = e >> 12, j = (e >> 6) & 63, k = e & 63;
            const float bb = B[(dir * 64 + j) * GLD + k] + gla_off(tot, dir, j, k);
            const float qv = bf2f(Z[(size_t)(tb + j) * ZLD + C_GQ + h * 64 + k]), kv = bf2f(Z[(size_t)(tb + j) * ZLD + C_GK + h * 64 + k]);
            Q[(dir * 64 + j) * GLD + k] = qv * __expf(bb); B[(dir * 64 + j) * GLD + k] = kv * __expf(-bb); }
        __syncthreads();
        { const int i = t >> 3, jg = t & 7; float af[8], ab[8];
#pragma unroll
            for (int jj = 0; jj < 8; ++jj) { af[jj] = 0.f; ab[jj] = 0.f; }
            for (int k4 = 0; k4 < 16; ++k4) { const f32x4 qf = *(const LAS f32x4*)(Q + i * GLD + 4 * k4), qb = *(const LAS f32x4*)(Q + (64 + i) * GLD + 4 * k4);
#pragma unroll
                for (int jj = 0; jj < 8; ++jj) { const int j = jg + 8 * jj; const f32x4 kf = *(const LAS f32x4*)(B + j * GLD + 4 * k4), kb = *(const LAS f32x4*)(B + (64 + j) * GLD + 4 * k4);
                    af[jj] += qf[0] * kf[0] + qf[1] * kf[1] + qf[2] * kf[2] + qf[3] * kf[3]; ab[jj] += qb[0] * kb[0] + qb[1] * kb[1] + qb[2] * kb[2] + qb[3] * kb[3]; } }
#pragma unroll
            for (int jj = 0; jj < 8; ++jj) { const int j = jg + 8 * jj; A[i * 65 + j] = (j <= i ? af[jj] : 0.f) + (j >= i ? ab[jj] : 0.f); } }
        __syncthreads();
        { const int i = t >> 3, vg = t & 7; f32x4 o[4];
#pragma unroll
            for (int c = 0; c < 4; ++c) o[c] = (f32x4){0.f, 0.f, 0.f, 0.f};
            for (int j = 0; j < 64; ++j) { const float a = A[i * 65 + j];
#pragma unroll
                for (int c = 0; c < 4; ++c) o[c] += a * *(const LAS f32x4*)(V + j * 128 + vg * 16 + 4 * c); }
            const float* sf = ST + (size_t)(((0 * 2 + b) * 260 + s) * 4 + h) * 8192 + vg * 16; const float* sb = ST + (size_t)(((1 * 2 + b) * 260 + s) * 4 + h) * 8192 + vg * 16;
#pragma unroll 4
            for (int k = 0; k < 64; ++k) { const float qf = Q[i * GLD + k], qb = Q[(64 + i) * GLD + k];
#pragma unroll
                for (int c = 0; c < 4; ++c) o[c] += qf * *(const f32x4*)(sf + k * 128 + 4 * c) + qb * *(const f32x4*)(sb + k * 128 + 4 * c); }
            float ss = 0.f;
#pragma unroll
            for (int c = 0; c < 4; ++c) ss += o[c][0] * o[c][0] + o[c][1] * o[c][1] + o[c][2] * o[c][2] + o[c][3] * o[c][3];
            ss += __shfl_xor(ss, 1); ss += __shfl_xor(ss, 2); ss += __shfl_xor(ss, 4);
            const float rstd = rsqrtf(ss * (1.f / 128.f) + 1e-6f);
            const int tok = tb + i; const bf16_t* rp = Z + (size_t)tok * ZLD + C_GR + h * 128 + vg * 16; const float* gg = p.glag + l * 128 + vg * 16;
            const u32x4 r0 = *(const u32x4*)rp, r1 = *(const u32x4*)(rp + 8);
            float rr[16] = {bflo(r0.x), bfhi(r0.x), bflo(r0.y), bfhi(r0.y), bflo(r0.z), bfhi(r0.z), bflo(r0.w), bfhi(r0.w), bflo(r1.x), bfhi(r1.x), bflo(r1.y), bfhi(r1.y), bflo(r1.z), bfhi(r1.z), bflo(r1.w), bfhi(r1.w)};
            float res[16];
#pragma unroll
            for (int c = 0; c < 4; ++c)
#pragma unroll
                for (int jx = 0; jx < 4; ++jx) { const float r = rr[4 * c + jx]; res[4 * c + jx] = o[c][jx] * rstd * gg[4 * c + jx] * (r / (1.f + __expf(-r))); }
            u32x4 w0, w1; w0.x = cvt_pk_bf16(res[0], res[1]); w0.y = cvt_pk_bf16(res[2], res[3]); w0.z = cvt_pk_bf16(res[4], res[5]); w0.w = cvt_pk_bf16(res[6], res[7]);
            w1.x = cvt_pk_bf16(res[8], res[9]); w1.y = cvt_pk_bf16(res[10], res[11]); w1.z = cvt_pk_bf16(res[12], res[13]); w1.w = cvt_pk_bf16(res[14], res[15]);
            bf16_t* yp = Y + (size_t)tok * DM + 512 + h * 128 + vg * 16; *(u32x4*)yp = w0; *(u32x4*)(yp + 8) = w1; }
        __syncthreads();
    }
}

__device__ void gla_gates2(int tid_, const P& p, int l, int h, int tokbase, LAS float* B, LAS float* gl, LAS float* tot) {
    const int t = tid_; const bf16_t* Z = (const bf16_t*)(p.ws + WS_H);
    { const int j = t >> 3, c4 = (t & 7) * 4; const uint2 u = *(const uint2*)(Z + (size_t)(tokbase + j) * ZLD + C_GFL + c4);
        LAS float* d = gl + j * 32 + c4; d[0] = bflo(u.x); d[1] = bfhi(u.x); d[2] = bflo(u.y); d[3] = bfhi(u.y); }
    const int dir = t >> 8, seg = (t >> 6) & 3, k = t & 63;
    const float* wg = (dir ? p.wgb : p.wgf) + l * 16 * 256 + h * 64 + k; float w[16];
#pragma unroll
    for (int r = 0; r < 16; ++r) w[r] = wg[r * 256];
    const float bg = (dir ? p.bgb : p.bgf)[l * 256 + h * 64 + k];
    __syncthreads();
    float run = 0.f;
    for (int jj = 0; jj < 16; ++jj) { const int j = dir ? (seg * 16 + 15 - jj) : (seg * 16 + jj); float u = bg;
#pragma unroll
        for (int r4 = 0; r4 < 4; ++r4) { const f32x4 g4 = *(const LAS f32x4*)(gl + j * 32 + dir * 16 + 4 * r4); u += g4[0] * w[4 * r4] + g4[1] * w[4 * r4 + 1] + g4[2] * w[4 * r4 + 2] + g4[3] * w[4 * r4 + 3]; }
        const float g = -(fmaxf(-u, 0.f) + __logf(1.f + __expf(-fabsf(u)))) * (1.f / 16.f); run += g; B[(dir * 64 + j) * GLD + k] = run; }
    tot[(dir * 4 + seg) * 64 + k] = run;
    __syncthreads();
    float off = 0.f, total = 0.f;
#pragma unroll
    for (int s = 0; s < 4; ++s) { const float v = tot[(dir * 4 + s) * 64 + k]; total += v; if (dir ? (s > seg) : (s < seg)) off += v; }
    for (int jj = 0; jj < 16; ++jj) { const int j = seg * 16 + jj; B[(dir * 64 + j) * GLD + k] += off; }
    __syncthreads();
    if (seg == 0) tot[(dir * 4) * 64 + k] = total;
    __syncthreads();
}
__device__ __forceinline__ unsigned gl_off128tr(int row, int ch) { return (unsigned)(row * 128 + ((ch ^ (((((row >> 3) & 1) << 1) | ((row >> 1) & 1)) << 1)) << 4)); }
__device__ __forceinline__ unsigned gl_offQ(int row, int ch) { return (unsigned)(row * 128 + ((ch ^ ((row >> 1) & 7)) << 4)); }
__device__ __forceinline__ unsigned gl_offK(int row, int ch) { return (unsigned)(row * 128 + ((ch ^ (((row >> 1) & 1) | (((row >> 3) & 3) << 1))) << 4)); }
constexpr int GL_B = 0, GL_QT = 34816, GL_KT = 51200, GL_V = 67584, GL_S = 83968, GL_GL = 116736, GL_TOT = 124928, GL_SSQ = 126976;
__device__ void gla_g1m(int tid_, int bid_, const P& p, int l, LAS unsigned char* lds) {
    LAS float* B = (LAS float*)(lds + GL_B); LAS float* gl = (LAS float*)(lds + GL_GL); LAS float* tot = (LAS float*)(lds + GL_TOT);
    LAS unsigned char* KH = lds + GL_QT; LAS unsigned char* VB = lds + GL_V;
    const bf16_t* Z = (const bf16_t*)(p.ws + WS_H); float* ST = (float*)(p.ws + WS_ST); float* DEC = (float*)(p.ws + WS_DEC);
    const int t = tid_, lane = t & 63, wid = __builtin_amdgcn_readfirstlane(t >> 6), l15 = lane & 15, lg = lane >> 4, vq = l15 >> 2, vp = lane & 3;
    for (int item = bid_; item < 520 * 4; item += gridDim.x) {
        const int h = item & 3, cs = item >> 2, b = cs / 260, s = cs - b * 260; const int tb = gla_tokbase(b, s);
        u32x4 vreg[2], kreg, qreg;
#pragma unroll
        for (int i = 0; i < 2; ++i) { const int idx = t + 512 * i; vreg[i] = *(const u32x4*)(Z + (size_t)(tb + (idx >> 4)) * ZLD + C_GV + h * 128 + (idx & 15) * 8); }
        { const int j = (t >> 3) & 63, ch = t & 7; const bf16_t* zp = Z + (size_t)(tb + j) * ZLD + h * 64 + ch * 8; kreg = *(const u32x4*)(zp + C_GK); qreg = *(const u32x4*)(zp + C_GQ); }
        gla_gates2(t, p, l, h, tb, B, gl, tot);
        unsigned char* qki = p.ws + WS_QKI + (size_t)item * 32768;
#pragma unroll
        for (int i = 0; i < 2; ++i) { const int idx = t + 512 * i; *(LAS u32x4*)(VB + att_voff(idx >> 4, idx & 15)) = vreg[i];
            const int dir = i, j = (t >> 3) & 63, ch = t & 7;
            const LAS float* bp = B + (dir * 64 + j) * GLD + ch * 8; const LAS float* tp = tot + (dir * 4) * 64 + ch * 8;
            const f32x4 b0 = *(const LAS f32x4*)bp, b1 = *(const LAS f32x4*)(bp + 4), t0 = *(const LAS f32x4*)tp, t1 = *(const LAS f32x4*)(tp + 4);
            float e[8], ei[8], et[8];
#pragma unroll
            for (int x = 0; x < 4; ++x) { e[x] = __expf(b0[x]); e[4 + x] = __expf(b1[x]); ei[x] = __builtin_amdgcn_rcpf(e[x]); ei[4 + x] = __builtin_amdgcn_rcpf(e[4 + x]); et[x] = __expf(t0[x]) * ei[x]; et[4 + x] = __expf(t1[x]) * ei[4 + x]; }
            const float kf[8] = {bflo(kreg.x), bfhi(kreg.x), bflo(kreg.y), bfhi(kreg.y), bflo(kreg.z), bfhi(kreg.z), bflo(kreg.w), bfhi(kreg.w)};
            const float qf[8] = {bflo(qreg.x), bfhi(qreg.x), bflo(qreg.y), bfhi(qreg.y), bflo(qreg.z), bfhi(qreg.z), bflo(qreg.w), bfhi(qreg.w)};
            u32x4 w, wq, wk;
            w.x = cvt_pk_bf16(kf[0] * et[0], kf[1] * et[1]); w.y = cvt_pk_bf16(kf[2] * et[2], kf[3] * et[3]); w.z = cvt_pk_bf16(kf[4] * et[4], kf[5] * et[5]); w.w = cvt_pk_bf16(kf[6] * et[6], kf[7] * et[7]);
            wq.x = cvt_pk_bf16(qf[0] * e[0], qf[1] * e[1]); wq.y = cvt_pk_bf16(qf[2] * e[2], qf[3] * e[3]); wq.z = cvt_pk_bf16(qf[4] * e[4], qf[5] * e[5]); wq.w = cvt_pk_bf16(qf[6] * e[6], qf[7] * e[7]);
            wk.x = cvt_pk_bf16(kf[0] * ei[0], kf[1] * ei[1]); wk.y = cvt_pk_bf16(kf[2] * ei[2], kf[3] * ei[3]); wk.z = cvt_pk_bf16(kf[4] * ei[4], kf[5] * ei[5]); wk.w = cvt_pk_bf16(kf[6] * ei[6], kf[7] * ei[7]);
            *(LAS u32x4*)(KH + dir * 8192 + gl_off128tr(j, ch)) = w;
            *(u32x4*)(qki + dir * 8192 + gl_offQ(j, ch)) = wq; *(u32x4*)(qki + 16384 + dir * 8192 + gl_offK(j, ch)) = wk; }
        if (t < 128) { const int dir = t >> 6, k = t & 63; DEC[(size_t)(((dir * 2 + b) * 260 + s) * 4 + h) * 64 + k] = __expf(tot[(dir * 4) * 64 + k]); }
        __syncthreads();
        { const int dir = wid >> 2, kt = wid & 3; const int phi = ((lg & 1) << 1) | ((vq >> 1) & 1);
            bf16x8 af[2];
#pragma unroll
            for (int jj = 0; jj < 2; ++jj) { s16x4 a0, a1;
                a0 = __builtin_amdgcn_ds_read_tr16_b64_v4i16((LAS s16x4*)(KH + dir * 8192 + (32 * jj + 8 * lg + vq) * 128 + ((2 * (kt ^ phi) + (vp >> 1)) << 4) + 8 * (vp & 1)));
                a1 = __builtin_amdgcn_ds_read_tr16_b64_v4i16((LAS s16x4*)(KH + dir * 8192 + (32 * jj + 8 * lg + 4 + vq) * 128 + ((2 * (kt ^ phi) + (vp >> 1)) << 4) + 8 * (vp & 1)));
                af[jj] = (bf16x8){a0[0], a0[1], a0[2], a0[3], a1[0], a1[1], a1[2], a1[3]}; }
            float* sp = ST + (size_t)(((dir * 2 + b) * 260 + s) * 4 + h) * 8192 + (16 * kt + 4 * lg) * 128 + l15;
#pragma unroll
            for (int vt = 0; vt < 8; ++vt) { f32x4 acc = {0.f, 0.f, 0.f, 0.f};
#pragma unroll
                for (int jj = 0; jj < 2; ++jj) { s16x4 v0, v1; const int r0 = 32 * jj + 8 * lg + vq, r1 = r0 + 4;
                    v0 = __builtin_amdgcn_ds_read_tr16_b64_v4i16((LAS s16x4*)(VB + att_voff(r0, 2 * vt + (vp >> 1)) + 8 * (vp & 1)));
                    v1 = __builtin_amdgcn_ds_read_tr16_b64_v4i16((LAS s16x4*)(VB + att_voff(r1, 2 * vt + (vp >> 1)) + 8 * (vp & 1)));
                    const bf16x8 vf = {v0[0], v0[1], v0[2], v0[3], v1[0], v1[1], v1[2], v1[3]};
                    acc = __builtin_amdgcn_mfma_f32_16x16x32_bf16(af[jj], vf, acc, 0, 0, 0); }
#pragma unroll
                for (int j = 0; j < 4; ++j) sp[j * 128 + 16 * vt] = acc[j]; }
        }
        __syncthreads();
    }
}
__device__ void gla_g3m(int tid_, int bid_, const P& p, int l, bool with_ctx, LAS unsigned char* lds) {
    LAS float* B = (LAS float*)(lds + GL_B); LAS float* gl = (LAS float*)(lds + GL_GL); LAS float* tot = (LAS float*)(lds + GL_TOT); LAS float* ssq = (LAS float*)(lds + GL_SSQ);
    LAS unsigned char* QT = lds + GL_QT; LAS unsigned char* KT = lds + GL_KT; LAS unsigned char* VB = lds + GL_V; LAS unsigned char* SB = lds + GL_S;
    const bf16_t* Z = (const bf16_t*)(p.ws + WS_H); const float* ST = (const float*)(p.ws + WS_ST); bf16_t* Y = (bf16_t*)(p.ws + WS_ABUF);
    const int t = tid_, lane = t & 63, wid = __builtin_amdgcn_readfirstlane(t >> 6), l15 = lane & 15, lg = lane >> 4, vq = l15 >> 2, vp = lane & 3;
    const int it = wid >> 1, vh = wid & 1;
    for (int item = bid_; item < 520 * 4; item += gridDim.x) {
        const int h = item & 3, cs = item >> 2, b = cs / 260, s = cs - b * 260; if (s < 4 && !with_ctx) continue;
        const int tb = gla_tokbase(b, s);
        u32x4 vreg[2], qk[4], sreg[4];
        const unsigned char* qki = p.ws + WS_QKI + (size_t)item * 32768;
#pragma unroll
        for (int i = 0; i < 2; ++i) { const int idx = t + 512 * i; vreg[i] = *(const u32x4*)(Z + (size_t)(tb + (idx >> 4)) * ZLD + C_GV + h * 128 + (idx & 15) * 8); }
#pragma unroll
        for (int i = 0; i < 4; ++i) { const int idx = t + 512 * i; qk[i] = *(const u32x4*)(qki + (size_t)idx * 16);
            const int dir = idx >> 10; sreg[i] = *(const u32x4*)(p.ws + WS_SBF + (size_t)(((dir * 2 + b) * 260 + s) * 4 + h) * 16384 + (size_t)(idx & 1023) * 16); }
#pragma unroll
        for (int i = 0; i < 2; ++i) { const int idx = t + 512 * i; *(LAS u32x4*)(VB + att_voff(idx >> 4, idx & 15)) = vreg[i]; }
#pragma unroll
        for (int i = 0; i < 4; ++i) { const int idx = t + 512 * i; *(LAS u32x4*)(QT + idx * 16) = qk[i]; *(LAS u32x4*)(SB + idx * 16) = sreg[i]; }
        __syncthreads();
        f32x4 O[4];
        {
            bf16x8 Qf[2][2];
#pragma unroll
            for (int dir = 0; dir < 2; ++dir)
#pragma unroll
                for (int kk = 0; kk < 2; ++kk) Qf[dir][kk] = *(const LAS bf16x8*)(QT + dir * 8192 + gl_offQ(16 * it + l15, 4 * kk + lg));
#pragma unroll
            for (int vt = 0; vt < 4; ++vt) O[vt] = (f32x4){0.f, 0.f, 0.f, 0.f};
            const int qi = 16 * it + l15;
#pragma unroll
            for (int jb = 0; jb < 2; ++jb) {
                f32x4 a[2];
#pragma unroll
                for (int jt = 0; jt < 2; ++jt) { f32x4 af = {0.f, 0.f, 0.f, 0.f}, ab = {0.f, 0.f, 0.f, 0.f}; const int row = 32 * jb + 8 * (l15 >> 2) + 4 * jt + (l15 & 3);
#pragma unroll
                    for (int kk = 0; kk < 2; ++kk) { const bf16x8 kf = *(const LAS bf16x8*)(KT + gl_offK(row, 4 * kk + lg)), kb = *(const LAS bf16x8*)(KT + 8192 + gl_offK(row, 4 * kk + lg));
                        af = __builtin_amdgcn_mfma_f32_16x16x32_bf16(kf, Qf[0][kk], af, 0, 0, 0); ab = __builtin_amdgcn_mfma_f32_16x16x32_bf16(kb, Qf[1][kk], ab, 0, 0, 0); }
#pragma unroll
                    for (int jx = 0; jx < 4; ++jx) { const int j = 32 * jb + 8 * lg + 4 * jt + jx; a[jt][jx] = (j <= qi ? af[jx] : 0.f) + (j >= qi ? ab[jx] : 0.f); } }
                u32x4 w; w.x = cvt_pk_bf16(a[0][0], a[0][1]); w.y = cvt_pk_bf16(a[0][2], a[0][3]); w.z = cvt_pk_bf16(a[1][0], a[1][1]); w.w = cvt_pk_bf16(a[1][2], a[1][3]);
                const bf16x8 pk = __builtin_bit_cast(bf16x8, w);
#pragma unroll
                for (int vt = 0; vt < 4; ++vt) { const int r0 = 32 * jb + 8 * lg + vq, cch = 2 * (4 * vh + vt) + (vp >> 1);
                    const s16x4 v0 = __builtin_amdgcn_ds_read_tr16_b64_v4i16((LAS s16x4*)(VB + att_voff(r0, cch) + 8 * (vp & 1)));
                    const s16x4 v1 = __builtin_amdgcn_ds_read_tr16_b64_v4i16((LAS s16x4*)(VB + att_voff(r0 + 4, cch) + 8 * (vp & 1)));
                    const bf16x8 vf = {v0[0], v0[1], v0[2], v0[3], v1[0], v1[1], v1[2], v1[3]};
                    O[vt] = __builtin_amdgcn_mfma_f32_16x16x32_bf16(vf, pk, O[vt], 0, 0, 0); }
            }
#pragma unroll
            for (int dir = 0; dir < 2; ++dir)
#pragma unroll
                for (int kk = 0; kk < 2; ++kk)
#pragma unroll
                    for (int vt = 0; vt < 4; ++vt) { const int r0 = 32 * kk + 8 * lg + vq, cch = 2 * (4 * vh + vt) + (vp >> 1);
                        const s16x4 s0 = __builtin_amdgcn_ds_read_tr16_b64_v4i16((LAS s16x4*)(SB + dir * 16384 + att_voff(r0, cch) + 8 * (vp & 1)));
                        const s16x4 s1 = __builtin_amdgcn_ds_read_tr16_b64_v4i16((LAS s16x4*)(SB + dir * 16384 + att_voff(r0 + 4, cch) + 8 * (vp & 1)));
                        const bf16x8 sf = {s0[0], s0[1], s0[2], s0[3], s1[0], s1[1], s1[2], s1[3]};
                        O[vt] = __builtin_amdgcn_mfma_f32_16x16x32_bf16(sf, Qf[dir][kk], O[vt], 0, 0, 0); }
        }
        float ss = 0.f;
#pragma unroll
        for (int vt = 0; vt < 4; ++vt) ss += O[vt][0] * O[vt][0] + O[vt][1] * O[vt][1] + O[vt][2] * O[vt][2] + O[vt][3] * O[vt][3];
        ss += __shfl_xor(ss, 16); ss += __shfl_xor(ss, 32);
        if (lg == 0) ssq[wid * 16 + l15] = ss;
        __syncthreads();
        { const float tot2 = ssq[(2 * it) * 16 + l15] + ssq[(2 * it + 1) * 16 + l15]; const float rstd = rsqrtf(tot2 * (1.f / 128.f) + 1e-6f);
            const int tok = tb + 16 * it + l15;
#pragma unroll
            for (int vt = 0; vt < 4; ++vt) { const int v0 = 64 * vh + 16 * vt + 4 * lg; const uint2 ru = *(const uint2*)(Z + (size_t)tok * ZLD + C_GR + h * 128 + v0); const f32x4 g4 = *(const f32x4*)(p.glag + l * 128 + v0);
                const float r0 = bflo(ru.x), r1 = bfhi(ru.x), r2 = bflo(ru.y), r3 = bfhi(ru.y);
                const float o0 = O[vt][0] * rstd * g4[0] * (r0 / (1.f + __expf(-r0))), o1 = O[vt][1] * rstd * g4[1] * (r1 / (1.f + __expf(-r1)));
                const float o2 = O[vt][2] * rstd * g4[2] * (r2 / (1.f + __expf(-r2))), o3 = O[vt][3] * rstd * g4[3] * (r3 / (1.f + __expf(-r3)));
                uint2 w; w.x = cvt_pk_bf16(o0, o1); w.y = cvt_pk_bf16(o2, o3); *(uint2*)(Y + (size_t)tok * DM + 512 + h * 128 + v0) = w; } }
        __syncthreads();
    }
}

constexpr int N_PHASES = 18;
#ifndef REP_G
#define REP_G 1
#endif
#ifndef REP_A
#define REP_A 1
#endif
#ifndef REP_N
#define REP_N 1
#endif
__device__ __forceinline__ void run_phase(int tid_, int bid_, const P& p, int ph, LAS unsigned char* lds) {
    if (ph == N_PHASES - 1) { phase_final(tid_, bid_, p); return; }
    if (ph == 9) { phase_ctxfix(tid_, bid_, p); return; }
    const int l = ph < 9 ? 0 : 1;
    const int sp = l == 0 ? (ph <= 6 ? ph - 1 : ph) : (ph <= 14 ? ph - 9 : ph - 8);
    const bool with_ctx = (l == 0);
    float* XC = (float*)(p.ws + WS_XC);
    const float* lat_src = l == 0 ? p.x : p.out; const float* ctx_src = l == 0 ? p.ctx : XC;
    bf16_t* wb = (bf16_t*)(p.ws + WS_W + (size_t)l * SZ_WL);
    bf16_t* ABUF = (bf16_t*)(p.ws + WS_ABUF); bf16_t* ABUF2 = (bf16_t*)(p.ws + WS_ABUF2); bf16_t* HB = (bf16_t*)(p.ws + WS_H);
    const float* MODA = (const float*)(p.ws + WS_MOD);
    const float* mod = MODA + (size_t)l * 3 * 12288;
    float* SSQ = (float*)(p.ws + WS_SSQ); const float* CV = (const float*)(p.ws + WS_CVEC) + (size_t)l * CV_L;
    const int Mres = with_ctx ? NTOK : NLAT;
    if (sp == 0) {
#pragma unroll 1
        for (int rep = 0; rep < REP_N; ++rep) { phase_norm(tid_, bid_, p, l, 1, lat_src, ctx_src, NTOK); }
        phase_cvec(tid_, bid_, p, lds);
        return; }
    if (sp == 2) {
#pragma unroll 1
        for (int rep = 0; rep < REP_G; ++rep) { gla_g1m(tid_, bid_, p, l, lds); }
#pragma unroll 1
        for (int rep = 0; rep < REP_A; ++rep) { attn_mfma(tid_, bid_, p, l, with_ctx, lds); }
        return; }
    if (sp == 3) { gla_scan(tid_, bid_, p); return; }
    if (sp == 4) {
#pragma unroll 1
        for (int rep = 0; rep < REP_G; ++rep) { gla_g3m(tid_, bid_, p, l, with_ctx, lds); }
        return; }
    pg8::Gemm g; EpiAny E{};
    E.ws = p.ws; E.out = p.out; E.l = l; E.ssq_idx = -1;
    if (sp == 1) { g = pg8::Gemm{ABUF, wb, NTOK, ZN, DM}; E.mode = 0; E.perm = true; if (l == 1) E.ssq_idx = 1; }
    else if (sp == 5) { g = pg8::Gemm{ABUF, wb + (size_t)ZN * DM, Mres, DM, DM}; E.mode = 2; E.perm = false;
        E.rlat = lat_src; E.rctx = ctx_src; E.gate_idx = 2; E.ntfull = DM / 64; E.aout_sel = 2; E.ng = p.n2g + l * DM; E.nsc_off = l * 3 * 12288 + 4 * DM; E.ssq_idx = (l == 0 ? 0 : 2); }
    else if (sp == 7) { g = pg8::Gemm{ABUF2, wb + (size_t)ZN * DM + (size_t)DM * DM, Mres, DFF, DM}; E.mode = 1; E.perm = true; E.ssq_idx = (l == 0 ? 0 : 2); }
    else { g = pg8::Gemm{HB, wb + (size_t)ZN * DM + (size_t)DM * DM + (size_t)DFF * DM, NLAT, DM, DFF}; E.mode = 2; E.perm = false;
        E.rlat = p.out; E.rctx = XC; E.gate_idx = 5; E.ntfull = DFF / 64; E.aout_sel = (l == 0 ? 1 : 0); E.ng = p.n1g + DM; E.nsc_off = 3 * 12288 + 1 * DM; E.ssq_idx = 1; }
    pg8::StaticOrder S; S.init(g.M, g.N, g.K, gridDim.x, bid_);
    if (sp == 8 && l == 0) { S.nsplit = 256; S.ks = 16; S.nt_split = 8; S.pm_split0 = 128; }
    pg8::gemm_phase(tid_, lds, g, S, E);
}

#define XB_TMO      128
#define XB_XCNT(j)  (256  + 64 * (j))
#define XB_XSUB(j)  (1280 + 64 * (j))
#define XB_XGEN(j)  (2304 + 64 * (j))
#define XB_TOP      3328
#define XB_TOPGEN   3392
#define XCD_BAR_WORDS 3456
#define XB_SPIN_CAP (1u << 18)
__device__ __forceinline__ unsigned xb_ld(unsigned* p)              { return __hip_atomic_load(p, __ATOMIC_RELAXED, __HIP_MEMORY_SCOPE_AGENT); }
__device__ __forceinline__ unsigned xb_add(unsigned* p, unsigned v) { return __hip_atomic_fetch_add(p, v, __ATOMIC_RELAXED, __HIP_MEMORY_SCOPE_AGENT); }
__device__ __forceinline__ unsigned xb_xcc_id() { return (unsigned)__builtin_amdgcn_s_getreg((3 << 11) | 20) & 0xFu; }
#define XB_SPIN(cond, bar) do { unsigned _sp = 0; while (cond) { __builtin_amdgcn_s_sleep(1); \
    if ((++_sp & 255u) == 0u) { if (xb_ld(&(bar)[XB_TMO])) break; if (_sp > XB_SPIN_CAP) { atomicAdd(&(bar)[XB_TMO], 1u); break; } } } } while (0)
struct XcdBarrier { unsigned* bar; unsigned x; volatile LAS unsigned* st; };
__device__ __forceinline__ XcdBarrier xcd_barrier_post(unsigned* bar, volatile LAS unsigned* st) {
    XcdBarrier b; b.bar = bar; b.x = xb_xcc_id(); b.st = st;
    if (threadIdx.x == 0) (void)xb_add(&bar[XB_XCNT(b.x)], 1u);
    return b;
}
__device__ __forceinline__ void xcd_barrier_complete(unsigned* bar, unsigned x, unsigned& nloc, unsigned& nx) {
    const unsigned G = gridDim.x * gridDim.y * gridDim.z;
    unsigned sum, cnt, mine, sp = 0u;
    for (;;) {
        sum = 0u; cnt = 0u; mine = 0u;
#pragma unroll
        for (unsigned j = 0; j < 16; ++j) { const unsigned c = xb_ld(&bar[XB_XCNT(j)]); sum += c; cnt += (c > 0u) ? 1u : 0u; mine = (j == x) ? c : mine; }
        if (sum == G) break;
        __builtin_amdgcn_s_sleep(1);
        if ((++sp & 255u) == 0u) { if (xb_ld(&bar[XB_TMO])) break; if (sp > XB_SPIN_CAP) { atomicAdd(&bar[XB_TMO], 1u); break; } }
    }
    nloc = mine > 0u ? mine : 1u; nx = cnt > 0u ? cnt : 1u;
}
__device__ __forceinline__ void xcd_barrier(const XcdBarrier& b) {
    asm volatile("s_waitcnt vmcnt(0)" ::: "memory");
    __syncthreads();
    if (threadIdx.x == 0) {
        unsigned* bar = b.bar;
        __builtin_amdgcn_s_waitcnt(0);
        unsigned nloc = b.st[0], nx = b.st[1];
        if (nloc == 0u) { xcd_barrier_complete(bar, b.x, nloc, nx); b.st[0] = nloc; b.st[1] = nx; }
        const unsigned old = xb_add(&bar[XB_XSUB(b.x)], 1u);
        const unsigned gen = old / nloc;
        if (old + 1u == (gen + 1u) * nloc) {
            __builtin_amdgcn_fence(__ATOMIC_RELEASE, "agent");
            asm volatile("s_waitcnt vmcnt(0)" ::: "memory");
            const unsigned og = xb_add(&bar[XB_TOP], 1u);
            const unsigned tg = og / nx;
            if (og + 1u == (tg + 1u) * nx) xb_add(&bar[XB_TOPGEN], 1u);
            else XB_SPIN(xb_ld(&bar[XB_TOPGEN]) == tg, bar);
            __builtin_amdgcn_fence(__ATOMIC_ACQUIRE, "agent");
            xb_add(&bar[XB_XGEN(b.x)], 1u);
            asm volatile("s_waitcnt vmcnt(0)" ::: "memory");
        } else {
            XB_SPIN(xb_ld(&bar[XB_XGEN(b.x)]) == gen, bar);
            __builtin_amdgcn_fence(__ATOMIC_ACQUIRE, "agent");
            asm volatile("s_waitcnt vmcnt(0)" ::: "memory");
        }
    }
    __syncthreads();
}

__global__ void __launch_bounds__(512, 2) mk_fwd(P p) {
    extern __shared__ __attribute__((aligned(16))) unsigned char shm[];
    LAS unsigned char* lds = (LAS unsigned char*)shm;
    cg::grid_group grid = cg::this_grid();
    volatile LAS unsigned* xst = (volatile LAS unsigned*)(lds + 131072);
    if (threadIdx.x == 0) { xst[0] = 0u; xst[1] = 0u; xst[2] = 0u; xst[3] = 0u; }
    __syncthreads();
    const XcdBarrier xb = xcd_barrier_post((unsigned*)(p.ws + WS_BAR), xst);
    int ph0 = (int)p.ph_lo;
    if (ph0 == 0) {
        int tid_ = threadIdx.x, bid_ = blockIdx.x;
        asm volatile("" : "+v"(tid_));
        asm volatile("" : "+s"(bid_));
        P q = p;
        { long zoff = 0; asm volatile("" : "+s"(zoff)); q.ws = p.ws + zoff; q.out = p.out + zoff; }
#pragma unroll 1
        for (int rep = 0; rep < REP_N; ++rep) { phase0(tid_, bid_, q, lds); __syncthreads(); }
        ph0 = 1;
        if (ph0 < (int)p.ph_hi) xcd_barrier(xb);
        if (p.ph_lo < 0) grid.sync();
    }
    for (int ph = ph0; ph < (int)p.ph_hi; ++ph) {
        int tid_ = threadIdx.x, bid_ = blockIdx.x;
        asm volatile("" : "+v"(tid_));
        asm volatile("" : "+s"(bid_));
        P q = p;
        { long zoff = 0; asm volatile("" : "+s"(zoff)); q.ws = p.ws + zoff; q.out = p.out + zoff; }
        run_phase(tid_, bid_, q, ph, lds);
        if (ph + 1 < (int)p.ph_hi) xcd_barrier(xb);
    }
}

#ifndef MK_MULTI
#define MK_MULTI 0
#endif
extern "C" void kernel_launch(void* const* d_in, const int* in_sizes, int n_in, void* d_out, int out_size, void* d_ws, size_t ws_size, hipStream_t stream) {
    static int grid = 0;
    if (grid == 0) {
        if (ws_size < WS_END) { fprintf(stderr, "kernel_launch: workspace too small: %zu < %zu\n", ws_size, (size_t)WS_END); grid = -1; return; }
        int dev = 0, cus = 0, per_cu = 0;
        hipGetDevice(&dev); hipDeviceGetAttribute(&cus, hipDeviceAttributeMultiprocessorCount, dev);
        if (hipFuncSetAttribute((const void*)mk_fwd, hipFuncAttributeMaxDynamicSharedMemorySize, LDS_BYTES) != hipSuccess) { fprintf(stderr, "kernel_launch: hipFuncSetAttribute failed\n"); grid = -1; return; }
        if (hipOccupancyMaxActiveBlocksPerMultiprocessor(&per_cu, (const void*)mk_fwd, 512, LDS_BYTES) != hipSuccess || per_cu < 1) { fprintf(stderr, "kernel_launch: occupancy query gave %d\n", per_cu); per_cu = 1; }
        (void)hipGetLastError();
        grid = cus * 1;
    }
    if (grid < 0) return;
    P p{};
    const float** pp = (const float**)&p;
    for (int i = 0; i < 20; ++i) pp[i] = (const float*)d_in[i];
    p.out = (float*)d_out; p.ws = (unsigned char*)d_ws;
#if MK_MULTI
    for (int ph = 0; ph < N_PHASES; ++ph) { p.ph_lo = ph; p.ph_hi = ph + 1; hipLaunchKernelGGL(mk_fwd, dim3(grid), dim3(512), LDS_BYTES, stream, p); }
#else
    p.ph_lo = 0; p.ph_hi = N_PHASES;
    if (hipMemsetAsync((char*)d_ws + WS_BAR, 0, 16384, stream) != hipSuccess) { fprintf(stderr, "kernel_launch: hipMemsetAsync failed\n"); return; }
    void* args[] = {&p};
    hipError_t e = hipLaunchCooperativeKernel((const void*)mk_fwd, dim3(grid), dim3(512), args, LDS_BYTES, stream);
    if (e != hipSuccess) fprintf(stderr, "cooperative launch failed: %s (grid %d)\n", hipGetErrorString(e), grid);
#endif
}
```

```cpp
#include <hip/hip_runtime.h>
#include <hip/hip_cooperative_groups.h>
#include <cstdio>
namespace cg = cooperative_groups;

#define LAS __attribute__((address_space(3)))
typedef unsigned short bf16_t;
typedef short bf16x8 __attribute__((ext_vector_type(8)));
typedef float f32x4 __attribute__((ext_vector_type(4)));
typedef unsigned u32x4 __attribute__((ext_vector_type(4)));

constexpr int DM = 2048, LSEQ = 16384, NLAT = 32768, NCTX = 512, NTOK = 33280, DFF = 8192;
constexpr int ZLD = 4640, ZN = 4864;
constexpr int C_NAQ = 0, C_NAK = 512, C_NAV = 1024, C_GQ = 1536, C_GK = 1792, C_GV = 2048, C_GR = 2560;
constexpr int C_SQ = 3072, C_SK = 4096, C_SV = 4352, C_GFL = 4608;
constexpr float LOG2E = 1.4426950408889634f;
constexpr float QSCALE = 0.08838834764831845f * 1.4426950408889634f;
constexpr int LDS_BYTES = 131072 + 16;

constexpr size_t SZ_WIN = (size_t)ZN * DM * 2, SZ_WOUT = (size_t)DM * DM * 2, SZ_WFF = (size_t)DFF * DM * 2;
constexpr size_t SZ_WL = SZ_WIN + SZ_WOUT + 2 * SZ_WFF;
constexpr size_t WS_W = 0;
constexpr size_t WS_ABUF = WS_W + 2 * SZ_WL;
constexpr size_t WS_H = WS_ABUF + (size_t)NTOK * DM * 2;
constexpr size_t SZ_Z = (size_t)NTOK * ZLD * 2;
constexpr size_t WS_ST = WS_H + SZ_Z;
constexpr size_t SZ_ST = (size_t)2 * 2 * 260 * 4 * 8192 * 4;
constexpr size_t WS_DEC = WS_ST + SZ_ST;
constexpr size_t SZ_DEC = (size_t)2 * 2 * 260 * 4 * 64 * 4;
constexpr size_t WS_XC = WS_H + (size_t)NTOK * DFF * 2;
constexpr size_t WS_MOD = WS_XC + (size_t)NCTX * DM * 4;
constexpr size_t WS_ROPE = WS_MOD + (size_t)2 * 3 * 12288 * 4;
constexpr size_t WS_ABUF2 = WS_ROPE + 2 * 256 * 32 * 4;
constexpr size_t WS_QKI = WS_ABUF2;
constexpr size_t WS_SBF = WS_ABUF2 + (size_t)2080 * 32768;
static_assert((size_t)2080 * 32768 * 2 <= (size_t)NTOK * DM * 2, "gla overlay");
constexpr size_t WS_SSQ = WS_ABUF2 + (size_t)NTOK * DM * 2;
constexpr size_t WS_CVEC = WS_SSQ + (size_t)3 * NTOK * 4;
constexpr int CV_L = 3 * (ZN + DFF);
constexpr size_t WS_BAR = WS_CVEC + (size_t)2 * CV_L * 4;
constexpr size_t WS_END = WS_BAR + 16384;
static_assert(WS_DEC + SZ_DEC <= WS_XC, "overlay");

struct P {
    const float *x, *c, *ctx, *c_ctx, *w_mod, *b_mod, *n1g, *n2g, *w_in, *rpb, *wgf, *bgf, *wgb, *bgb, *glag, *sink, *w_out, *w_ff1, *w_ff2, *fng;
    float* out;
    unsigned char* ws;
    long ph_lo, ph_hi;
};

__device__ __forceinline__ unsigned cvt_pk_bf16(float lo, float hi) { unsigned r; asm volatile("v_cvt_pk_bf16_f32 %0, %1, %2" : "=v"(r) : "v"(lo), "v"(hi)); return r; }
__device__ __forceinline__ float bf2f(bf16_t b) { return __uint_as_float(((unsigned)b) << 16); }
__device__ __forceinline__ float bflo(unsigned u) { return __uint_as_float(u << 16); }
__device__ __forceinline__ float bfhi(unsigned u) { return __uint_as_float(u & 0xffff0000u); }
__device__ __forceinline__ float wave_sum(float v) { for (int o = 32; o > 0; o >>= 1) v += __shfl_xor(v, o); return v; }
__device__ __forceinline__ float wave_max(float v) { for (int o = 32; o > 0; o >>= 1) v = fmaxf(v, __shfl_xor(v, o)); return v; }
__device__ __forceinline__ float dot8(u32x4 a, u32x4 b) {
    float s = bflo(a.x) * bflo(b.x); s += bfhi(a.x) * bfhi(b.x); s += bflo(a.y) * bflo(b.y); s += bfhi(a.y) * bfhi(b.y);
    s += bflo(a.z) * bflo(b.z); s += bfhi(a.z) * bfhi(b.z); s += bflo(a.w) * bflo(b.w); s += bfhi(a.w) * bfhi(b.w); return s;
}

namespace pg8 {
constexpr int BM = 256, BK = 64, HALF = 128, HTB = HALF * BK * 2, NXCD = 8, WGM = 8;
__device__ __forceinline__ int lds_byte(int r, int c) { const int st = (r >> 4) * 2 + (c >> 5), rr = r & 15, cc = c & 31, ob = rr * 64 + cc * 2; return st * 1024 + (ob ^ (((ob >> 9) & 1) << 5)); }
__device__ __forceinline__ void stage_rc(int b, int& R, int& C) { const int st = b / 1024, sb = b % 1024, swz = sb ^ (((sb >> 9) & 1) << 5); R = (st >> 1) * 16 + swz / 64; C = (st & 1) * 32 + (swz % 64) / 2; }
__device__ __forceinline__ int perm32(int rho) { const int n = rho >> 4, i = rho & 15; return 8 * (i >> 2) + 4 * n + (i & 3); }
struct Unit { int pm, pn, k0, nt; };
struct Gemm { const bf16_t* A; const bf16_t* Bt; int M, N, K; };
struct StaticOrder {
    int nM, nN, nwg, G, c;
    __device__ void init(int M, int N, int K, int G_, int c_) { nM = M / BM; nN = N / BM; nwg = nM * nN; G = G_; c = c_; ntfull = K / BK; nsplit = 0; ks = 1; nt_split = 0; pm_split0 = 0; }
    int ntfull, nsplit, ks, nt_split, pm_split0;
    __device__ __forceinline__ bool next(int i, Unit& u) const {
        const long L = (long)i * G + c;
        const bool full = L < nwg; const int sidx = (int)(L - nwg);
        if (!full && sidx >= nsplit) return false;
        int wgid = full ? (int)L : 0; { const int q = nwg / NXCD, r = nwg % NXCD, xcd = wgid % NXCD, off = wgid / NXCD; wgid = (xcd < r ? xcd * (q + 1) : r * (q + 1) + (xcd - r) * q) + off; }
        const int nig = WGM * nN, gid = wgid / nig, fm = gid * WGM, gsz = (nM - fm) < WGM ? (nM - fm) : WGM;
        const int fpm = fm + ((wgid % nig) % gsz), fpn = (wgid % nig) / gsz;
        const int tl = sidx / ks, spm = pm_split0 + tl / nN, spn = tl % nN, sk0 = (sidx % ks) * nt_split * BK;
        u.pm = full ? fpm : spm; u.pn = full ? fpn : spn; u.k0 = full ? 0 : sk0; u.nt = full ? ntfull : nt_split;
        return true;
    }
};

template <class Epi>
__device__ __forceinline__ void gemm_phase(int tid_, LAS unsigned char* lds, const Gemm g, const StaticOrder& S, const Epi& E) {
    const int tid = tid_, wid = __builtin_amdgcn_readfirstlane(tid >> 6), lane = tid & 63, wr = wid >> 2, wc = wid & 3, fr = lane & 15, fq = lane >> 4;
    const int K = g.K;
    unsigned voffA[2], voffB[2];
#pragma unroll
    for (int i = 0; i < 2; ++i) { int R, C; stage_rc(tid * 16 + i * 8192, R, C); const int Rb = E.perm ? ((R & ~31) + perm32(R & 31)) : R;
        voffA[i] = (unsigned)(R * K + C) * 2u; voffB[i] = (unsigned)(Rb * K + C) * 2u; }
    const size_t kstep = (size_t)(BK * 2);
    const size_t hstep = (size_t)HALF * K * 2;
    const size_t tstep = 2 * hstep;
    const unsigned ldsw = (unsigned)wid * 1024u;
    const int aoff = lds_byte(wr * 64 + fr, fq * 8), boff = lds_byte(wc * 32 + fr, fq * 8);
#define PG8_SA(b, h) (((b) * 2 + (h)) * HTB)
#define PG8_SB(b, h) ((4 + (b) * 2 + (h)) * HTB)
#define PG8_STAGE(bufoff, gbase, voff) do { _Pragma("unroll") for (int _i = 0; _i < 2; ++_i) \
        __builtin_amdgcn_global_load_lds((const unsigned*)((const char*)(gbase) + (voff)[_i]), (LAS unsigned*)(lds + (bufoff) + ldsw + _i * 8192), 16, 0, 0); } while (0)
#define PG8_LDA(dst, b, h) do { _Pragma("unroll") for (int m = 0; m < 4; ++m) _Pragma("unroll") for (int k = 0; k < 2; ++k) dst[m][k] = *(const LAS bf16x8*)(lds + PG8_SA(b, h) + aoff + m * 2048 + k * 1024); } while (0)
#define PG8_LDB(dst, b, h) do { _Pragma("unroll") for (int n = 0; n < 2; ++n) _Pragma("unroll") for (int k = 0; k < 2; ++k) dst[n][k] = *(const LAS bf16x8*)(lds + PG8_SB(b, h) + boff + n * 2048 + k * 1024); } while (0)
#define PG8_MMA(ai, bj, At, Bt) do { __builtin_amdgcn_s_setprio(1); _Pragma("unroll") for (int m = 0; m < 4; ++m) _Pragma("unroll") for (int n = 0; n < 2; ++n) _Pragma("unroll") for (int k = 0; k < 2; ++k) \
        acc[ai][bj][m][n] = __builtin_amdgcn_mfma_f32_16x16x32_bf16(Bt[n][k], At[m][k], acc[ai][bj][m][n], 0, 0, 0); __builtin_amdgcn_s_setprio(0); } while (0)
#define PG8_WAIT_V(n) asm volatile("s_waitcnt vmcnt(" #n ")" ::: "memory")
#define PG8_WAIT_L(n) asm volatile("s_waitcnt lgkmcnt(" #n ")" ::: "memory")
#define PG8_BAR __builtin_amdgcn_s_barrier()
#define PG8_SCHED __builtin_amdgcn_sched_barrier(0)
    Unit cur, nxt; int ui = 0;
    if (!S.next(0, cur)) return;
    f32x4 acc[2][2][4][2];
#pragma unroll
    for (int a = 0; a < 2; ++a)
#pragma unroll
        for (int b = 0; b < 2; ++b)
#pragma unroll
            for (int m = 0; m < 4; ++m)
#pragma unroll
                for (int n = 0; n < 2; ++n) acc[a][b][m][n] = (f32x4){0.f, 0.f, 0.f, 0.f};
    bf16x8 At[4][2], B0[2][2], B1[2][2];
    const char* cA = (const char*)g.A + (size_t)cur.pm * tstep + (size_t)cur.k0 * 2; const char* cB = (const char*)g.Bt + (size_t)cur.pn * tstep + (size_t)cur.k0 * 2;
    PG8_STAGE(PG8_SB(0, 0), cB, voffB); PG8_STAGE(PG8_SA(0, 0), cA, voffA); PG8_STAGE(PG8_SB(0, 1), cB + hstep, voffB); PG8_STAGE(PG8_SA(0, 1), cA + hstep, voffA);
    if (wr == 1) PG8_BAR;
    PG8_WAIT_V(4); PG8_BAR;
    PG8_STAGE(PG8_SB(1, 0), cB + kstep, voffB); PG8_STAGE(PG8_SA(1, 0), cA + kstep, voffA); PG8_STAGE(PG8_SB(1, 1), cB + hstep + kstep, voffB);
    PG8_WAIT_V(6); PG8_BAR;
    for (;;) {
        const bool has_next = S.next(ui + 1, nxt);
        const char* nA = has_next ? (const char*)g.A + (size_t)nxt.pm * tstep + (size_t)nxt.k0 * 2 : cA; const char* nB = has_next ? (const char*)g.Bt + (size_t)nxt.pn * tstep + (size_t)nxt.k0 * 2 : cB;
        const int nt = cur.nt;
        for (int t = 0; t < nt; t += 2) {
            const bool last = (t == nt - 2);
            const char* a1 = cA + (size_t)(t + 1) * kstep;
            const char* a2 = last ? nA : cA + (size_t)(t + 2) * kstep; const char* b2 = last ? nB : cB + (size_t)(t + 2) * kstep;
            const char* a3 = a2 + kstep; const char* b3 = b2 + kstep;
            PG8_LDB(B0, 0, 0); PG8_SCHED; PG8_LDA(At, 0, 0); PG8_STAGE(PG8_SA(1, 1), a1 + hstep, voffA);
            PG8_WAIT_L(8); PG8_BAR; PG8_WAIT_L(0); PG8_MMA(0, 0, At, B0); PG8_BAR; PG8_SCHED;
            PG8_LDB(B1, 0, 1); PG8_STAGE(PG8_SB(0, 0), b2, voffB);
            PG8_BAR; PG8_WAIT_L(0); PG8_MMA(0, 1, At, B1); PG8_BAR;
            PG8_LDA(At, 0, 1); PG8_STAGE(PG8_SA(0, 0), a2, voffA);
            PG8_BAR; PG8_WAIT_L(0); PG8_MMA(1, 0, At, B0); PG8_BAR; PG8_SCHED;
            PG8_STAGE(PG8_SB(0, 1), b2 + hstep, voffB);
            PG8_WAIT_V(6); PG8_BAR; PG8_MMA(1, 1, At, B1); PG8_BAR;
            PG8_LDB(B0, 1, 0); PG8_SCHED; PG8_LDA(At, 1, 0); PG8_STAGE(PG8_SA(0, 1), a2 + hstep, voffA);
            PG8_WAIT_L(8); PG8_BAR; PG8_WAIT_L(0); PG8_MMA(0, 0, At, B0); PG8_BAR; PG8_SCHED;
            PG8_LDB(B1, 1, 1); PG8_STAGE(PG8_SB(1, 0), b3, voffB);
            PG8_BAR; PG8_WAIT_L(0); PG8_MMA(0, 1, At, B1); PG8_BAR;
            PG8_LDA(At, 1, 1); PG8_STAGE(PG8_SA(1, 0), a3, voffA);
            PG8_BAR; PG8_WAIT_L(0); PG8_MMA(1, 0, At, B0); PG8_BAR; PG8_SCHED;
            PG8_STAGE(PG8_SB(1, 1), b3 + hstep, voffB);
            PG8_WAIT_V(6); PG8_BAR; PG8_MMA(1, 1, At, B1); PG8_BAR;
        }
        E(acc, cur, wr, wc, fr, fq);
        if (!has_next) break;
#pragma unroll
        for (int a = 0; a < 2; ++a)
#pragma unroll
            for (int b = 0; b < 2; ++b)
#pragma unroll
                for (int m = 0; m < 4; ++m)
#pragma unroll
                    for (int n = 0; n < 2; ++n) acc[a][b][m][n] = (f32x4){0.f, 0.f, 0.f, 0.f};
        cur = nxt; cA = nA; cB = nB; ++ui;
    }
    PG8_WAIT_V(0);
    if (wr == 0) PG8_BAR;
    PG8_BAR;
#undef PG8_SA
#undef PG8_SB
#undef PG8_STAGE
#undef PG8_LDA
#undef PG8_LDB
#undef PG8_MMA
#undef PG8_WAIT_V
#undef PG8_WAIT_L
#undef PG8_BAR
#undef PG8_SCHED
}
}

struct EpiIn {
    static constexpr bool PERM = true;
    bf16_t* Z; const float* rcos; const float* rsin; const float* ssq; const float* cvec;
    __device__ __forceinline__ void operator()(const f32x4 (&acc)[2][2][4][2], const pg8::Unit& u, int wr, int wc, int fr, int fq) const {
        const int row0 = u.pm * 256 + wr * 64 + fr, col0 = u.pn * 256 + wc * 32 + 8 * fq;
        const bool rope = (u.pn >= 12) && (u.pn <= 16) && (u.pm < 128);
        const int modsel = u.pm < 64 ? 0 : (u.pm < 128 ? 1 : 2);
        f32x4 cv[2][2];
#pragma unroll
        for (int bj = 0; bj < 2; ++bj) { cv[bj][0] = (f32x4){0.f, 0.f, 0.f, 0.f}; cv[bj][1] = (f32x4){0.f, 0.f, 0.f, 0.f};
            if (ssq) { cv[bj][0] = *(const f32x4*)(cvec + modsel * ZN + col0 + bj * 128); cv[bj][1] = *(const f32x4*)(cvec + modsel * ZN + col0 + bj * 128 + 4); } }
#pragma unroll
        for (int ai = 0; ai < 2; ++ai)
#pragma unroll
            for (int m = 0; m < 4; ++m) {
                const int row = row0 + ai * 128 + m * 16;
                const float rs = ssq ? rsqrtf(ssq[row] * (1.f / DM) + 1e-6f) : 1.f;
                f32x4 cs = {1.f, 1.f, 1.f, 1.f}, sn = {0.f, 0.f, 0.f, 0.f};
                if (rope) { const int tok = row & (LSEQ - 1); const int pos = (wc < 2) ? (tok >> 6) : (tok & 63); const int f0 = 16 * (wc & 1) + 4 * fq;
                    cs = *(const f32x4*)(rcos + pos * 32 + f0); sn = *(const f32x4*)(rsin + pos * 32 + f0); }
#pragma unroll
                for (int bj = 0; bj < 2; ++bj) {
                    const int c = col0 + bj * 128;
                    if (c < ZLD) {
                        f32x4 v0 = acc[ai][bj][m][0] * rs + cv[bj][0], v1 = acc[ai][bj][m][1] * rs + cv[bj][1];
                        if (rope) { const f32x4 n0 = v0 * cs - v1 * sn, n1 = v1 * cs + v0 * sn; v0 = n0; v1 = n1; }
                        u32x4 w; w.x = cvt_pk_bf16(v0[0], v0[1]); w.y = cvt_pk_bf16(v0[2], v0[3]); w.z = cvt_pk_bf16(v1[0], v1[1]); w.w = cvt_pk_bf16(v1[2], v1[3]);
                        *(u32x4*)(Z + (size_t)row * ZLD + c) = w;
                    }
                }
            }
    }
};
struct EpiSq {
    static constexpr bool PERM = true;
    bf16_t* O; int ldc; const float* ssq; const float* cvec;
    __device__ __forceinline__ void operator()(const f32x4 (&acc)[2][2][4][2], const pg8::Unit& u, int wr, int wc, int fr, int fq) const {
        const int row0 = u.pm * 256 + wr * 64 + fr, col0 = u.pn * 256 + wc * 32 + 8 * fq;
        const int modsel = u.pm < 64 ? 0 : (u.pm < 128 ? 1 : 2);
        f32x4 cv[2][2];
#pragma unroll
        for (int bj = 0; bj < 2; ++bj) { cv[bj][0] = *(const f32x4*)(cvec + modsel * DFF + col0 + bj * 128); cv[bj][1] = *(const f32x4*)(cvec + modsel * DFF + col0 + bj * 128 + 4); }
#pragma unroll
        for (int ai = 0; ai < 2; ++ai)
#pragma unroll
            for (int m = 0; m < 4; ++m) { const int row = row0 + ai * 128 + m * 16; bf16_t* rowp = O + (size_t)row * ldc + col0;
                const float rs = rsqrtf(ssq[row] * (1.f / DM) + 1e-6f);
#pragma unroll
                for (int bj = 0; bj < 2; ++bj) { f32x4 v0 = acc[ai][bj][m][0] * rs + cv[bj][0], v1 = acc[ai][bj][m][1] * rs + cv[bj][1];
#pragma unroll
                    for (int j = 0; j < 4; ++j) { float a = fmaxf(v0[j], 0.f), b = fmaxf(v1[j], 0.f); v0[j] = a * a; v1[j] = b * b; }
                    u32x4 w; w.x = cvt_pk_bf16(v0[0], v0[1]); w.y = cvt_pk_bf16(v0[2], v0[3]); w.z = cvt_pk_bf16(v1[0], v1[1]); w.w = cvt_pk_bf16(v1[2], v1[3]);
                    *(u32x4*)(rowp + bj * 128) = w; } }
    }
};
struct EpiRes {
    static constexpr bool PERM = true;
    const float* lat_res; const float* ctx_res; float* lat_out; float* ctx_out; const float* gate;
    float* part; int ntfull;
    bf16_t* aout; const float* ng; const float* nsc; float* ssq;
    __device__ __forceinline__ void operator()(const f32x4 (&acc)[2][2][4][2], const pg8::Unit& u, int wr, int wc, int fr, int fq) const {
        const int row0 = u.pm * 256 + wr * 64 + fr, col0 = u.pn * 256 + wc * 32 + 8 * fq;
        if (u.nt != ntfull) {
            float* pp = part + (size_t)(u.k0 / (u.nt * 64)) * NCTX * DM;
#pragma unroll
            for (int ai = 0; ai < 2; ++ai)
#pragma unroll
                for (int m = 0; m < 4; ++m) { float* op = pp + (size_t)(row0 + ai * 128 + m * 16 - NLAT) * DM;
#pragma unroll
                    for (int bj = 0; bj < 2; ++bj)
#pragma unroll
                        for (int n = 0; n < 2; ++n) *(f32x4*)(op + col0 + bj * 128 + n * 4) = acc[ai][bj][m][n]; }
            return;
        }
        const int modsel = u.pm < 64 ? 0 : (u.pm < 128 ? 1 : 2);
        f32x4 gv[2][2];
#pragma unroll
        for (int bj = 0; bj < 2; ++bj)
#pragma unroll
            for (int n = 0; n < 2; ++n) gv[bj][n] = *(const f32x4*)(gate + modsel * 12288 + col0 + bj * 128 + n * 4);
        f32x4 gm[2][2];
        if (aout) {
#pragma unroll
            for (int bj = 0; bj < 2; ++bj)
#pragma unroll
                for (int n = 0; n < 2; ++n) { const int c = col0 + bj * 128 + n * 4; gm[bj][n] = *(const f32x4*)(ng + c) * (*(const f32x4*)(nsc + modsel * 12288 + c) + 1.f); }
        }
#pragma unroll
        for (int ai = 0; ai < 2; ++ai)
#pragma unroll
            for (int m = 0; m < 4; ++m) {
                const int row = row0 + ai * 128 + m * 16;
                const float* rp; float* op;
                if (row < NLAT) { rp = lat_res + (size_t)row * DM; op = lat_out + (size_t)row * DM; } else { rp = ctx_res + (size_t)(row - NLAT) * DM; op = ctx_out + (size_t)(row - NLAT) * DM; }
                float ss = 0.f;
#pragma unroll
                for (int bj = 0; bj < 2; ++bj) { const int c = col0 + bj * 128;
                    const f32x4 o0 = *(const f32x4*)(rp + c) + gv[bj][0] * acc[ai][bj][m][0], o1 = *(const f32x4*)(rp + c + 4) + gv[bj][1] * acc[ai][bj][m][1];
                    *(f32x4*)(op + c) = o0; *(f32x4*)(op + c + 4) = o1;
                    if (aout) { ss += o0[0] * o0[0] + o0[1] * o0[1] + o0[2] * o0[2] + o0[3] * o0[3] + o1[0] * o1[0] + o1[1] * o1[1] + o1[2] * o1[2] + o1[3] * o1[3];
                        const f32x4 a0 = o0 * gm[bj][0], a1 = o1 * gm[bj][1];
                        u32x4 w; w.x = cvt_pk_bf16(a0[0], a0[1]); w.y = cvt_pk_bf16(a0[2], a0[3]); w.z = cvt_pk_bf16(a1[0], a1[1]); w.w = cvt_pk_bf16(a1[2], a1[3]);
                        *(u32x4*)(aout + (size_t)row * DM + c) = w; } }
                if (aout) { ss += __shfl_xor(ss, 16); ss += __shfl_xor(ss, 32); if (fq == 0) atomicAdd(ssq + row, ss); }
                __builtin_amdgcn_sched_barrier(0);
            }
    }
};

struct EpiAny {
    unsigned char* ws; float* out; const float* rlat; const float* rctx; const float* ng;
    int mode, l, ssq_idx, gate_idx, aout_sel, nsc_off, ntfull; bool perm;
    __device__ __forceinline__ void operator()(const f32x4 (&acc)[2][2][4][2], const pg8::Unit& u, int wr, int wc, int fr, int fq) const {
        const float* rope = (const float*)(ws + WS_ROPE); const float* CV = (const float*)(ws + WS_CVEC) + (size_t)l * CV_L;
        float* SSQ = (float*)(ws + WS_SSQ); const float* MODA = (const float*)(ws + WS_MOD);
        if (mode == 0) { const EpiIn e{(bf16_t*)(ws + WS_H), rope, rope + 8192, ssq_idx >= 0 ? SSQ + (size_t)ssq_idx * NTOK : nullptr, CV}; e(acc, u, wr, wc, fr, fq); }
        else if (mode == 1) { const EpiSq e{(bf16_t*)(ws + WS_H), DFF, SSQ + (size_t)ssq_idx * NTOK, CV + 3 * ZN}; e(acc, u, wr, wc, fr, fq); }
        else { const EpiRes e{rlat, rctx, out, (float*)(ws + WS_XC), MODA + (size_t)l * 3 * 12288 + gate_idx * DM, (float*)(ws + WS_ABUF2), ntfull,
                              aout_sel == 0 ? nullptr : (bf16_t*)(ws + (aout_sel == 1 ? WS_ABUF : WS_ABUF2)), ng, MODA + nsc_off, SSQ + (size_t)ssq_idx * NTOK}; e(acc, u, wr, wc, fr, fq); }
    }
};

__device__ __forceinline__ void map_col_in(int n, int& src, float& scale) {
    if (n < 3072) { src = n; scale = (n < 512) ? QSCALE : ((n >= 1536 && n < 1792) ? 0.125f : 1.f); }
    else if (n < 4352) { const bool isq = n < 4096; const int base = isq ? 3072 : 4096, sbase = isq ? 3104 : 4128; const int hh = (n - base) >> 7, pp = (n - base) & 127;
        const int i = 4 * (pp >> 3) + (pp & 3), half = (pp >> 2) & 1; const int od = (i < 32 ? i : i + 32) + 32 * half; src = sbase + hh * 128 + od; scale = isq ? QSCALE : 1.f; }
    else if (n < 4608) { src = 4384 + (n - 4352); scale = 1.f; }
    else if (n < 4640) { src = 3072 + (n - 4608); scale = 1.f; }
    else { src = -1; scale = 0.f; }
}
__device__ void conv_tile(int tid_, int bid_, const float* __restrict__ w, int Nsrc, int K, bf16_t* __restrict__ Bt, int n0, int k0, int mode, LAS float* tile) {
    const int t = tid_;
    { const int n = t & 127, kq = t >> 7; int src = n0 + n; float scale = 1.f; if (mode) map_col_in(n0 + n, src, scale);
        float v[32];
#pragma unroll
        for (int i = 0; i < 32; ++i) v[i] = (src >= 0) ? w[(size_t)(k0 + kq + 4 * i) * Nsrc + src] : 0.f;
#pragma unroll
        for (int i = 0; i < 32; ++i) tile[(kq + 4 * i) * 129 + n] = v[i] * scale; }
    __syncthreads();
    { const int n2 = t >> 2, kc = t & 3;
#pragma unroll
        for (int u = 0; u < 4; ++u) { float v[8];
#pragma unroll
            for (int j = 0; j < 8; ++j) v[j] = tile[(32 * kc + 8 * u + j) * 129 + n2];
            u32x4 pk; pk.x = cvt_pk_bf16(v[0], v[1]); pk.y = cvt_pk_bf16(v[2], v[3]); pk.z = cvt_pk_bf16(v[4], v[5]); pk.w = cvt_pk_bf16(v[6], v[7]);
            *(u32x4*)(Bt + (size_t)(n0 + n2) * K + k0 + 32 * kc + 8 * u) = pk; } }
    __syncthreads();
}
__device__ void phase0(int tid_, int bid_, const P& p, LAS unsigned char* lds) {
    LAS float* tile = (LAS float*)lds;
    LAS float* act = (LAS float*)(lds + 66560);
    LAS float* red = (LAS float*)(lds + 66560 + 24576);
    const int t = tid_;
    for (int i = t; i < 3 * 2048; i += 512) { const int v = i >> 11, k = i & 2047; const float xv = v < 2 ? p.c[v * 2048 + k] : p.c_ctx[k]; act[i] = xv / (1.f + __expf(-xv)); }
    { const int idx = bid_ * 512 + t; if (idx < 8192) { const int pos = idx >> 5, f = idx & 31; const double inv = pow(10000.0, -(double)f / 32.0); const double a = (double)pos * inv;
            float* rc = (float*)(p.ws + WS_ROPE); rc[idx] = (float)cos(a); rc[8192 + idx] = (float)sin(a); } }
    { float* sq = (float*)(p.ws + WS_SSQ); for (int i = bid_ * 512 + t; i < 3 * NTOK; i += gridDim.x * 512) sq[i] = 0.f; }
    __syncthreads();
    const int NGEMV = 768, NCONV = 2912;
    for (int it = bid_; it < NGEMV + 2 * NCONV; it += gridDim.x) {
        if (it < NGEMV) {
            const int l = it / 384, c0 = (it % 384) * 32; const int cq = t & 7, kg = t >> 3;
            float a0[4] = {0, 0, 0, 0}, a1[4] = {0, 0, 0, 0}, a2[4] = {0, 0, 0, 0};
            const float* wp = p.w_mod + (size_t)l * 2048 * 12288 + c0 + 4 * cq;
#pragma unroll 8
            for (int kk = 0; kk < 32; ++kk) { const int k = kg * 32 + kk; const f32x4 w4 = *(const f32x4*)(wp + (size_t)k * 12288); const float x0 = act[k], x1 = act[2048 + k], x2 = act[4096 + k];
#pragma unroll
                for (int j = 0; j < 4; ++j) { a0[j] += x0 * w4[j]; a1[j] += x1 * w4[j]; a2[j] += x2 * w4[j]; } }
#pragma unroll
            for (int j = 0; j < 4; ++j) { red[(kg * 3 + 0) * 32 + 4 * cq + j] = a0[j]; red[(kg * 3 + 1) * 32 + 4 * cq + j] = a1[j]; red[(kg * 3 + 2) * 32 + 4 * cq + j] = a2[j]; }
            __syncthreads();
            if (t < 96) { const int v = t >> 5, cc = t & 31; float s = 0.f; for (int g = 0; g < 64; ++g) s += red[(g * 3 + v) * 32 + cc];
                ((float*)(p.ws + WS_MOD))[(size_t)(l * 3 + v) * 12288 + c0 + cc] = s + p.b_mod[l * 12288 + c0 + cc]; }
            __syncthreads();
        } else {
            int r = it - NGEMV; const int l = r / NCONV; r -= l * NCONV;
            bf16_t* wb = (bf16_t*)(p.ws + WS_W + (size_t)l * SZ_WL);
            if (r < 608) { conv_tile(tid_, bid_, p.w_in + (size_t)l * DM * ZLD, ZLD, DM, wb, (r / 16) * 128, (r % 16) * 128, 1, tile); }
            else if (r < 864) { r -= 608; conv_tile(tid_, bid_, p.w_out + (size_t)l * DM * DM, DM, DM, wb + (size_t)ZN * DM, (r / 16) * 128, (r % 16) * 128, 0, tile); }
            else if (r < 1888) { r -= 864; conv_tile(tid_, bid_, p.w_ff1 + (size_t)l * DM * DFF, DFF, DM, wb + (size_t)ZN * DM + (size_t)DM * DM, (r / 16) * 128, (r % 16) * 128, 0, tile); }
            else { r -= 1888; conv_tile(tid_, bid_, p.w_ff2 + (size_t)l * DFF * DM, DM, DFF, wb + (size_t)ZN * DM + (size_t)DM * DM + (size_t)DFF * DM, (r / 64) * 128, (r % 64) * 128, 0, tile); }
        }
    }
}

__device__ void phase_norm(int tid_, int bid_, const P& p, int l, int which, const float* lat_src, const float* ctx_src, int nrows) {
    const int lane = tid_ & 63, wid = tid_ >> 6;
    bf16_t* A = (bf16_t*)(p.ws + WS_ABUF);
    const float* g = (which == 1 ? p.n1g : p.n2g) + l * DM;
    const float* mod = (const float*)(p.ws + WS_MOD) + (size_t)l * 3 * 12288;
    for (int row = bid_ * 8 + wid; row < nrows; row += gridDim.x * 8) {
        const float* xr = row < NLAT ? lat_src + (size_t)row * DM : ctx_src + (size_t)(row - NLAT) * DM;
        f32x4 v[8]; float ss = 0.f;
#pragma unroll
        for (int i = 0; i < 8; ++i) { v[i] = ((const f32x4*)xr)[lane + 64 * i]; ss += v[i][0] * v[i][0] + v[i][1] * v[i][1] + v[i][2] * v[i][2] + v[i][3] * v[i][3]; }
        ss = wave_sum(ss);
        const float rstd = rsqrtf(ss * (1.f / DM) + 1e-6f);
        const int modsel = row < LSEQ ? 0 : (row < NLAT ? 1 : 2);
        const float* sh = mod + modsel * 12288 + (which == 1 ? 0 : 3) * DM; const float* sc = sh + DM;
#pragma unroll
        for (int i = 0; i < 8; ++i) { const int c = 4 * (lane + 64 * i); const f32x4 g4 = *(const f32x4*)(g + c), s4 = *(const f32x4*)(sh + c), c4 = *(const f32x4*)(sc + c);
            float o[4];
#pragma unroll
            for (int j = 0; j < 4; ++j) o[j] = v[i][j] * rstd * g4[j] * (1.f + c4[j]) + s4[j];
            uint2 w; w.x = cvt_pk_bf16(o[0], o[1]); w.y = cvt_pk_bf16(o[2], o[3]); *(uint2*)(A + (size_t)row * DM + c) = w; }
    }
}
__device__ void phase_cvec(int tid_, int bid_, const P& p, LAS unsigned char* lds) {
    const int lane = tid_ & 63, wid = tid_ >> 6;
    LAS float* shv = (LAS float*)lds;
    const float* MOD = (const float*)(p.ws + WS_MOD);
    for (int i = tid_; i < 9 * 2048; i += 512) { const int set = i / 6144, r = i - set * 6144, v = r >> 11, k = r & 2047; const int l = set == 0 ? 0 : 1, idx = set == 1 ? 0 : 3;
        shv[i] = MOD[(size_t)(l * 3 + v) * 12288 + idx * 2048 + k]; }
    __syncthreads();
    float* CV = (float*)(p.ws + WS_CVEC);
    const int NR = DFF + ZN + DFF;
    for (int rr = bid_ * 8 + wid; rr < NR; rr += gridDim.x * 8) {
        int set, n, l, ncols; const bf16_t* wrow; float* outp;
        const bf16_t* wb0 = (const bf16_t*)(p.ws + WS_W); const bf16_t* wb1 = (const bf16_t*)(p.ws + WS_W + SZ_WL);
        if (rr < DFF) { set = 0; n = rr; l = 0; wrow = wb0 + (size_t)ZN * DM + (size_t)DM * DM + (size_t)n * DM; outp = CV + 3 * ZN + n; ncols = DFF; }
        else if (rr < DFF + ZN) { set = 1; n = rr - DFF; l = 1; wrow = wb1 + (size_t)n * DM; outp = CV + CV_L + n; ncols = ZN; }
        else { set = 2; n = rr - DFF - ZN; l = 1; wrow = wb1 + (size_t)ZN * DM + (size_t)DM * DM + (size_t)n * DM; outp = CV + CV_L + 3 * ZN + n; ncols = DFF; }
        float a0 = 0.f, a1 = 0.f, a2 = 0.f;
#pragma unroll
        for (int i = 0; i < 4; ++i) { const int k0 = lane * 8 + 512 * i; const u32x4 w = *(const u32x4*)(wrow + k0);
            const float wf[8] = {bflo(w.x), bfhi(w.x), bflo(w.y), bfhi(w.y), bflo(w.z), bfhi(w.z), bflo(w.w), bfhi(w.w)};
            const LAS float* s0 = shv + set * 6144 + k0;
#pragma unroll
            for (int j = 0; j < 8; ++j) { a0 += wf[j] * s0[j]; a1 += wf[j] * s0[2048 + j]; a2 += wf[j] * s0[4096 + j]; } }
        a0 = wave_sum(a0); a1 = wave_sum(a1); a2 = wave_sum(a2);
        if (lane == 0) { outp[0] = a0; outp[ncols] = a1; outp[2 * ncols] = a2; }
    }
}
__device__ void phase_ctxfix(int tid_, int bid_, const P& p) {
    const int lane = tid_ & 63, wid = tid_ >> 6;
    float* XC = (float*)(p.ws + WS_XC); const float* PART = (const float*)(p.ws + WS_ABUF2); bf16_t* A = (bf16_t*)(p.ws + WS_ABUF); float* SSQ = (float*)(p.ws + WS_SSQ) + NTOK;
    const float* MOD = (const float*)(p.ws + WS_MOD);
    const float* ga2 = MOD + (size_t)2 * 12288 + 5 * DM;
    const float* sc1 = MOD + (size_t)(3 + 2) * 12288 + 1 * DM;
    const float* g1 = p.n1g + DM;
    for (int idx = bid_ * 8 + wid; idx < NCTX * 4; idx += gridDim.x * 8) {
        const int r = idx >> 2, c0 = (idx & 3) * 512 + lane * 8;
        f32x4 s0 = {0.f, 0.f, 0.f, 0.f}, s1 = {0.f, 0.f, 0.f, 0.f};
#pragma unroll
        for (int sl = 0; sl < 16; ++sl) { const float* pp = PART + ((size_t)sl * NCTX + r) * DM + c0; s0 += *(const f32x4*)pp; s1 += *(const f32x4*)(pp + 4); }
        float* xp = XC + (size_t)r * DM + c0;
        const f32x4 x0 = *(const f32x4*)xp + *(const f32x4*)(ga2 + c0) * s0, x1 = *(const f32x4*)(xp + 4) + *(const f32x4*)(ga2 + c0 + 4) * s1;
        *(f32x4*)xp = x0; *(f32x4*)(xp + 4) = x1;
        float ss = x0[0] * x0[0] + x0[1] * x0[1] + x0[2] * x0[2] + x0[3] * x0[3] + x1[0] * x1[0] + x1[1] * x1[1] + x1[2] * x1[2] + x1[3] * x1[3];
        const f32x4 a0 = x0 * (*(const f32x4*)(g1 + c0)) * (*(const f32x4*)(sc1 + c0) + 1.f), a1 = x1 * (*(const f32x4*)(g1 + c0 + 4)) * (*(const f32x4*)(sc1 + c0 + 4) + 1.f);
        u32x4 w; w.x = cvt_pk_bf16(a0[0], a0[1]); w.y = cvt_pk_bf16(a0[2], a0[3]); w.z = cvt_pk_bf16(a1[0], a1[1]); w.w = cvt_pk_bf16(a1[2], a1[3]);
        *(u32x4*)(A + (size_t)(NLAT + r) * DM + c0) = w;
        ss = wave_sum(ss); if (lane == 0) atomicAdd(SSQ + NLAT + r, ss);
    }
}
__device__ void phase_final(int tid_, int bid_, const P& p) {
    const int lane = tid_ & 63, wid = tid_ >> 6;
    for (int row = bid_ * 8 + wid; row < NLAT; row += gridDim.x * 8) {
        float* xr = p.out + (size_t)row * DM;
        f32x4 v[8]; float ss = 0.f;
#pragma unroll
        for (int i = 0; i < 8; ++i) { v[i] = ((const f32x4*)xr)[lane + 64 * i]; ss += v[i][0] * v[i][0] + v[i][1] * v[i][1] + v[i][2] * v[i][2] + v[i][3] * v[i][3]; }
        ss = wave_sum(ss);
        const float rstd = rsqrtf(ss * (1.f / DM) + 1e-6f);
#pragma unroll
        for (int i = 0; i < 8; ++i) { const int c = 4 * (lane + 64 * i); const f32x4 g4 = *(const f32x4*)(p.fng + c); ((f32x4*)xr)[lane + 64 * i] = v[i] * rstd * g4; }
    }
}

__device__ void attn_simple(int tid_, int bid_, const P& p, int l, bool with_ctx, LAS unsigned char* lds) {
    const int lane = tid_ & 63, wid = tid_ >> 6;
    const bf16_t* Z = (const bf16_t*)(p.ws + WS_H);
    bf16_t* Y = (bf16_t*)(p.ws + WS_ABUF);
    LAS float* sc = (LAS float*)lds + wid * 576;
    const int nq_lat = NLAT * 12; const int nq = nq_lat + (with_ctx ? NCTX * 12 : 0);
    const int gw = bid_ * 8 + wid, nw = gridDim.x * 8;
    for (int it = gw; it < nq; it += nw) {
        int tok, hs; bool isctx;
        if (it < nq_lat) { tok = it / 12; hs = it - tok * 12; isctx = false; } else { const int r = it - nq_lat; tok = NLAT + r / 12; hs = r % 12; isctx = true; }
        const int b = isctx ? ((tok - NLAT) >> 8) : (tok >> 14);
        const bool na = hs < 4;
        int qcol, kcol, vcol, ycol;
        if (na) { qcol = C_NAQ + hs * 128; kcol = C_NAK + hs * 128; vcol = C_NAV + hs * 128; ycol = hs * 128; }
        else { const int h = hs - 4; qcol = C_SQ + h * 128; kcol = C_SK + (h >> 2) * 128; vcol = C_SV + (h >> 2) * 128; ycol = 1024 + h * 128; }
        int nloc = 0, lo = 0, rs = 0, cs = 0, r = 0, cpos = 0;
        if (!isctx) { const int t = tok & (LSEQ - 1);
            if (na) { r = t >> 6; cpos = t & 63; rs = min(max(r - 4, 0), 248); cs = min(max(cpos - 8, 0), 48); nloc = 128; }
            else { lo = max(t - 128, 0); const int hi = min(t + 128, LSEQ - 1); nloc = hi - lo + 1; } }
        const int nk = nloc + 256; const int ctxbase = NLAT + b * 256, latbase = b * LSEQ;
        u32x4 q[16]; { const u32x4* qp = (const u32x4*)(Z + (size_t)tok * ZLD + qcol);
#pragma unroll
            for (int i = 0; i < 16; ++i) q[i] = qp[i]; }
        const float* rp = p.rpb + (size_t)l * 4 * 465 + (na ? hs : 0) * 465;
        float mx = -3.0e38f;
        for (int j = lane; j < nk; j += 64) {
            int kt; float bias = 0.f;
            if (j < nloc) { if (na) { const int kr = rs + (j >> 4), kc = cs + (j & 15); kt = latbase + kr * 64 + kc; bias = rp[(kr - r + 7) * 31 + (kc - cpos + 15)] * LOG2E; } else kt = latbase + lo + j; }
            else kt = ctxbase + (j - nloc);
            const u32x4* kp = (const u32x4*)(Z + (size_t)kt * ZLD + kcol);
            float s = 0.f;
#pragma unroll
            for (int i = 0; i < 16; ++i) s += dot8(q[i], kp[i]);
            s += bias; sc[j] = s; mx = fmaxf(mx, s);
        }
        mx = wave_max(mx);
        float snk = 0.f; if (!na) { snk = p.sink[l * 8 + (hs - 4)] * LOG2E; mx = fmaxf(mx, snk); }
        float sum = 0.f;
        for (int j = lane; j < nk; j += 64) { const float pj = exp2f(sc[j] - mx); sc[j] = pj; sum += pj; }
        sum = wave_sum(sum); if (!na) sum += exp2f(snk - mx);
        float o0 = 0.f, o1 = 0.f;
#pragma unroll 4
        for (int j = 0; j < nk; ++j) {
            int kt;
            if (j < nloc) { if (na) kt = latbase + (rs + (j >> 4)) * 64 + cs + (j & 15); else kt = latbase + lo + j; } else kt = ctxbase + (j - nloc);
            const float pj = sc[j]; const unsigned vv = *(const unsigned*)(Z + (size_t)kt * ZLD + vcol + 2 * lane);
            o0 += pj * bflo(vv); o1 += pj * bfhi(vv);
        }
        const float inv = 1.f / sum;
        *(unsigned*)(Y + (size_t)tok * DM + ycol + 2 * lane) = cvt_pk_bf16(o0 * inv, o1 * inv);
    }
}

__device__ __forceinline__ float grp_max4(float v) {
    unsigned a = __float_as_uint(v); auto r = __builtin_amdgcn_permlane16_swap(a, a, false, false); v = fmaxf(__uint_as_float(r[0]), __uint_as_float(r[1]));
    a = __float_as_uint(v); auto r2 = __builtin_amdgcn_permlane32_swap(a, a, false, false); return fmaxf(__uint_as_float(r2[0]), __uint_as_float(r2[1]));
}
__device__ __forceinline__ float grp_sum4(float v) {
    unsigned a = __float_as_uint(v); auto r = __builtin_amdgcn_permlane16_swap(a, a, false, false); v = __uint_as_float(r[0]) + __uint_as_float(r[1]);
    a = __float_as_uint(v); auto r2 = __builtin_amdgcn_permlane32_swap(a, a, false, false); return __uint_as_float(r2[0]) + __uint_as_float(r2[1]);
}
typedef short s16x4 __attribute__((ext_vector_type(4)));
__device__ __forceinline__ unsigned att_koff(int row, int ch) { return (unsigned)(row * 256 + ((ch ^ ((row & 3) | (((row >> 3) & 3) << 2))) << 4)); }
__device__ __forceinline__ unsigned att_voff(int row, int ch) { return (unsigned)(row * 256 + ((ch ^ (((row & 3) << 2) | ((row >> 2) & 3))) << 4)); }
constexpr float ATT_MASKED = -1.0e30f, ATT_MINIT = -5.0e29f;
__device__ void attn_mfma(int tid_, int bid_, const P& p, int l, bool with_ctx, LAS unsigned char* lds) {
    const int lane = tid_ & 63, wid = __builtin_amdgcn_readfirstlane(tid_ >> 6), l15 = lane & 15, lg = lane >> 4;
    const bf16_t* Z = (const bf16_t*)(p.ws + WS_H);
    bf16_t* Y = (bf16_t*)(p.ws + WS_ABUF);
    LAS float* rpbs = (LAS float*)(lds + 65536);
    const int n_swa = 1024, n_na = 512, n_ctx = with_ctx ? 24 : 0;
    unsigned kx[4];
#pragma unroll
    for (int kk = 0; kk < 4; ++kk) kx[kk] = (unsigned)((8 * (l15 >> 2) + (l15 & 3)) * 256 + (((4 * kk + lg) ^ l15) << 4));
    const int vq = l15 >> 2, vp = lane & 3;
    unsigned vrow[2], vx[2];
#pragma unroll
    for (int t = 0; t < 2; ++t) { vrow[t] = (unsigned)((8 * lg + 4 * t + vq) * 256 + 8 * (vp & 1)); vx[t] = (unsigned)((vq << 2) | ((2 * lg + t) & 3)); }
    int st_row[2], st_ch[2];
#pragma unroll
    for (int i = 0; i < 2; ++i) { const int idx = tid_ + 512 * i; st_row[i] = idx >> 4; st_ch[i] = idx & 15; }

    for (int item = bid_; item < n_swa + n_na + n_ctx; item += gridDim.x) {
        int type, b, kcol, vcol, nloc = 0, loc_tok0 = 0, loc_pos0 = 0, qtok0, qcol, ycol, qpos0 = 0, r_na = 0, rs_lo = 0, rsr = 0, hbias = 0;
        bool has_sink = false; float sinkv = 0.f;
        if (item < n_swa) {
            type = 0; b = item >> 9; const int g = (item >> 8) & 1, m = item & 255; const int h = 4 * g + (wid >> 1);
            qpos0 = 64 * m + 32 * (wid & 1); qtok0 = b * LSEQ + qpos0; qcol = C_SQ + h * 128; ycol = 1024 + h * 128; kcol = C_SK + g * 128; vcol = C_SV + g * 128;
            const int c_lo = max(0, 2 - m), c_hi = min(4, 257 - m); nloc = c_hi - c_lo + 1; loc_pos0 = 64 * (m - 2 + c_lo); loc_tok0 = b * LSEQ + loc_pos0;
            has_sink = true; sinkv = p.sink[l * 8 + h] * LOG2E;
        } else if (item < n_swa + n_na) {
            type = 1; const int it = item - n_swa; b = it >> 8; const int h = (it >> 6) & 3, R4 = it & 63; r_na = 4 * R4 + (wid >> 1); qpos0 = 32 * (wid & 1);
            qtok0 = b * LSEQ + r_na * 64 + qpos0; qcol = C_NAQ + h * 128; ycol = h * 128; kcol = C_NAK + h * 128; vcol = C_NAV + h * 128; hbias = h;
            rs_lo = min(max(4 * R4 - 4, 0), 248); const int rs_hi = min(max(4 * R4 - 1, 0), 248) + 7; nloc = rs_hi - rs_lo + 1; loc_tok0 = b * LSEQ + rs_lo * 64;
            rsr = min(max(r_na - 4, 0), 248);
        } else {
            type = 2; int it = item - n_swa - n_na;
            if (it < 8) { b = it >> 2; const int h = it & 3; qcol = C_NAQ + h * 128; ycol = h * 128; kcol = C_NAK + h * 128; vcol = C_NAV + h * 128; }
            else { it -= 8; b = it >> 3; const int h = it & 7; qcol = C_SQ + h * 128; ycol = 1024 + h * 128; kcol = C_SK + (h >> 2) * 128; vcol = C_SV + (h >> 2) * 128; has_sink = true; sinkv = p.sink[l * 8 + h] * LOG2E; }
            qtok0 = NLAT + b * 256 + 32 * wid;
        }
        const int nch = nloc + 4; const int ctx_tok0 = NLAT + b * 256;
        if (type == 1) { for (int i = tid_; i < 465; i += 512) rpbs[i] = p.rpb[(size_t)(l * 4 + hbias) * 465 + i] * LOG2E; }
        bf16x8 Qf[2][4];
#pragma unroll
        for (int qt = 0; qt < 2; ++qt)
#pragma unroll
            for (int kk = 0; kk < 4; ++kk) Qf[qt][kk] = *(const bf16x8*)(Z + (size_t)(qtok0 + 16 * qt + l15) * ZLD + qcol + 32 * kk + 8 * lg);
        f32x4 O[8][2];
#pragma unroll
        for (int dt = 0; dt < 8; ++dt) { O[dt][0] = (f32x4){0.f, 0.f, 0.f, 0.f}; O[dt][1] = (f32x4){0.f, 0.f, 0.f, 0.f}; }
        float mrun[2] = {ATT_MINIT, ATT_MINIT}, lsum[2] = {0.f, 0.f};
        u32x4 kr[2], vr[2];
#define ATT_LOAD(tokb) do { _Pragma("unroll") for (int i = 0; i < 2; ++i) { const bf16_t* src = Z + (size_t)((tokb) + st_row[i]) * ZLD + st_ch[i] * 8; kr[i] = *(const u32x4*)(src + kcol); vr[i] = *(const u32x4*)(src + vcol); } } while (0)
#define ATT_STORE(buf) do { _Pragma("unroll") for (int i = 0; i < 2; ++i) { *(LAS u32x4*)(lds + (buf) * 16384 + att_koff(st_row[i], st_ch[i])) = kr[i]; *(LAS u32x4*)(lds + 32768 + (buf) * 16384 + att_voff(st_row[i], st_ch[i])) = vr[i]; } } while (0)
#define ATT_TOK(c) ((c) < nloc ? loc_tok0 + 64 * (c) : ctx_tok0 + 64 * ((c) - nloc))
        ATT_LOAD(ATT_TOK(0)); ATT_STORE(0); __syncthreads();
        for (int c = 0; c < nch; ++c) {
            if (c + 1 < nch) ATT_LOAD(ATT_TOK(c + 1));
            const bool is_loc = c < nloc;
            LAS unsigned char* Kb = lds + (c & 1) * 16384; LAS unsigned char* Vb = lds + 32768 + (c & 1) * 16384;
#pragma unroll 1
            for (int blk = 0; blk < 2; ++blk) {
                bool rel = true; int kb = 0, kr_na = 0;
                if (is_loc) { if (type == 0) { kb = loc_pos0 + 64 * c + 32 * blk; rel = (kb + 31 >= qpos0 - 128) && (kb <= qpos0 + 159); } else { kr_na = rs_lo + c; rel = (kr_na >= rsr) && (kr_na <= rsr + 7); } }
                if (!rel) continue;
                f32x4 s[2][2];
#pragma unroll
                for (int kt = 0; kt < 2; ++kt) { s[kt][0] = (f32x4){0.f, 0.f, 0.f, 0.f}; s[kt][1] = (f32x4){0.f, 0.f, 0.f, 0.f}; }
#pragma unroll
                for (int kk = 0; kk < 4; ++kk)
#pragma unroll
                    for (int kt = 0; kt < 2; ++kt) { const bf16x8 kf = *(const LAS bf16x8*)(Kb + kx[kk] + (32 * blk + 4 * kt) * 256);
                        s[kt][0] = __builtin_amdgcn_mfma_f32_16x16x32_bf16(kf, Qf[0][kk], s[kt][0], 0, 0, 0); s[kt][1] = __builtin_amdgcn_mfma_f32_16x16x32_bf16(kf, Qf[1][kk], s[kt][1], 0, 0, 0); }
                if (is_loc) {
                    if (type == 0) { if (!((kb >= qpos0 - 97) && (kb <= qpos0 + 97))) { const int dq = kb + 8 * lg - qpos0 - l15;
#pragma unroll
                        for (int kt = 0; kt < 2; ++kt)
#pragma unroll
                            for (int qt = 0; qt < 2; ++qt)
#pragma unroll
                                for (int j = 0; j < 4; ++j) { const int d = dq + 4 * kt + j - 16 * qt; s[kt][qt][j] = (d <= 128 && d >= -128) ? s[kt][qt][j] : ATT_MASKED; } }
                    } else { const int rowoff = (kr_na - r_na + 7) * 31;
#pragma unroll
                        for (int qt = 0; qt < 2; ++qt) { const int qc = qpos0 + 16 * qt + l15; const int cs = min(max(qc - 8, 0), 48);
#pragma unroll
                            for (int kt = 0; kt < 2; ++kt)
#pragma unroll
                                for (int j = 0; j < 4; ++j) { const int kc = 32 * blk + 8 * lg + 4 * kt + j; const bool valid = (kc >= cs) && (kc < cs + 16);
                                    const int bi = min(max(kc - qc + 15, 0), 30); const float bias = rpbs[rowoff + bi]; s[kt][qt][j] = valid ? s[kt][qt][j] + bias : ATT_MASKED; } }
                    }
                }
                bf16x8 pk[2];
#pragma unroll
                for (int qt = 0; qt < 2; ++qt) {
                    float ml = fmaxf(fmaxf(fmaxf(s[0][qt][0], s[0][qt][1]), fmaxf(s[0][qt][2], s[0][qt][3])), fmaxf(fmaxf(s[1][qt][0], s[1][qt][1]), fmaxf(s[1][qt][2], s[1][qt][3])));
                    ml = grp_max4(ml);
                    const float mn = fmaxf(mrun[qt], ml); const float alpha = __builtin_amdgcn_exp2f(mrun[qt] - mn); mrun[qt] = mn;
                    float ps = 0.f; float pv[8];
#pragma unroll
                    for (int kt = 0; kt < 2; ++kt)
#pragma unroll
                        for (int j = 0; j < 4; ++j) { const float e = __builtin_amdgcn_exp2f(s[kt][qt][j] - mn); pv[4 * kt + j] = e; ps += e; }
                    lsum[qt] = lsum[qt] * alpha + ps;
                    if (__any(alpha != 1.f)) {
#pragma unroll
                        for (int dt = 0; dt < 8; ++dt) O[dt][qt] *= alpha; }
                    u32x4 w; w.x = cvt_pk_bf16(pv[0], pv[1]); w.y = cvt_pk_bf16(pv[2], pv[3]); w.z = cvt_pk_bf16(pv[4], pv[5]); w.w = cvt_pk_bf16(pv[6], pv[7]);
                    pk[qt] = __builtin_bit_cast(bf16x8, w);
                }
#pragma unroll
                for (int dt = 0; dt < 8; ++dt) {
                    const s16x4 v0 = __builtin_amdgcn_ds_read_tr16_b64_v4i16((LAS s16x4*)(Vb + vrow[0] + blk * 8192 + ((((unsigned)(2 * dt + (vp >> 1))) ^ vx[0]) << 4)));
                    const s16x4 v1 = __builtin_amdgcn_ds_read_tr16_b64_v4i16((LAS s16x4*)(Vb + vrow[1] + blk * 8192 + ((((unsigned)(2 * dt + (vp >> 1))) ^ vx[1]) << 4)));
                    const bf16x8 vf = {v0[0], v0[1], v0[2], v0[3], v1[0], v1[1], v1[2], v1[3]};
                    O[dt][0] = __builtin_amdgcn_mfma_f32_16x16x32_bf16(vf, pk[0], O[dt][0], 0, 0, 0); O[dt][1] = __builtin_amdgcn_mfma_f32_16x16x32_bf16(vf, pk[1], O[dt][1], 0, 0, 0);
                }
            }
            if (c + 1 < nch) ATT_STORE((c + 1) & 1);
            __syncthreads();
        }
#undef ATT_LOAD
#undef ATT_STORE
#undef ATT_TOK
#pragma unroll
        for (int qt = 0; qt < 2; ++qt) {
            float lt = grp_sum4(lsum[qt]);
            if (has_sink) lt += exp2f(fminf(sinkv - mrun[qt], 126.f));
            const float inv = 1.f / lt;
            bf16_t* yp = Y + (size_t)(qtok0 + 16 * qt + l15) * DM + ycol + 4 * lg;
#pragma unroll
            for (int dt = 0; dt < 8; ++dt) { uint2 w; w.x = cvt_pk_bf16(O[dt][qt][0] * inv, O[dt][qt][1] * inv); w.y = cvt_pk_bf16(O[dt][qt][2] * inv, O[dt][qt][3] * inv); *(uint2*)(yp + 16 * dt) = w; }
        }
    }
}

__device__ __forceinline__ int gla_tokbase(int b, int s) { return s < 4 ? NLAT + b * 256 + s * 64 : b * LSEQ + (s - 4) * 64; }
constexpr int GLD = 68;
__device__ void gla_gates(int tid_, int bid_, const P& p, int l, int h, int tokbase, LAS float* B, LAS float* gl, LAS float* tot) {
    const int t = tid_; const bf16_t* Z = (const bf16_t*)(p.ws + WS_H);
    for (int i = t; i < 64 * 32; i += 512) { const int j = i >> 5, r = i & 31; gl[i] = bf2f(Z[(size_t)(tokbase + j) * ZLD + C_GFL + r]); }
    __syncthreads();
    const int dir = t >> 8, seg = (t >> 6) & 3, k = t & 63;
    const float* wg = (dir ? p.wgb : p.wgf) + l * 16 * 256 + h * 64 + k; float w[16];
#pragma unroll
    for (int r = 0; r < 16; ++r) w[r] = wg[r * 256];
    const float bg = (dir ? p.bgb : p.bgf)[l * 256 + h * 64 + k];
    float run = 0.f;
    for (int jj = 0; jj < 16; ++jj) { const int j = dir ? (seg * 16 + 15 - jj) : (seg * 16 + jj); float u = bg;
#pragma unroll
        for (int r = 0; r < 16; ++r) u += gl[j * 32 + dir * 16 + r] * w[r];
        const float g = -(fmaxf(-u, 0.f) + log1pf(__expf(-fabsf(u)))) * (1.f / 16.f); run += g; B[(dir * 64 + j) * GLD + k] = run; }
    tot[(dir * 4 + seg) * 64 + k] = run;
    __syncthreads();
}
__device__ __forceinline__ float gla_off(LAS const float* tot, int dir, int j, int k) {
    const int seg = j >> 4; float o = 0.f;
    if (!dir) { for (int s = 0; s < 3; ++s) if (s < seg) o += tot[s * 64 + k]; } else { for (int s = 1; s < 4; ++s) if (s > seg) o += tot[(4 + s) * 64 + k]; }
    return o;
}
__device__ void gla_g1(int tid_, int bid_, const P& p, int l, LAS unsigned char* lds) {
    LAS float* B = (LAS float*)lds;
    LAS float* V = (LAS float*)(lds + 36864);
    LAS float* gl = (LAS float*)(lds + 36864 + 32768);
    LAS float* tot = (LAS float*)(lds + 36864 + 32768 + 8192);
    const bf16_t* Z = (const bf16_t*)(p.ws + WS_H); float* ST = (float*)(p.ws + WS_ST); float* DEC = (float*)(p.ws + WS_DEC);
    const int t = tid_;
    for (int item = bid_; item < 520 * 4; item += gridDim.x) {
        const int h = item & 3, cs = item >> 2, b = cs / 260, s = cs - b * 260; const int tb = gla_tokbase(b, s);
        gla_gates(tid_, bid_, p, l, h, tb, B, gl, tot);
        for (int i = t; i < 64 * 16; i += 512) { const int j = i >> 4, c8 = (i & 15) * 8; const u32x4 u = *(const u32x4*)(Z + (size_t)(tb + j) * ZLD + C_GV + h * 128 + c8);
            LAS float* d = V + j * 128 + c8; d[0] = bflo(u.x); d[1] = bfhi(u.x); d[2] = bflo(u.y); d[3] = bfhi(u.y); d[4] = bflo(u.z); d[5] = bfhi(u.z); d[6] = bflo(u.w); d[7] = bfhi(u.w); }
        for (int e = t; e < 2 * 4096; e += 512) { const int dir = e >> 12, j = (e >> 6) & 63, k = e & 63;
            const float total = tot[(dir * 4 + 0) * 64 + k] + tot[(dir * 4 + 1) * 64 + k] + tot[(dir * 4 + 2) * 64 + k] + tot[(dir * 4 + 3) * 64 + k];
            const float bb = B[(dir * 64 + j) * GLD + k] + gla_off(tot, dir, j, k);
            const float kv = bf2f(Z[(size_t)(tb + j) * ZLD + C_GK + h * 64 + k]);
            B[(dir * 64 + j) * GLD + k] = kv * __expf(total - bb);
            if (j == 0) DEC[(size_t)(((dir * 2 + b) * 260 + s) * 4 + h) * 64 + k] = __expf(total); }
        __syncthreads();
        { const int vq = t & 31, kk = t >> 5; float af[4][4], ab[4][4];
#pragma unroll
            for (int a = 0; a < 4; ++a)
#pragma unroll
                for (int c = 0; c < 4; ++c) { af[a][c] = 0.f; ab[a][c] = 0.f; }
            for (int j = 0; j < 64; ++j) { const f32x4 v4 = *(const LAS f32x4*)(V + j * 128 + 4 * vq); const f32x4 kf = *(const LAS f32x4*)(B + j * GLD + 4 * kk), kb = *(const LAS f32x4*)(B + (64 + j) * GLD + 4 * kk);
#pragma unroll
                for (int a = 0; a < 4; ++a)
#pragma unroll
                    for (int c = 0; c < 4; ++c) { af[a][c] += kf[a] * v4[c]; ab[a][c] += kb[a] * v4[c]; } }
            float* sf = ST + (size_t)(((0 * 2 + b) * 260 + s) * 4 + h) * 8192; float* sb = ST + (size_t)(((1 * 2 + b) * 260 + s) * 4 + h) * 8192;
#pragma unroll
            for (int a = 0; a < 4; ++a) { *(f32x4*)(sf + (4 * kk + a) * 128 + 4 * vq) = (f32x4){af[a][0], af[a][1], af[a][2], af[a][3]}; *(f32x4*)(sb + (4 * kk + a) * 128 + 4 * vq) = (f32x4){ab[a][0], ab[a][1], ab[a][2], ab[a][3]}; } }
        __syncthreads();
    }
}
__device__ void gla_scan(int tid_, int bid_, const P& p) {
    const float* ST = (const float*)(p.ws + WS_ST); const float* DEC = (const float*)(p.ws + WS_DEC); bf16_t* SB = (bf16_t*)(p.ws + WS_SBF);
    for (int e = bid_ * 512 + tid_; e < 131072; e += gridDim.x * 512) {
        const int dir = e >> 16, b = (e >> 15) & 1, h = (e >> 13) & 3, kv = e & 8191, k = kv >> 7;
        const size_t sboff = (att_voff(k, (kv & 127) >> 3) >> 1) + (kv & 7);
        float S = 0.f;
        for (int st0 = 0; st0 < 260; st0 += 10) {
            float kvv[10], dd[10]; size_t idx[10];
#pragma unroll
            for (int u = 0; u < 10; ++u) { const int step = st0 + u; const int s = step < 4 ? (dir ? 3 - step : step) : (dir ? 263 - step : step);
                idx[u] = (size_t)(((dir * 2 + b) * 260 + s) * 4 + h); kvv[u] = ST[idx[u] * 8192 + kv]; dd[u] = DEC[idx[u] * 64 + k]; }
#pragma unroll
            for (int u = 0; u < 10; ++u) { SB[idx[u] * 8192 + sboff] = (bf16_t)(cvt_pk_bf16(S, 0.f) & 0xffffu); S = dd[u] * S + kvv[u]; }
        }
    }
}
__device__ void gla_g3(int tid_, int bid_, const P& p, int l, bool with_ctx, LAS unsigned char* lds) {
    LAS float* B = (LAS float*)lds;
    LAS float* Q = (LAS float*)(lds + 34816);
    LAS float* V = (LAS float*)(lds + 69632);
    LAS float* A = (LAS float*)(lds + 102400);
    LAS float* gl = (LAS float*)(lds + 119040);
    LAS float* tot = (LAS float*)(lds + 127232);
    const bf16_t* Z = (const bf16_t*)(p.ws + WS_H); const float* ST = (const float*)(p.ws + WS_ST); bf16_t* Y = (bf16_t*)(p.ws + WS_ABUF);
    const int t = tid_;
    for (int item = bid_; item < 520 * 4; item += gridDim.x) {
        const int h = item & 3, cs = item >> 2, b = cs / 260, s = cs - b * 260; if (s < 4 && !with_ctx) continue;
        const int tb = gla_tokbase(b, s);
        gla_gates(tid_, bid_, p, l, h, tb, B, gl, tot);
        for (int i = t; i < 64 * 16; i += 512) { const int j = i >> 4, c8 = (i & 15) * 8; const u32x4 u = *(const u32x4*)(Z + (size_t)(tb + j) * ZLD + C_GV + h * 128 + c8);
            LAS float* d = V + j * 128 + c8; d[0] = bflo(u.x); d[1] = bfhi(u.x); d[2] = bflo(u.y); d[3] = bfhi(u.y); d[4] = bflo(u.z); d[5] = bfhi(u.z); d[6] = bflo(u.w); d[7] = bfhi(u.w); }
        for (int e = t; e < 2 * 4096; e += 512) { const int dir = e >> 12, j = (e >> 6) & 63, k = e & 63;
            const float bb = B[(dir * 64 + j) * GLD + k] + gla_off(tot, dir, j, k);
            const float qv = bf2f(Z[(size_t)(tb + j) * ZLD + C_GQ + h * 64 + k]), kv = bf2f(Z[(size_t)(tb + j) * ZLD + C_GK + h * 64 + k]);
            Q[(dir * 64 + j) * GLD + k] = qv * __expf(bb); B[(dir * 64 + j) * GLD + k] = kv * __expf(-bb); }
        __syncthreads();
        { const int i = t >> 3, jg = t & 7; float af[8], ab[8];
#pragma unroll
            for (int jj = 0; jj < 8; ++jj) { af[jj] = 0.f; ab[jj] = 0.f; }
            for (int k4 = 0; k4 < 16; ++k4) { const f32x4 qf = *(const LAS f32x4*)(Q + i * GLD + 4 * k4), qb = *(const LAS f32x4*)(Q + (64 + i) * GLD + 4 * k4);
#pragma unroll
                for (int jj = 0; jj < 8; ++jj) { const int j = jg + 8 * jj; const f32x4 kf = *(const LAS f32x4*)(B + j * GLD + 4 * k4), kb = *(const LAS f32x4*)(B + (64 + j) * GLD + 4 * k4);
                    af[jj] += qf[0] * kf[0] + qf[1] * kf[1] + qf[2] * kf[2] + qf[3] * kf[3]; ab[jj] += qb[0] * kb[0] + qb[1] * kb[1] + qb[2] * kb[2] + qb[3] * kb[3]; } }
#pragma unroll
            for (int jj = 0; jj < 8; ++jj) { const int j = jg + 8 * jj; A[i * 65 + j] = (j <= i ? af[jj] : 0.f) + (j >= i ? ab[jj] : 0.f); } }
        __syncthreads();
        { const int i = t >> 3, vg = t & 7; f32x4 o[4];
#pragma unroll
            for (int c = 0; c < 4; ++c) o[c] = (f32x4){0.f, 0.f, 0.f, 0.f};
            for (int j = 0; j < 64; ++j) { const float a = A[i * 65 + j];
#pragma unroll
                for (int c = 0; c < 4; ++c) o[c] += a * *(const LAS f32x4*)(V + j * 128 + vg * 16 + 4 * c); }
            const float* sf = ST + (size_t)(((0 * 2 + b) * 260 + s) * 4 + h) * 8192 + vg * 16; const float* sb = ST + (size_t)(((1 * 2 + b) * 260 + s) * 4 + h) * 8192 + vg * 16;
#pragma unroll 4
            for (int k = 0; k < 64; ++k) { const float qf = Q[i * GLD + k], qb = Q[(64 + i) * GLD + k];
#pragma unroll
                for (int c = 0; c < 4; ++c) o[c] += qf * *(const f32x4*)(sf + k * 128 + 4 * c) + qb * *(const f32x4*)(sb + k * 128 + 4 * c); }
            float ss = 0.f;
#pragma unroll
            for (int c = 0; c < 4; ++c) ss += o[c][0] * o[c][0] + o[c][1] * o[c][1] + o[c][2] * o[c][2] + o[c][3] * o[c][3];
            ss += __shfl_xor(ss, 1); ss += __shfl_xor(ss, 2); ss += __shfl_xor(ss, 4);
            const float rstd = rsqrtf(ss * (1.f / 128.f) + 1e-6f);
            const int tok = tb + i; const bf16_t* rp = Z + (size_t)tok * ZLD + C_GR + h * 128 + vg * 16; const float* gg = p.glag + l * 128 + vg * 16;
            const u32x4 r0 = *(const u32x4*)rp, r1 = *(const u32x4*)(rp + 8);
            float rr[16] = {bflo(r0.x), bfhi(r0.x), bflo(r0.y), bfhi(r0.y), bflo(r0.z), bfhi(r0.z), bflo(r0.w), bfhi(r0.w), bflo(r1.x), bfhi(r1.x), bflo(r1.y), bfhi(r1.y), bflo(r1.z), bfhi(r1.z), bflo(r1.w), bfhi(r1.w)};
            float res[16];
#pragma unroll
            for (int c = 0; c < 4; ++c)
#pragma unroll
                for (int jx = 0; jx < 4; ++jx) { const float r = rr[4 * c + jx]; res[4 * c + jx] = o[c][jx] * rstd * gg[4 * c + jx] * (r / (1.f + __expf(-r))); }
            u32x4 w0, w1; w0.x = cvt_pk_bf16(res[0], res[1]); w0.y = cvt_pk_bf16(res[2], res[3]); w0.z = cvt_pk_bf16(res[4], res[5]); w0.w = cvt_pk_bf16(res[6], res[7]);
            w1.x = cvt_pk_bf16(res[8], res[9]); w1.y = cvt_pk_bf16(res[10], res[11]); w1.z = cvt_pk_bf16(res[12], res[13]); w1.w = cvt_pk_bf16(res[14], res[15]);
            bf16_t* yp = Y + (size_t)tok * DM + 512 + h * 128 + vg * 16; *(u32x4*)yp = w0; *(u32x4*)(yp + 8) = w1; }
        __syncthreads();
    }
}

__device__ void gla_gates2(int tid_, const P& p, int l, int h, int tokbase, LAS float* B, LAS float* gl, LAS float* tot) {
    const int t = tid_; const bf16_t* Z = (const bf16_t*)(p.ws + WS_H);
    { const int j = t >> 3, c4 = (t & 7) * 4; const uint2 u = *(const uint2*)(Z + (size_t)(tokbase + j) * ZLD + C_GFL + c4);
        LAS float* d = gl + j * 32 + c4; d[0] = bflo(u.x); d[1] = bfhi(u.x); d[2] = bflo(u.y); d[3] = bfhi(u.y); }
    const int dir = t >> 8, seg = (t >> 6) & 3, k = t & 63;
    const float* wg = (dir ? p.wgb : p.wgf) + l * 16 * 256 + h * 64 + k; float w[16];
#pragma unroll
    for (int r = 0; r < 16; ++r) w[r] = wg[r * 256];
    const float bg = (dir ? p.bgb : p.bgf)[l * 256 + h * 64 + k];
    __syncthreads();
    float run = 0.f;
    for (int jj = 0; jj < 16; ++jj) { const int j = dir ? (seg * 16 + 15 - jj) : (seg * 16 + jj); float u = bg;
#pragma unroll
        for (int r4 = 0; r4 < 4; ++r4) { const f32x4 g4 = *(const LAS f32x4*)(gl + j * 32 + dir * 16 + 4 * r4); u += g4[0] * w[4 * r4] + g4[1] * w[4 * r4 + 1] + g4[2] * w[4 * r4 + 2] + g4[3] * w[4 * r4 + 3]; }
        const float g = -(fmaxf(-u, 0.f) + __logf(1.f + __expf(-fabsf(u)))) * (1.f / 16.f); run += g; B[(dir * 64 + j) * GLD + k] = run; }
    tot[(dir * 4 + seg) * 64 + k] = run;
    __syncthreads();
    float off = 0.f, total = 0.f;
#pragma unroll
    for (int s = 0; s < 4; ++s) { const float v = tot[(dir * 4 + s) * 64 + k]; total += v; if (dir ? (s > seg) : (s < seg)) off += v; }
    for (int jj = 0; jj < 16; ++jj) { const int j = seg * 16 + jj; B[(dir * 64 + j) * GLD + k] += off; }
    __syncthreads();
    if (seg == 0) tot[(dir * 4) * 64 + k] = total;
    __syncthreads();
}
__device__ __forceinline__ unsigned gl_off128tr(int row, int ch) { return (unsigned)(row * 128 + ((ch ^ (((((row >> 3) & 1) << 1) | ((row >> 1) & 1)) << 1)) << 4)); }
__device__ __forceinline__ unsigned gl_offQ(int row, int ch) { return (unsigned)(row * 128 + ((ch ^ ((row >> 1) & 7)) << 4)); }
__device__ __forceinline__ unsigned gl_offK(int row, int ch) { return (unsigned)(row * 128 + ((ch ^ (((row >> 1) & 1) | (((row >> 3) & 3) << 1))) << 4)); }
constexpr int GL_B = 0, GL_QT = 34816, GL_KT = 51200, GL_V = 67584, GL_S = 83968, GL_GL = 116736, GL_TOT = 124928, GL_SSQ = 126976;
__device__ void gla_g1m(int tid_, int bid_, const P& p, int l, LAS unsigned char* lds) {
    LAS float* B = (LAS float*)(lds + GL_B); LAS float* gl = (LAS float*)(lds + GL_GL); LAS float* tot = (LAS float*)(lds + GL_TOT);
    LAS unsigned char* KH = lds + GL_QT; LAS unsigned char* VB = lds + GL_V;
    const bf16_t* Z = (const bf16_t*)(p.ws + WS_H); float* ST = (float*)(p.ws + WS_ST); float* DEC = (float*)(p.ws + WS_DEC);
    const int t = tid_, lane = t & 63, wid = __builtin_amdgcn_readfirstlane(t >> 6), l15 = lane & 15, lg = lane >> 4, vq = l15 >> 2, vp = lane & 3;
    for (int item = bid_; item < 520 * 4; item += gridDim.x) {
        const int h = item & 3, cs = item >> 2, b = cs / 260, s = cs - b * 260; const int tb = gla_tokbase(b, s);
        u32x4 vreg[2], kreg, qreg;
#pragma unroll
        for (int i = 0; i < 2; ++i) { const int idx = t + 512 * i; vreg[i] = *(const u32x4*)(Z + (size_t)(tb + (idx >> 4)) * ZLD + C_GV + h * 128 + (idx & 15) * 8); }
        { const int j = (t >> 3) & 63, ch = t & 7; const bf16_t* zp = Z + (size_t)(tb + j) * ZLD + h * 64 + ch * 8; kreg = *(const u32x4*)(zp + C_GK); qreg = *(const u32x4*)(zp + C_GQ); }
        gla_gates2(t, p, l, h, tb, B, gl, tot);
        unsigned char* qki = p.ws + WS_QKI + (size_t)item * 32768;
#pragma unroll
        for (int i = 0; i < 2; ++i) { const int idx = t + 512 * i; *(LAS u32x4*)(VB + att_voff(idx >> 4, idx & 15)) = vreg[i];
            const int dir = i, j = (t >> 3) & 63, ch = t & 7;
            const LAS float* bp = B + (dir * 64 + j) * GLD + ch * 8; const LAS float* tp = tot + (dir * 4) * 64 + ch * 8;
            const f32x4 b0 = *(const LAS f32x4*)bp, b1 = *(const LAS f32x4*)(bp + 4), t0 = *(const LAS f32x4*)tp, t1 = *(const LAS f32x4*)(tp + 4);
            float e[8], ei[8], et[8];
#pragma unroll
            for (int x = 0; x < 4; ++x) { e[x] = __expf(b0[x]); e[4 + x] = __expf(b1[x]); ei[x] = __builtin_amdgcn_rcpf(e[x]); ei[4 + x] = __builtin_amdgcn_rcpf(e[4 + x]); et[x] = __expf(t0[x]) * ei[x]; et[4 + x] = __expf(t1[x]) * ei[4 + x]; }
            const float kf[8] = {bflo(kreg.x), bfhi(kreg.x), bflo(kreg.y), bfhi(kreg.y), bflo(kreg.z), bfhi(kreg.z), bflo(kreg.w), bfhi(kreg.w)};
            const float qf[8] = {bflo(qreg.x), bfhi(qreg.x), bflo(qreg.y), bfhi(qreg.y), bflo(qreg.z), bfhi(qreg.z), bflo(qreg.w), bfhi(qreg.w)};
            u32x4 w, wq, wk;
            w.x = cvt_pk_bf16(kf[0] * et[0], kf[1] * et[1]); w.y = cvt_pk_bf16(kf[2] * et[2], kf[3] * et[3]); w.z = cvt_pk_bf16(kf[4] * et[4], kf[5] * et[5]); w.w = cvt_pk_bf16(kf[6] * et[6], kf[7] * et[7]);
            wq.x = cvt_pk_bf16(qf[0] * e[0], qf[1] * e[1]); wq.y = cvt_pk_bf16(qf[2] * e[2], qf[3] * e[3]); wq.z = cvt_pk_bf16(qf[4] * e[4], qf[5] * e[5]); wq.w = cvt_pk_bf16(qf[6] * e[6], qf[7] * e[7]);
            wk.x = cvt_pk_bf16(kf[0] * ei[0], kf[1] * ei[1]); wk.y = cvt_pk_bf16(kf[2] * ei[2], kf[3] * ei[3]); wk.z = cvt_pk_bf16(kf[4] * ei[4], kf[5] * ei[5]); wk.w = cvt_pk_bf16(kf[6] * ei[6], kf[7] * ei[7]);
            *(LAS u32x4*)(KH + dir * 8192 + gl_off128tr(j, ch)) = w;
            *(u32x4*)(qki + dir * 8192 + gl_offQ(j, ch)) = wq; *(u32x4*)(qki + 16384 + dir * 8192 + gl_offK(j, ch)) = wk; }
        if (t < 128) { const int dir = t >> 6, k = t & 63; DEC[(size_t)(((dir * 2 + b) * 260 + s) * 4 + h) * 64 + k] = __expf(tot[(dir * 4) * 64 + k]); }
        __syncthreads();
        { const int dir = wid >> 2, kt = wid & 3; const int phi = ((lg & 1) << 1) | ((vq >> 1) & 1);
            bf16x8 af[2];
#pragma unroll
            for (int jj = 0; jj < 2; ++jj) { s16x4 a0, a1;
                a0 = __builtin_amdgcn_ds_read_tr16_b64_v4i16((LAS s16x4*)(KH + dir * 8192 + (32 * jj + 8 * lg + vq) * 128 + ((2 * (kt ^ phi) + (vp >> 1)) << 4) + 8 * (vp & 1)));
                a1 = __builtin_amdgcn_ds_read_tr16_b64_v4i16((LAS s16x4*)(KH + dir * 8192 + (32 * jj + 8 * lg + 4 + vq) * 128 + ((2 * (kt ^ phi) + (vp >> 1)) << 4) + 8 * (vp & 1)));
                af[jj] = (bf16x8){a0[0], a0[1], a0[2], a0[3], a1[0], a1[1], a1[2], a1[3]}; }
            float* sp = ST + (size_t)(((dir * 2 + b) * 260 + s) * 4 + h) * 8192 + (16 * kt + 4 * lg) * 128 + l15;
#pragma unroll
            for (int vt = 0; vt < 8; ++vt) { f32x4 acc = {0.f, 0.f, 0.f, 0.f};
#pragma unroll
                for (int jj = 0; jj < 2; ++jj) { s16x4 v0, v1; const int r0 = 32 * jj + 8 * lg + vq, r1 = r0 + 4;
                    v0 = __builtin_amdgcn_ds_read_tr16_b64_v4i16((LAS s16x4*)(VB + att_voff(r0, 2 * vt + (vp >> 1)) + 8 * (vp & 1)));
                    v1 = __builtin_amdgcn_ds_read_tr16_b64_v4i16((LAS s16x4*)(VB + att_voff(r1, 2 * vt + (vp >> 1)) + 8 * (vp & 1)));
                    const bf16x8 vf = {v0[0], v0[1], v0[2], v0[3], v1[0], v1[1], v1[2], v1[3]};
                    acc = __builtin_amdgcn_mfma_f32_16x16x32_bf16(af[jj], vf, acc, 0, 0, 0); }
#pragma unroll
                for (int j = 0; j < 4; ++j) sp[j * 128 + 16 * vt] = acc[j]; }
        }
        __syncthreads();
    }
}
__device__ void gla_g3m(int tid_, int bid_, const P& p, int l, bool with_ctx, LAS unsigned char* lds) {
    LAS float* B = (LAS float*)(lds + GL_B); LAS float* gl = (LAS float*)(lds + GL_GL); LAS float* tot = (LAS float*)(lds + GL_TOT); LAS float* ssq = (LAS float*)(lds + GL_SSQ);
    LAS unsigned char* QT = lds + GL_QT; LAS unsigned char* KT = lds + GL_KT; LAS unsigned char* VB = lds + GL_V; LAS unsigned char* SB = lds + GL_S;
    const bf16_t* Z = (const bf16_t*)(p.ws + WS_H); const float* ST = (const float*)(p.ws + WS_ST); bf16_t* Y = (bf16_t*)(p.ws + WS_ABUF);
    const int t = tid_, lane = t & 63, wid = __builtin_amdgcn_readfirstlane(t >> 6), l15 = lane & 15, lg = lane >> 4, vq = l15 >> 2, vp = lane & 3;
    const int it = wid >> 1, vh = wid & 1;
    for (int item = bid_; item < 520 * 4; item += gridDim.x) {
        const int h = item & 3, cs = item >> 2, b = cs / 260, s = cs - b * 260; if (s < 4 && !with_ctx) continue;
        const int tb = gla_tokbase(b, s);
        u32x4 vreg[2], qk[4], sreg[4];
        const unsigned char* qki = p.ws + WS_QKI + (size_t)item * 32768;
#pragma unroll
        for (int i = 0; i < 2; ++i) { const int idx = t + 512 * i; vreg[i] = *(const u32x4*)(Z + (size_t)(tb + (idx >> 4)) * ZLD + C_GV + h * 128 + (idx & 15) * 8); }
#pragma unroll
        for (int i = 0; i < 4; ++i) { const int idx = t + 512 * i; qk[i] = *(const u32x4*)(qki + (size_t)idx * 16);
            const int dir = idx >> 10; sreg[i] = *(const u32x4*)(p.ws + WS_SBF + (size_t)(((dir * 2 + b) * 260 + s) * 4 + h) * 16384 + (size_t)(idx & 1023) * 16); }
#pragma unroll
        for (int i = 0; i < 2; ++i) { const int idx = t + 512 * i; *(LAS u32x4*)(VB + att_voff(idx >> 4, idx & 15)) = vreg[i]; }
#pragma unroll
        for (int i = 0; i < 4; ++i) { const int idx = t + 512 * i; *(LAS u32x4*)(QT + idx * 16) = qk[i]; *(LAS u32x4*)(SB + idx * 16) = sreg[i]; }
        __syncthreads();
        f32x4 O[4];
        {
            bf16x8 Qf[2][2];
#pragma unroll
            for (int dir = 0; dir < 2; ++dir)
#pragma unroll
                for (int kk = 0; kk < 2; ++kk) Qf[dir][kk] = *(const LAS bf16x8*)(QT + dir * 8192 + gl_offQ(16 * it + l15, 4 * kk + lg));
#pragma unroll
            for (int vt = 0; vt < 4; ++vt) O[vt] = (f32x4){0.f, 0.f, 0.f, 0.f};
            const int qi = 16 * it + l15;
#pragma unroll
            for (int jb = 0; jb < 2; ++jb) {
                f32x4 a[2];
#pragma unroll
                for (int jt = 0; jt < 2; ++jt) { f32x4 af = {0.f, 0.f, 0.f, 0.f}, ab = {0.f, 0.f, 0.f, 0.f}; const int row = 32 * jb + 8 * (l15 >> 2) + 4 * jt + (l15 & 3);
#pragma unroll
                    for (int kk = 0; kk < 2; ++kk) { const bf16x8 kf = *(const LAS bf16x8*)(KT + gl_offK(row, 4 * kk + lg)), kb = *(const LAS bf16x8*)(KT + 8192 + gl_offK(row, 4 * kk + lg));
                        af = __builtin_amdgcn_mfma_f32_16x16x32_bf16(kf, Qf[0][kk], af, 0, 0, 0); ab = __builtin_amdgcn_mfma_f32_16x16x32_bf16(kb, Qf[1][kk], ab, 0, 0, 0); }
#pragma unroll
                    for (int jx = 0; jx < 4; ++jx) { const int j = 32 * jb + 8 * lg + 4 * jt + jx; a[jt][jx] = (j <= qi ? af[jx] : 0.f) + (j >= qi ? ab[jx] : 0.f); } }
                u32x4 w; w.x = cvt_pk_bf16(a[0][0], a[0][1]); w.y = cvt_pk_bf16(a[0][2], a[0][3]); w.z = cvt_pk_bf16(a[1][0], a[1][1]); w.w = cvt_pk_bf16(a[1][2], a[1][3]);
                const bf16x8 pk = __builtin_bit_cast(bf16x8, w);
#pragma unroll
                for (int vt = 0; vt < 4; ++vt) { const int r0 = 32 * jb + 8 * lg + vq, cch = 2 * (4 * vh + vt) + (vp >> 1);
                    const s16x4 v0 = __builtin_amdgcn_ds_read_tr16_b64_v4i16((LAS s16x4*)(VB + att_voff(r0, cch) + 8 * (vp & 1)));
                    const s16x4 v1 = __builtin_amdgcn_ds_read_tr16_b64_v4i16((LAS s16x4*)(VB + att_voff(r0 + 4, cch) + 8 * (vp & 1)));
                    const bf16x8 vf = {v0[0], v0[1], v0[2], v0[3], v1[0], v1[1], v1[2], v1[3]};
                    O[vt] = __builtin_amdgcn_mfma_f32_16x16x32_bf16(vf, pk, O[vt], 0, 0, 0); }
            }
#pragma unroll
            for (int dir = 0; dir < 2; ++dir)
#pragma unroll
                for (int kk = 0; kk < 2; ++kk)
#pragma unroll
                    for (int vt = 0; vt < 4; ++vt) { const int r0 = 32 * kk + 8 * lg + vq, cch = 2 * (4 * vh + vt) + (vp >> 1);
                        const s16x4 s0 = __builtin_amdgcn_ds_read_tr16_b64_v4i16((LAS s16x4*)(SB + dir * 16384 + att_voff(r0, cch) + 8 * (vp & 1)));
                        const s16x4 s1 = __builtin_amdgcn_ds_read_tr16_b64_v4i16((LAS s16x4*)(SB + dir * 16384 + att_voff(r0 + 4, cch) + 8 * (vp & 1)));
                        const bf16x8 sf = {s0[0], s0[1], s0[2], s0[3], s1[0], s1[1], s1[2], s1[3]};
                        O[vt] = __builtin_amdgcn_mfma_f32_16x16x32_bf16(sf, Qf[dir][kk], O[vt], 0, 0, 0); }
        }
        float ss = 0.f;
#pragma unroll
        for (int vt = 0; vt < 4; ++vt) ss += O[vt][0] * O[vt][0] + O[vt][1] * O[vt][1] + O[vt][2] * O[vt][2] + O[vt][3] * O[vt][3];
        ss += __shfl_xor(ss, 16); ss += __shfl_xor(ss, 32);
        if (lg == 0) ssq[wid * 16 + l15] = ss;
        __syncthreads();
        { const float tot2 = ssq[(2 * it) * 16 + l15] + ssq[(2 * it + 1) * 16 + l15]; const float rstd = rsqrtf(tot2 * (1.f / 128.f) + 1e-6f);
            const int tok = tb + 16 * it + l15;
#pragma unroll
            for (int vt = 0; vt < 4; ++vt) { const int v0 = 64 * vh + 16 * vt + 4 * lg; const uint2 ru = *(const uint2*)(Z + (size_t)tok * ZLD + C_GR + h * 128 + v0); const f32x4 g4 = *(const f32x4*)(p.glag + l * 128 + v0);
                const float r0 = bflo(ru.x), r1 = bfhi(ru.x), r2 = bflo(ru.y), r3 = bfhi(ru.y);
                const float o0 = O[vt][0] * rstd * g4[0] * (r0 / (1.f + __expf(-r0))), o1 = O[vt][1] * rstd * g4[1] * (r1 / (1.f + __expf(-r1)));
                const float o2 = O[vt][2] * rstd * g4[2] * (r2 / (1.f + __expf(-r2))), o3 = O[vt][3] * rstd * g4[3] * (r3 / (1.f + __expf(-r3)));
                uint2 w; w.x = cvt_pk_bf16(o0, o1); w.y = cvt_pk_bf16(o2, o3); *(uint2*)(Y + (size_t)tok * DM + 512 + h * 128 + v0) = w; } }
        __syncthreads();
    }
}

constexpr int N_PHASES = 18;
#ifndef REP_G
#define REP_G 1
#endif
#ifndef REP_A
#define REP_A 1
#endif
#ifndef REP_N
#define REP_N 1
#endif
__device__ __forceinline__ void run_phase(int tid_, int bid_, const P& p, int ph, LAS unsigned char* lds) {
    if (ph == N_PHASES - 1) { phase_final(tid_, bid_, p); return; }
    if (ph == 9) { phase_ctxfix(tid_, bid_, p); return; }
    const int l = ph < 9 ? 0 : 1;
    const int sp = l == 0 ? (ph <= 6 ? ph - 1 : ph) : (ph <= 14 ? ph - 9 : ph - 8);
    const bool with_ctx = (l == 0);
    float* XC = (float*)(p.ws + WS_XC);
    const float* lat_src = l == 0 ? p.x : p.out; const float* ctx_src = l == 0 ? p.ctx : XC;
    bf16_t* wb = (bf16_t*)(p.ws + WS_W + (size_t)l * SZ_WL);
    bf16_t* ABUF = (bf16_t*)(p.ws + WS_ABUF); bf16_t* ABUF2 = (bf16_t*)(p.ws + WS_ABUF2); bf16_t* HB = (bf16_t*)(p.ws + WS_H);
    const float* MODA = (const float*)(p.ws + WS_MOD);
    const float* mod = MODA + (size_t)l * 3 * 12288;
    float* SSQ = (float*)(p.ws + WS_SSQ); const float* CV = (const float*)(p.ws + WS_CVEC) + (size_t)l * CV_L;
    const int Mres = with_ctx ? NTOK : NLAT;
    if (sp == 0) {
#pragma unroll 1
        for (int rep = 0; rep < REP_N; ++rep) { phase_norm(tid_, bid_, p, l, 1, lat_src, ctx_src, NTOK); }
        phase_cvec(tid_, bid_, p, lds);
        return; }
    if (sp == 2) {
#pragma unroll 1
        for (int rep = 0; rep < REP_G; ++rep) { gla_g1m(tid_, bid_, p, l, lds); }
#pragma unroll 1
        for (int rep = 0; rep < REP_A; ++rep) { attn_mfma(tid_, bid_, p, l, with_ctx, lds); }
        return; }
    if (sp == 3) { gla_scan(tid_, bid_, p); return; }
    if (sp == 4) {
#pragma unroll 1
        for (int rep = 0; rep < REP_G; ++rep) { gla_g3m(tid_, bid_, p, l, with_ctx, lds); }
        return; }
    pg8::Gemm g; EpiAny E{};
    E.ws = p.ws; E.out = p.out; E.l = l; E.ssq_idx = -1;
    if (sp == 1) { g = pg8::Gemm{ABUF, wb, NTOK, ZN, DM}; E.mode = 0; E.perm = true; if (l == 1) E.ssq_idx = 1; }
    else if (sp == 5) { g = pg8::Gemm{ABUF, wb + (size_t)ZN * DM, Mres, DM, DM}; E.mode = 2; E.perm = true;
        E.rlat = lat_src; E.rctx = ctx_src; E.gate_idx = 2; E.ntfull = DM / 64; E.aout_sel = 2; E.ng = p.n2g + l * DM; E.nsc_off = l * 3 * 12288 + 4 * DM; E.ssq_idx = (l == 0 ? 0 : 2); }
    else if (sp == 7) { g = pg8::Gemm{ABUF2, wb + (size_t)ZN * DM + (size_t)DM * DM, Mres, DFF, DM}; E.mode = 1; E.perm = true; E.ssq_idx = (l == 0 ? 0 : 2); }
    else { g = pg8::Gemm{HB, wb + (size_t)ZN * DM + (size_t)DM * DM + (size_t)DFF * DM, NLAT, DM, DFF}; E.mode = 2; E.perm = true;
        E.rlat = p.out; E.rctx = XC; E.gate_idx = 5; E.ntfull = DFF / 64; E.aout_sel = (l == 0 ? 1 : 0); E.ng = p.n1g + DM; E.nsc_off = 3 * 12288 + 1 * DM; E.ssq_idx = 1; }
    pg8::StaticOrder S; S.init(g.M, g.N, g.K, gridDim.x, bid_);
    if (sp == 8 && l == 0) { S.nsplit = 256; S.ks = 16; S.nt_split = 8; S.pm_split0 = 128; }
    pg8::gemm_phase(tid_, lds, g, S, E);
}

#define XB_TMO      128
#define XB_XCNT(j)  (256  + 64 * (j))
#define XB_XSUB(j)  (1280 + 64 * (j))
#define XB_XGEN(j)  (2304 + 64 * (j))
#define XB_TOP      3328
#define XB_TOPGEN   3392
#define XCD_BAR_WORDS 3456
#define XB_SPIN_CAP (1u << 18)
__device__ __forceinline__ unsigned xb_ld(unsigned* p)              { return __hip_atomic_load(p, __ATOMIC_RELAXED, __HIP_MEMORY_SCOPE_AGENT); }
__device__ __forceinline__ unsigned xb_add(unsigned* p, unsigned v) { return __hip_atomic_fetch_add(p, v, __ATOMIC_RELAXED, __HIP_MEMORY_SCOPE_AGENT); }
__device__ __forceinline__ unsigned xb_xcc_id() { return (unsigned)__builtin_amdgcn_s_getreg((3 << 11) | 20) & 0xFu; }
#define XB_SPIN(cond, bar) do { unsigned _sp = 0; while (cond) { __builtin_amdgcn_s_sleep(1); \
    if ((++_sp & 255u) == 0u) { if (xb_ld(&(bar)[XB_TMO])) break; if (_sp > XB_SPIN_CAP) { atomicAdd(&(bar)[XB_TMO], 1u); break; } } } } while (0)
struct XcdBarrier { unsigned* bar; unsigned x; volatile LAS unsigned* st; };
__device__ __forceinline__ XcdBarrier xcd_barrier_post(unsigned* bar, volatile LAS unsigned* st) {
    XcdBarrier b; b.bar = bar; b.x = xb_xcc_id(); b.st = st;
    if (threadIdx.x == 0) (void)xb_add(&bar[XB_XCNT(b.x)], 1u);
    return b;
}
__device__ __forceinline__ void xcd_barrier_complete(unsigned* bar, unsigned x, unsigned& nloc, unsigned& nx) {
    const unsigned G = gridDim.x * gridDim.y * gridDim.z;
    unsigned sum, cnt, mine, sp = 0u;
    for (;;) {
        sum = 0u; cnt = 0u; mine = 0u;
#pragma unroll
        for (unsigned j = 0; j < 16; ++j) { const unsigned c = xb_ld(&bar[XB_XCNT(j)]); sum += c; cnt += (c > 0u) ? 1u : 0u; mine = (j == x) ? c : mine; }
        if (sum == G) break;
        __builtin_amdgcn_s_sleep(1);
        if ((++sp & 255u) == 0u) { if (xb_ld(&bar[XB_TMO])) break; if (sp > XB_SPIN_CAP) { atomicAdd(&bar[XB_TMO], 1u); break; } }
    }
    nloc = mine > 0u ? mine : 1u; nx = cnt > 0u ? cnt : 1u;
}
__device__ __forceinline__ void xcd_barrier(const XcdBarrier& b) {
    asm volatile("s_waitcnt vmcnt(0)" ::: "memory");
    __syncthreads();
    if (threadIdx.x == 0) {
        unsigned* bar = b.bar;
        __builtin_amdgcn_s_waitcnt(0);
        unsigned nloc = b.st[0], nx = b.st[1];
        if (nloc == 0u) { xcd_barrier_complete(bar, b.x, nloc, nx); b.st[0] = nloc; b.st[1] = nx; }
        const unsigned old = xb_add(&bar[XB_XSUB(b.x)], 1u);
        const unsigned gen = old / nloc;
        if (old + 1u == (gen + 1u) * nloc) {
            __builtin_amdgcn_fence(__ATOMIC_RELEASE, "agent");
            asm volatile("s_waitcnt vmcnt(0)" ::: "memory");
            const unsigned og = xb_add(&bar[XB_TOP], 1u);
            const unsigned tg = og / nx;
            if (og + 1u == (tg + 1u) * nx) xb_add(&bar[XB_TOPGEN], 1u);
            else XB_SPIN(xb_ld(&bar[XB_TOPGEN]) == tg, bar);
            __builtin_amdgcn_fence(__ATOMIC_ACQUIRE, "agent");
            xb_add(&bar[XB_XGEN(b.x)], 1u);
            asm volatile("s_waitcnt vmcnt(0)" ::: "memory");
        } else {
            XB_SPIN(xb_ld(&bar[XB_XGEN(b.x)]) == gen, bar);
            __builtin_amdgcn_fence(__ATOMIC_ACQUIRE, "agent");
            asm volatile("s_waitcnt vmcnt(0)" ::: "memory");
        }
    }
    __syncthreads();
}

__global__ void __launch_bounds__(512, 2) mk_fwd(P p) {
    extern __shared__ __attribute__((aligned(16))) unsigned char shm[];
    LAS unsigned char* lds = (LAS unsigned char*)shm;
    cg::grid_group grid = cg::this_grid();
    volatile LAS unsigned* xst = (volatile LAS unsigned*)(lds + 131072);
    if (threadIdx.x == 0) { xst[0] = 0u; xst[1] = 0u; xst[2] = 0u; xst[3] = 0u; }
    __syncthreads();
    const XcdBarrier xb = xcd_barrier_post((unsigned*)(p.ws + WS_BAR), xst);
    int ph0 = (int)p.ph_lo;
    if (ph0 == 0) {
        int tid_ = threadIdx.x, bid_ = blockIdx.x;
        asm volatile("" : "+v"(tid_));
        asm volatile("" : "+s"(bid_));
        P q = p;
        { long zoff = 0; asm volatile("" : "+s"(zoff)); q.ws = p.ws + zoff; q.out = p.out + zoff; }
#pragma unroll 1
        for (int rep = 0; rep < REP_N; ++rep) { phase0(tid_, bid_, q, lds); __syncthreads(); }
        ph0 = 1;
        if (ph0 < (int)p.ph_hi) xcd_barrier(xb);
        if (p.ph_lo < 0) grid.sync();
    }
    for (int ph = ph0; ph < (int)p.ph_hi; ++ph) {
        int tid_ = threadIdx.x, bid_ = blockIdx.x;
        asm volatile("" : "+v"(tid_));
        asm volatile("" : "+s"(bid_));
        P q = p;
        { long zoff = 0; asm volatile("" : "+s"(zoff)); q.ws = p.ws + zoff; q.out = p.out + zoff; }
        run_phase(tid_, bid_, q, ph, lds);
        if (ph + 1 < (int)p.ph_hi) xcd_barrier(xb);
    }
}

#ifndef MK_MULTI
#define MK_MULTI 0
#endif
extern "C" void kernel_launch(void* const* d_in, const int* in_sizes, int n_in, void* d_out, int out_size, void* d_ws, size_t ws_size, hipStream_t stream) {
    static int grid = 0;
    if (grid == 0) {
        if (ws_size < WS_END) { fprintf(stderr, "kernel_launch: workspace too small: %zu < %zu\n", ws_size, (size_t)WS_END); grid = -1; return; }
        int dev = 0, cus = 0, per_cu = 0;
        hipGetDevice(&dev); hipDeviceGetAttribute(&cus, hipDeviceAttributeMultiprocessorCount, dev);
        if (hipFuncSetAttribute((const void*)mk_fwd, hipFuncAttributeMaxDynamicSharedMemorySize, LDS_BYTES) != hipSuccess) { fprintf(stderr, "kernel_launch: hipFuncSetAttribute failed\n"); grid = -1; return; }
        if (hipOccupancyMaxActiveBlocksPerMultiprocessor(&per_cu, (const void*)mk_fwd, 512, LDS_BYTES) != hipSuccess || per_cu < 1) { fprintf(stderr, "kernel_launch: occupancy query gave %d\n", per_cu); per_cu = 1; }
        (void)hipGetLastError();
        grid = cus * 1;
    }
    if (grid < 0) return;
    P p{};
    const float** pp = (const float**)&p;
    for (int i = 0; i < 20; ++i) pp[i] = (const float*)d_in[i];
    p.out = (float*)d_out; p.ws = (unsigned char*)d_ws;
#if MK_MULTI
    for (int ph = 0; ph < N_PHASES; ++ph) { p.ph_lo = ph; p.ph_hi = ph + 1; hipLaunchKernelGGL(mk_fwd, dim3(grid), dim3(512), LDS_BYTES, stream, p); }
#else
    p.ph_lo = 0; p.ph_hi = N_PHASES;
    if (hipMemsetAsync((char*)d_ws + WS_BAR, 0, 16384, stream) != hipSuccess) { fprintf(stderr, "kernel_launch: hipMemsetAsync failed\n"); return; }
    void* args[] = {&p};
    hipError_t e = hipLaunchCooperativeKernel((const void*)mk_fwd, dim3(grid), dim3(512), args, LDS_BYTES, stream);
    if (e != hipSuccess) fprintf(stderr, "cooperative launch failed: %s (grid %d)\n", hipGetErrorString(e), grid);
#endif
}
```

```cpp
#include <hip/hip_runtime.h>
#include <hip/hip_cooperative_groups.h>
#include <cstdio>
namespace cg = cooperative_groups;

#define LAS __attribute__((address_space(3)))
typedef unsigned short bf16_t;
typedef short bf16x8 __attribute__((ext_vector_type(8)));
typedef float f32x4 __attribute__((ext_vector_type(4)));
typedef unsigned u32x4 __attribute__((ext_vector_type(4)));
typedef unsigned u32x2v __attribute__((ext_vector_type(2)));

constexpr int DM = 2048, LSEQ = 16384, NLAT = 32768, NCTX = 512, NTOK = 33280, DFF = 8192;
constexpr int ZLD = 4640, ZN = 4864;
constexpr int C_NAQ = 0, C_NAK = 512, C_NAV = 1024, C_GQ = 1536, C_GK = 1792, C_GV = 2048, C_GR = 2560;
constexpr int C_SQ = 3072, C_SK = 4096, C_SV = 4352, C_GFL = 4608;
constexpr float LOG2E = 1.4426950408889634f;
constexpr float QSCALE = 0.08838834764831845f * 1.4426950408889634f;
constexpr int LDS_OUTB = 70144;
constexpr int LDS_XST = LDS_OUTB + 65536;
constexpr int LDS_BYTES = LDS_XST + 16;

constexpr size_t SZ_WIN = (size_t)ZN * DM * 2, SZ_WOUT = (size_t)DM * DM * 2, SZ_WFF = (size_t)DFF * DM * 2;
constexpr size_t SZ_WL = SZ_WIN + SZ_WOUT + 2 * SZ_WFF;
constexpr size_t WS_W = 0;
constexpr size_t WS_ABUF = WS_W + 2 * SZ_WL;
constexpr size_t WS_H = WS_ABUF + (size_t)NTOK * DM * 2;
constexpr size_t SZ_Z = (size_t)NTOK * ZLD * 2;
constexpr size_t WS_ST = WS_H + SZ_Z;
constexpr size_t SZ_ST = (size_t)2 * 2 * 260 * 4 * 8192 * 4;
constexpr size_t WS_DEC = WS_ST + SZ_ST;
constexpr size_t SZ_DEC = (size_t)2 * 2 * 260 * 4 * 64 * 4;
constexpr size_t WS_XC = WS_H + (size_t)NTOK * DFF * 2;
constexpr size_t WS_MOD = WS_XC + (size_t)NCTX * DM * 4;
constexpr size_t WS_ROPE = WS_MOD + (size_t)2 * 3 * 12288 * 4;
constexpr size_t WS_ABUF2 = WS_ROPE + 2 * 256 * 32 * 4;
constexpr size_t WS_QKI = WS_ABUF2;
constexpr size_t WS_SBF = WS_ABUF2 + (size_t)2080 * 32768;
static_assert((size_t)2080 * 32768 * 2 <= (size_t)NTOK * DM * 2, "gla overlay");
constexpr size_t WS_SSQ = WS_ABUF2 + (size_t)NTOK * DM * 2;
constexpr size_t WS_CVEC = WS_SSQ + (size_t)3 * NTOK * 4;
constexpr int CV_L = 3 * (ZN + DFF);
constexpr size_t WS_BAR = WS_CVEC + (size_t)2 * CV_L * 4;
constexpr size_t WS_END = WS_BAR + 16384;
static_assert(WS_DEC + SZ_DEC <= WS_XC, "overlay");

struct P {
    const float *x, *c, *ctx, *c_ctx, *w_mod, *b_mod, *n1g, *n2g, *w_in, *rpb, *wgf, *bgf, *wgb, *bgb, *glag, *sink, *w_out, *w_ff1, *w_ff2, *fng;
    float* out;
    unsigned char* ws;
    long ph_lo, ph_hi;
};

__device__ __forceinline__ unsigned cvt_pk_bf16(float lo, float hi) { unsigned r; asm volatile("v_cvt_pk_bf16_f32 %0, %1, %2" : "=v"(r) : "v"(lo), "v"(hi)); return r; }
__device__ __forceinline__ float bf2f(bf16_t b) { return __uint_as_float(((unsigned)b) << 16); }
__device__ __forceinline__ float bflo(unsigned u) { return __uint_as_float(u << 16); }
__device__ __forceinline__ float bfhi(unsigned u) { return __uint_as_float(u & 0xffff0000u); }
__device__ __forceinline__ float wave_sum(float v) { for (int o = 32; o > 0; o >>= 1) v += __shfl_xor(v, o); return v; }
__device__ __forceinline__ float wave_max(float v) { for (int o = 32; o > 0; o >>= 1) v = fmaxf(v, __shfl_xor(v, o)); return v; }
__device__ __forceinline__ float dot8(u32x4 a, u32x4 b) {
    float s = bflo(a.x) * bflo(b.x); s += bfhi(a.x) * bfhi(b.x); s += bflo(a.y) * bflo(b.y); s += bfhi(a.y) * bfhi(b.y);
    s += bflo(a.z) * bflo(b.z); s += bfhi(a.z) * bfhi(b.z); s += bflo(a.w) * bflo(b.w); s += bfhi(a.w) * bfhi(b.w); return s;
}

namespace pg8 {
constexpr int BM = 256, BK = 64, HALF = 128, HTB = HALF * BK * 2, NXCD = 8, WGM = 8;
__device__ __forceinline__ int lds_byte(int r, int c) { const int st = (r >> 4) * 2 + (c >> 5), rr = r & 15, cc = c & 31, ob = rr * 64 + cc * 2; return st * 1024 + (ob ^ (((ob >> 9) & 1) << 5)); }
__device__ __forceinline__ void stage_rc(int b, int& R, int& C) { const int st = b / 1024, sb = b % 1024, swz = sb ^ (((sb >> 9) & 1) << 5); R = (st >> 1) * 16 + swz / 64; C = (st & 1) * 32 + (swz % 64) / 2; }
__device__ __forceinline__ int perm32(int rho) { const int n = rho >> 4, i = rho & 15; return 8 * (i >> 2) + 4 * n + (i & 3); }
struct Unit { int pm, pn, k0, nt; };
struct Gemm { const bf16_t* A; const bf16_t* Bt; int M, N, K; };
struct StaticOrder {
    int nM, nN, nwg, G, c;
    __device__ void init(int M, int N, int K, int G_, int c_) { nM = M / BM; nN = N / BM; nwg = nM * nN; G = G_; c = c_; ntfull = K / BK; nsplit = 0; ks = 1; nt_split = 0; pm_split0 = 0; }
    int ntfull, nsplit, ks, nt_split, pm_split0;
    __device__ __forceinline__ bool next(int i, Unit& u) const {
        const long L = (long)i * G + c;
        const bool full = L < nwg; const int sidx = (int)(L - nwg);
        if (!full && sidx >= nsplit) return false;
        int wgid = full ? (int)L : 0; { const int q = nwg / NXCD, r = nwg % NXCD, xcd = wgid % NXCD, off = wgid / NXCD; wgid = (xcd < r ? xcd * (q + 1) : r * (q + 1) + (xcd - r) * q) + off; }
        const int nig = WGM * nN, gid = wgid / nig, fm = gid * WGM, gsz = (nM - fm) < WGM ? (nM - fm) : WGM;
        const int fpm = fm + ((wgid % nig) % gsz), fpn = (wgid % nig) / gsz;
        const int tl = sidx / ks, spm = pm_split0 + tl / nN, spn = tl % nN, sk0 = (sidx % ks) * nt_split * BK;
        u.pm = full ? fpm : spm; u.pn = full ? fpn : spn; u.k0 = full ? 0 : sk0; u.nt = full ? ntfull : nt_split;
        return true;
    }
};

template <class Epi>
__device__ __forceinline__ void gemm_phase(int tid_, LAS unsigned char* lds, const Gemm g, const StaticOrder& S, const Epi& E) {
    const int tid = tid_, wid = __builtin_amdgcn_readfirstlane(tid >> 6), lane = tid & 63, wr = wid >> 2, wc = wid & 3, fr = lane & 15, fq = lane >> 4;
    const int K = g.K;
    unsigned voffA[2], voffB[2];
#pragma unroll
    for (int i = 0; i < 2; ++i) { int R, C; stage_rc(tid * 16 + i * 8192, R, C); const int Rb = E.perm ? ((R & ~31) + perm32(R & 31)) : R;
        voffA[i] = (unsigned)(R * K + C) * 2u; voffB[i] = (unsigned)(Rb * K + C) * 2u; }
    const size_t kstep = (size_t)(BK * 2);
    const size_t hstep = (size_t)HALF * K * 2;
    const size_t tstep = 2 * hstep;
    const unsigned ldsw = (unsigned)wid * 1024u;
    const int aoff = lds_byte(wr * 64 + fr, fq * 8), boff = lds_byte(wc * 32 + fr, fq * 8);
#define PG8_SA(b, h) (((b) * 2 + (h)) * HTB)
#define PG8_SB(b, h) ((4 + (b) * 2 + (h)) * HTB)
#define PG8_STAGE(bufoff, gbase, voff) do { _Pragma("unroll") for (int _i = 0; _i < 2; ++_i) \
        __builtin_amdgcn_global_load_lds((const unsigned*)((const char*)(gbase) + (voff)[_i]), (LAS unsigned*)(lds + (bufoff) + ldsw + _i * 8192), 16, 0, 0); } while (0)
#define PG8_LDA(dst, b, h) do { _Pragma("unroll") for (int m = 0; m < 4; ++m) _Pragma("unroll") for (int k = 0; k < 2; ++k) dst[m][k] = *(const LAS bf16x8*)(lds + PG8_SA(b, h) + aoff + m * 2048 + k * 1024); } while (0)
#define PG8_LDB(dst, b, h) do { _Pragma("unroll") for (int n = 0; n < 2; ++n) _Pragma("unroll") for (int k = 0; k < 2; ++k) dst[n][k] = *(const LAS bf16x8*)(lds + PG8_SB(b, h) + boff + n * 2048 + k * 1024); } while (0)
#define PG8_MMA(ai, bj, At, Bt) do { __builtin_amdgcn_s_setprio(1); _Pragma("unroll") for (int m = 0; m < 4; ++m) _Pragma("unroll") for (int n = 0; n < 2; ++n) _Pragma("unroll") for (int k = 0; k < 2; ++k) \
        acc[ai][bj][m][n] = __builtin_amdgcn_mfma_f32_16x16x32_bf16(Bt[n][k], At[m][k], acc[ai][bj][m][n], 0, 0, 0); __builtin_amdgcn_s_setprio(0); } while (0)
#define PG8_WAIT_V(n) asm volatile("s_waitcnt vmcnt(" #n ")" ::: "memory")
#define PG8_WAIT_L(n) asm volatile("s_waitcnt lgkmcnt(" #n ")" ::: "memory")
#define PG8_BAR __builtin_amdgcn_s_barrier()
#define PG8_SCHED __builtin_amdgcn_sched_barrier(0)
    Unit cur, nxt; int ui = 0;
    if (!S.next(0, cur)) return;
    f32x4 acc[2][2][4][2];
#pragma unroll
    for (int a = 0; a < 2; ++a)
#pragma unroll
        for (int b = 0; b < 2; ++b)
#pragma unroll
            for (int m = 0; m < 4; ++m)
#pragma unroll
                for (int n = 0; n < 2; ++n) acc[a][b][m][n] = (f32x4){0.f, 0.f, 0.f, 0.f};
    bf16x8 At[4][2], B0[2][2], B1[2][2];
    const char* cA = (const char*)g.A + (size_t)cur.pm * tstep + (size_t)cur.k0 * 2; const char* cB = (const char*)g.Bt + (size_t)cur.pn * tstep + (size_t)cur.k0 * 2;
    PG8_STAGE(PG8_SB(0, 0), cB, voffB); PG8_STAGE(PG8_SA(0, 0), cA, voffA); PG8_STAGE(PG8_SB(0, 1), cB + hstep, voffB); PG8_STAGE(PG8_SA(0, 1), cA + hstep, voffA);
    if (wr == 1) PG8_BAR;
    PG8_WAIT_V(4); PG8_BAR;
    PG8_STAGE(PG8_SB(1, 0), cB + kstep, voffB); PG8_STAGE(PG8_SA(1, 0), cA + kstep, voffA); PG8_STAGE(PG8_SB(1, 1), cB + hstep + kstep, voffB);
    PG8_WAIT_V(6); PG8_BAR;
    for (;;) {
        const bool has_next = S.next(ui + 1, nxt);
        const char* nA = has_next ? (const char*)g.A + (size_t)nxt.pm * tstep + (size_t)nxt.k0 * 2 : cA; const char* nB = has_next ? (const char*)g.Bt + (size_t)nxt.pn * tstep + (size_t)nxt.k0 * 2 : cB;
        const int nt = cur.nt;
        for (int t = 0; t < nt; t += 2) {
            const bool last = (t == nt - 2);
            const char* a1 = cA + (size_t)(t + 1) * kstep;
            const char* a2 = last ? nA : cA + (size_t)(t + 2) * kstep; const char* b2 = last ? nB : cB + (size_t)(t + 2) * kstep;
            const char* a3 = a2 + kstep; const char* b3 = b2 + kstep;
            PG8_LDB(B0, 0, 0); PG8_SCHED; PG8_LDA(At, 0, 0); PG8_STAGE(PG8_SA(1, 1), a1 + hstep, voffA);
            PG8_WAIT_L(8); PG8_BAR; PG8_WAIT_L(0); PG8_MMA(0, 0, At, B0); PG8_BAR; PG8_SCHED;
            PG8_LDB(B1, 0, 1); PG8_STAGE(PG8_SB(0, 0), b2, voffB);
            PG8_BAR; PG8_WAIT_L(0); PG8_MMA(0, 1, At, B1); PG8_BAR;
            PG8_LDA(At, 0, 1); PG8_STAGE(PG8_SA(0, 0), a2, voffA);
            PG8_BAR; PG8_WAIT_L(0); PG8_MMA(1, 0, At, B0); PG8_BAR; PG8_SCHED;
            PG8_STAGE(PG8_SB(0, 1), b2 + hstep, voffB);
            PG8_WAIT_V(6); PG8_BAR; PG8_MMA(1, 1, At, B1); PG8_BAR;
            PG8_LDB(B0, 1, 0); PG8_SCHED; PG8_LDA(At, 1, 0); PG8_STAGE(PG8_SA(0, 1), a2 + hstep, voffA);
            PG8_WAIT_L(8); PG8_BAR; PG8_WAIT_L(0); PG8_MMA(0, 0, At, B0); PG8_BAR; PG8_SCHED;
            PG8_LDB(B1, 1, 1); PG8_STAGE(PG8_SB(1, 0), b3, voffB);
            PG8_BAR; PG8_WAIT_L(0); PG8_MMA(0, 1, At, B1); PG8_BAR;
            PG8_LDA(At, 1, 1); PG8_STAGE(PG8_SA(1, 0), a3, voffA);
            PG8_BAR; PG8_WAIT_L(0); PG8_MMA(1, 0, At, B0); PG8_BAR; PG8_SCHED;
            PG8_STAGE(PG8_SB(1, 1), b3 + hstep, voffB);
            PG8_WAIT_V(6); PG8_BAR; PG8_MMA(1, 1, At, B1); PG8_BAR;
        }
        E(acc, cur, wr, wc, fr, fq);
        if (!has_next) break;
#pragma unroll
        for (int a = 0; a < 2; ++a)
#pragma unroll
            for (int b = 0; b < 2; ++b)
#pragma unroll
                for (int m = 0; m < 4; ++m)
#pragma unroll
                    for (int n = 0; n < 2; ++n) acc[a][b][m][n] = (f32x4){0.f, 0.f, 0.f, 0.f};
        cur = nxt; cA = nA; cB = nB; ++ui;
    }
    PG8_WAIT_V(0);
    if (wr == 0) PG8_BAR;
    PG8_BAR;
#undef PG8_SA
#undef PG8_SB
#undef PG8_STAGE
#undef PG8_LDA
#undef PG8_LDB
#undef PG8_MMA
#undef PG8_WAIT_V
#undef PG8_WAIT_L
#undef PG8_BAR
#undef PG8_SCHED
}
}

struct EpiIn {
    static constexpr bool PERM = true;
    bf16_t* Z; const float* rcos; const float* rsin; const float* ssq; const float* cvec;
    __device__ __forceinline__ void operator()(const f32x4 (&acc)[2][2][4][2], const pg8::Unit& u, int wr, int wc, int fr, int fq) const {
        const int row0 = u.pm * 256 + wr * 64 + fr, col0 = u.pn * 256 + wc * 32 + 8 * fq;
        const bool rope = (u.pn >= 12) && (u.pn <= 16) && (u.pm < 128);
        const int modsel = u.pm < 64 ? 0 : (u.pm < 128 ? 1 : 2);
        f32x4 cv[2][2];
#pragma unroll
        for (int bj = 0; bj < 2; ++bj) { cv[bj][0] = (f32x4){0.f, 0.f, 0.f, 0.f}; cv[bj][1] = (f32x4){0.f, 0.f, 0.f, 0.f};
            if (ssq) { cv[bj][0] = *(const f32x4*)(cvec + modsel * ZN + col0 + bj * 128); cv[bj][1] = *(const f32x4*)(cvec + modsel * ZN + col0 + bj * 128 + 4); } }
#pragma unroll
        for (int ai = 0; ai < 2; ++ai)
#pragma unroll
            for (int m = 0; m < 4; ++m) {
                const int row = row0 + ai * 128 + m * 16;
                const float rs = ssq ? rsqrtf(ssq[row] * (1.f / DM) + 1e-6f) : 1.f;
                f32x4 cs = {1.f, 1.f, 1.f, 1.f}, sn = {0.f, 0.f, 0.f, 0.f};
                if (rope) { const int tok = row & (LSEQ - 1); const int pos = (wc < 2) ? (tok >> 6) : (tok & 63); const int f0 = 16 * (wc & 1) + 4 * fq;
                    cs = *(const f32x4*)(rcos + pos * 32 + f0); sn = *(const f32x4*)(rsin + pos * 32 + f0); }
#pragma unroll
                for (int bj = 0; bj < 2; ++bj) {
                    const int c = col0 + bj * 128;
                    if (c < ZLD) {
                        f32x4 v0 = acc[ai][bj][m][0] * rs + cv[bj][0], v1 = acc[ai][bj][m][1] * rs + cv[bj][1];
                        if (rope) { const f32x4 n0 = v0 * cs - v1 * sn, n1 = v1 * cs + v0 * sn; v0 = n0; v1 = n1; }
                        u32x4 w; w.x = cvt_pk_bf16(v0[0], v0[1]); w.y = cvt_pk_bf16(v0[2], v0[3]); w.z = cvt_pk_bf16(v1[0], v1[1]); w.w = cvt_pk_bf16(v1[2], v1[3]);
                        *(u32x4*)(Z + (size_t)row * ZLD + c) = w;
                    }
                }
            }
    }
};
struct EpiSq {
    static constexpr bool PERM = true;
    bf16_t* O; int ldc; const float* ssq; const float* cvec;
    __device__ __forceinline__ void operator()(const f32x4 (&acc)[2][2][4][2], const pg8::Unit& u, int wr, int wc, int fr, int fq) const {
        const int row0 = u.pm * 256 + wr * 64 + fr, col0 = u.pn * 256 + wc * 32 + 8 * fq;
        const int modsel = u.pm < 64 ? 0 : (u.pm < 128 ? 1 : 2);
        f32x4 cv[2][2];
#pragma unroll
        for (int bj = 0; bj < 2; ++bj) { cv[bj][0] = *(const f32x4*)(cvec + modsel * DFF + col0 + bj * 128); cv[bj][1] = *(const f32x4*)(cvec + modsel * DFF + col0 + bj * 128 + 4); }
#pragma unroll
        for (int ai = 0; ai < 2; ++ai)
#pragma unroll
            for (int m = 0; m < 4; ++m) { const int row = row0 + ai * 128 + m * 16; bf16_t* rowp = O + (size_t)row * ldc + col0;
                const float rs = rsqrtf(ssq[row] * (1.f / DM) + 1e-6f);
#pragma unroll
                for (int bj = 0; bj < 2; ++bj) { f32x4 v0 = acc[ai][bj][m][0] * rs + cv[bj][0], v1 = acc[ai][bj][m][1] * rs + cv[bj][1];
#pragma unroll
                    for (int j = 0; j < 4; ++j) { float a = fmaxf(v0[j], 0.f), b = fmaxf(v1[j], 0.f); v0[j] = a * a; v1[j] = b * b; }
                    u32x4 w; w.x = cvt_pk_bf16(v0[0], v0[1]); w.y = cvt_pk_bf16(v0[2], v0[3]); w.z = cvt_pk_bf16(v1[0], v1[1]); w.w = cvt_pk_bf16(v1[2], v1[3]);
                    *(u32x4*)(rowp + bj * 128) = w; } }
    }
};
struct EpiRes {
    static constexpr bool PERM = true;
    const float* lat_res; const float* ctx_res; float* lat_out; float* ctx_out; const float* gate;
    float* part; int ntfull;
    bf16_t* aout; const float* ng; const float* nsc; float* ssq;
    __device__ __forceinline__ void operator()(const f32x4 (&acc)[2][2][4][2], const pg8::Unit& u, int wr, int wc, int fr, int fq) const {
        const int row0 = u.pm * 256 + wr * 64 + fr, col0 = u.pn * 256 + wc * 32 + 8 * fq;
        if (u.nt != ntfull) {
            float* pp = part + (size_t)(u.k0 / (u.nt * 64)) * NCTX * DM;
#pragma unroll
            for (int ai = 0; ai < 2; ++ai)
#pragma unroll
                for (int m = 0; m < 4; ++m) { float* op = pp + (size_t)(row0 + ai * 128 + m * 16 - NLAT) * DM;
#pragma unroll
                    for (int bj = 0; bj < 2; ++bj)
#pragma unroll
                        for (int n = 0; n < 2; ++n) *(f32x4*)(op + col0 + bj * 128 + n * 4) = acc[ai][bj][m][n]; }
            return;
        }
        const int modsel = u.pm < 64 ? 0 : (u.pm < 128 ? 1 : 2);
        f32x4 gv[2][2];
#pragma unroll
        for (int bj = 0; bj < 2; ++bj)
#pragma unroll
            for (int n = 0; n < 2; ++n) gv[bj][n] = *(const f32x4*)(gate + modsel * 12288 + col0 + bj * 128 + n * 4);
        f32x4 gm[2][2];
        if (aout) {
#pragma unroll
            for (int bj = 0; bj < 2; ++bj)
#pragma unroll
                for (int n = 0; n < 2; ++n) { const int c = col0 + bj * 128 + n * 4; gm[bj][n] = *(const f32x4*)(ng + c) * (*(const f32x4*)(nsc + modsel * 12288 + c) + 1.f); }
        }
#pragma unroll
        for (int ai = 0; ai < 2; ++ai)
#pragma unroll
            for (int m = 0; m < 4; ++m) {
                const int row = row0 + ai * 128 + m * 16;
                const float* rp; float* op;
                if (row < NLAT) { rp = lat_res + (size_t)row * DM; op = lat_out + (size_t)row * DM; } else { rp = ctx_res + (size_t)(row - NLAT) * DM; op = ctx_out + (size_t)(row - NLAT) * DM; }
                float ss = 0.f;
#pragma unroll
                for (int bj = 0; bj < 2; ++bj) { const int c = col0 + bj * 128;
                    const f32x4 o0 = *(const f32x4*)(rp + c) + gv[bj][0] * acc[ai][bj][m][0], o1 = *(const f32x4*)(rp + c + 4) + gv[bj][1] * acc[ai][bj][m][1];
                    *(f32x4*)(op + c) = o0; *(f32x4*)(op + c + 4) = o1;
                    if (aout) { ss += o0[0] * o0[0] + o0[1] * o0[1] + o0[2] * o0[2] + o0[3] * o0[3] + o1[0] * o1[0] + o1[1] * o1[1] + o1[2] * o1[2] + o1[3] * o1[3];
                        const f32x4 a0 = o0 * gm[bj][0], a1 = o1 * gm[bj][1];
                        u32x4 w; w.x = cvt_pk_bf16(a0[0], a0[1]); w.y = cvt_pk_bf16(a0[2], a0[3]); w.z = cvt_pk_bf16(a1[0], a1[1]); w.w = cvt_pk_bf16(a1[2], a1[3]);
                        *(u32x4*)(aout + (size_t)row * DM + c) = w; } }
                if (aout) { ss += __shfl_xor(ss, 16); ss += __shfl_xor(ss, 32); if (fq == 0) atomicAdd(ssq + row, ss); }
                __builtin_amdgcn_sched_barrier(0);
            }
    }
};

struct EpiAny {
    unsigned char* ws; float* out; const float* rlat; const float* rctx; const float* ng;
    int mode, l, ssq_idx, gate_idx, aout_sel, nsc_off, ntfull; bool perm;
    __device__ __forceinline__ void operator()(const f32x4 (&acc)[2][2][4][2], const pg8::Unit& u, int wr, int wc, int fr, int fq) const {
        const float* rope = (const float*)(ws + WS_ROPE); const float* CV = (const float*)(ws + WS_CVEC) + (size_t)l * CV_L;
        float* SSQ = (float*)(ws + WS_SSQ); const float* MODA = (const float*)(ws + WS_MOD);
        if (mode == 0) { const EpiIn e{(bf16_t*)(ws + WS_H), rope, rope + 8192, ssq_idx >= 0 ? SSQ + (size_t)ssq_idx * NTOK : nullptr, CV}; e(acc, u, wr, wc, fr, fq); }
        else if (mode == 1) { const EpiSq e{(bf16_t*)(ws + WS_H), DFF, SSQ + (size_t)ssq_idx * NTOK, CV + 3 * ZN}; e(acc, u, wr, wc, fr, fq); }
        else { const EpiRes e{rlat, rctx, out, (float*)(ws + WS_XC), MODA + (size_t)l * 3 * 12288 + gate_idx * DM, (float*)(ws + WS_ABUF2), ntfull,
                              aout_sel == 0 ? nullptr : (bf16_t*)(ws + (aout_sel == 1 ? WS_ABUF : WS_ABUF2)), ng, MODA + nsc_off, SSQ + (size_t)ssq_idx * NTOK}; e(acc, u, wr, wc, fr, fq); }
    }
};

__device__ __forceinline__ void map_col_in(int n, int& src, float& scale) {
    if (n < 3072) { src = n; scale = (n < 512) ? QSCALE : ((n >= 1536 && n < 1792) ? 0.125f : 1.f); }
    else if (n < 4352) { const bool isq = n < 4096; const int base = isq ? 3072 : 4096, sbase = isq ? 3104 : 4128; const int hh = (n - base) >> 7, pp = (n - base) & 127;
        const int i = 4 * (pp >> 3) + (pp & 3), half = (pp >> 2) & 1; const int od = (i < 32 ? i : i + 32) + 32 * half; src = sbase + hh * 128 + od; scale = isq ? QSCALE : 1.f; }
    else if (n < 4608) { src = 4384 + (n - 4352); scale = 1.f; }
    else if (n < 4640) { src = 3072 + (n - 4608); scale = 1.f; }
    else { src = -1; scale = 0.f; }
}
__device__ void conv_tile(int tid_, int bid_, const float* __restrict__ w, int Nsrc, int K, bf16_t* __restrict__ Bt, int n0, int k0, int mode, LAS float* tile) {
    const int t = tid_;
    { const int n = t & 127, kq = t >> 7; int src = n0 + n; float scale = 1.f; if (mode) map_col_in(n0 + n, src, scale);
        float v[32];
#pragma unroll
        for (int i = 0; i < 32; ++i) v[i] = (src >= 0) ? w[(size_t)(k0 + kq + 4 * i) * Nsrc + src] : 0.f;
#pragma unroll
        for (int i = 0; i < 32; ++i) tile[(kq + 4 * i) * 129 + n] = v[i] * scale; }
    __syncthreads();
    { const int n2 = t >> 2, kc = t & 3;
#pragma unroll
        for (int u = 0; u < 4; ++u) { float v[8];
#pragma unroll
            for (int j = 0; j < 8; ++j) v[j] = tile[(32 * kc + 8 * u + j) * 129 + n2];
            u32x4 pk; pk.x = cvt_pk_bf16(v[0], v[1]); pk.y = cvt_pk_bf16(v[2], v[3]); pk.z = cvt_pk_bf16(v[4], v[5]); pk.w = cvt_pk_bf16(v[6], v[7]);
            *(u32x4*)(Bt + (size_t)(n0 + n2) * K + k0 + 32 * kc + 8 * u) = pk; } }
    __syncthreads();
}
__device__ void phase0(int tid_, int bid_, const P& p, LAS unsigned char* lds) {
    LAS float* tile = (LAS float*)lds;
    LAS float* act = (LAS float*)(lds + 66560);
    LAS float* red = (LAS float*)(lds + 66560 + 24576);
    const int t = tid_;
    for (int i = t; i < 3 * 2048; i += 512) { const int v = i >> 11, k = i & 2047; const float xv = v < 2 ? p.c[v * 2048 + k] : p.c_ctx[k]; act[i] = xv / (1.f + __expf(-xv)); }
    { const int idx = bid_ * 512 + t; if (idx < 8192) { const int pos = idx >> 5, f = idx & 31; const double inv = pow(10000.0, -(double)f / 32.0); const double a = (double)pos * inv;
            float* rc = (float*)(p.ws + WS_ROPE); rc[idx] = (float)cos(a); rc[8192 + idx] = (float)sin(a); } }
    { float* sq = (float*)(p.ws + WS_SSQ); for (int i = bid_ * 512 + t; i < 3 * NTOK; i += gridDim.x * 512) sq[i] = 0.f; }
    __syncthreads();
    const int NGEMV = 768, NCONV = 2912;
    for (int it = bid_; it < NGEMV + 2 * NCONV; it += gridDim.x) {
        if (it < NGEMV) {
            const int l = it / 384, c0 = (it % 384) * 32; const int cq = t & 7, kg = t >> 3;
            float a0[4] = {0, 0, 0, 0}, a1[4] = {0, 0, 0, 0}, a2[4] = {0, 0, 0, 0};
            const float* wp = p.w_mod + (size_t)l * 2048 * 12288 + c0 + 4 * cq;
#pragma unroll 8
            for (int kk = 0; kk < 32; ++kk) { const int k = kg * 32 + kk; const f32x4 w4 = *(const f32x4*)(wp + (size_t)k * 12288); const float x0 = act[k], x1 = act[2048 + k], x2 = act[4096 + k];
#pragma unroll
                for (int j = 0; j < 4; ++j) { a0[j] += x0 * w4[j]; a1[j] += x1 * w4[j]; a2[j] += x2 * w4[j]; } }
#pragma unroll
            for (int j = 0; j < 4; ++j) { red[(kg * 3 + 0) * 32 + 4 * cq + j] = a0[j]; red[(kg * 3 + 1) * 32 + 4 * cq + j] = a1[j]; red[(kg * 3 + 2) * 32 + 4 * cq + j] = a2[j]; }
            __syncthreads();
            if (t < 96) { const int v = t >> 5, cc = t & 31; float s = 0.f; for (int g = 0; g < 64; ++g) s += red[(g * 3 + v) * 32 + cc];
                ((float*)(p.ws + WS_MOD))[(size_t)(l * 3 + v) * 12288 + c0 + cc] = s + p.b_mod[l * 12288 + c0 + cc]; }
            __syncthreads();
        } else {
            int r = it - NGEMV; const int l = r / NCONV; r -= l * NCONV;
            bf16_t* wb = (bf16_t*)(p.ws + WS_W + (size_t)l * SZ_WL);
            if (r < 608) { conv_tile(tid_, bid_, p.w_in + (size_t)l * DM * ZLD, ZLD, DM, wb, (r / 16) * 128, (r % 16) * 128, 1, tile); }
            else if (r < 864) { r -= 608; conv_tile(tid_, bid_, p.w_out + (size_t)l * DM * DM, DM, DM, wb + (size_t)ZN * DM, (r / 16) * 128, (r % 16) * 128, 0, tile); }
            else if (r < 1888) { r -= 864; conv_tile(tid_, bid_, p.w_ff1 + (size_t)l * DM * DFF, DFF, DM, wb + (size_t)ZN * DM + (size_t)DM * DM, (r / 16) * 128, (r % 16) * 128, 0, tile); }
            else { r -= 1888; conv_tile(tid_, bid_, p.w_ff2 + (size_t)l * DFF * DM, DM, DFF, wb + (size_t)ZN * DM + (size_t)DM * DM + (size_t)DFF * DM, (r / 64) * 128, (r % 64) * 128, 0, tile); }
        }
    }
}

__device__ void phase_norm(int tid_, int bid_, const P& p, int l, int which, const float* lat_src, const float* ctx_src, int nrows) {
    const int lane = tid_ & 63, wid = tid_ >> 6;
    bf16_t* A = (bf16_t*)(p.ws + WS_ABUF);
    const float* g = (which == 1 ? p.n1g : p.n2g) + l * DM;
    const float* mod = (const float*)(p.ws + WS_MOD) + (size_t)l * 3 * 12288;
    for (int row = bid_ * 8 + wid; row < nrows; row += gridDim.x * 8) {
        const float* xr = row < NLAT ? lat_src + (size_t)row * DM : ctx_src + (size_t)(row - NLAT) * DM;
        f32x4 v[8]; float ss = 0.f;
#pragma unroll
        for (int i = 0; i < 8; ++i) { v[i] = ((const f32x4*)xr)[lane + 64 * i]; ss += v[i][0] * v[i][0] + v[i][1] * v[i][1] + v[i][2] * v[i][2] + v[i][3] * v[i][3]; }
        ss = wave_sum(ss);
        const float rstd = rsqrtf(ss * (1.f / DM) + 1e-6f);
        const int modsel = row < LSEQ ? 0 : (row < NLAT ? 1 : 2);
        const float* sh = mod + modsel * 12288 + (which == 1 ? 0 : 3) * DM; const float* sc = sh + DM;
#pragma unroll
        for (int i = 0; i < 8; ++i) { const int c = 4 * (lane + 64 * i); const f32x4 g4 = *(const f32x4*)(g + c), s4 = *(const f32x4*)(sh + c), c4 = *(const f32x4*)(sc + c);
            float o[4];
#pragma unroll
            for (int j = 0; j < 4; ++j) o[j] = v[i][j] * rstd * g4[j] * (1.f + c4[j]) + s4[j];
            uint2 w; w.x = cvt_pk_bf16(o[0], o[1]); w.y = cvt_pk_bf16(o[2], o[3]); *(uint2*)(A + (size_t)row * DM + c) = w; }
    }
}
__device__ void phase_cvec(int tid_, int bid_, const P& p, LAS unsigned char* lds) {
    const int lane = tid_ & 63, wid = tid_ >> 6;
    LAS float* shv = (LAS float*)lds;
    const float* MOD = (const float*)(p.ws + WS_MOD);
    for (int i = tid_; i < 9 * 2048; i += 512) { const int set = i / 6144, r = i - set * 6144, v = r >> 11, k = r & 2047; const int l = set == 0 ? 0 : 1, idx = set == 1 ? 0 : 3;
        shv[i] = MOD[(size_t)(l * 3 + v) * 12288 + idx * 2048 + k]; }
    __syncthreads();
    float* CV = (float*)(p.ws + WS_CVEC);
    const int NR = DFF + ZN + DFF;
    for (int rr = bid_ * 8 + wid; rr < NR; rr += gridDim.x * 8) {
        int set, n, l, ncols; const bf16_t* wrow; float* outp;
        const bf16_t* wb0 = (const bf16_t*)(p.ws + WS_W); const bf16_t* wb1 = (const bf16_t*)(p.ws + WS_W + SZ_WL);
        if (rr < DFF) { set = 0; n = rr; l = 0; wrow = wb0 + (size_t)ZN * DM + (size_t)DM * DM + (size_t)n * DM; outp = CV + 3 * ZN + n; ncols = DFF; }
        else if (rr < DFF + ZN) { set = 1; n = rr - DFF; l = 1; wrow = wb1 + (size_t)n * DM; outp = CV + CV_L + n; ncols = ZN; }
        else { set = 2; n = rr - DFF - ZN; l = 1; wrow = wb1 + (size_t)ZN * DM + (size_t)DM * DM + (size_t)n * DM; outp = CV + CV_L + 3 * ZN + n; ncols = DFF; }
        float a0 = 0.f, a1 = 0.f, a2 = 0.f;
#pragma unroll
        for (int i = 0; i < 4; ++i) { const int k0 = lane * 8 + 512 * i; const u32x4 w = *(const u32x4*)(wrow + k0);
            const float wf[8] = {bflo(w.x), bfhi(w.x), bflo(w.y), bfhi(w.y), bflo(w.z), bfhi(w.z), bflo(w.w), bfhi(w.w)};
            const LAS float* s0 = shv + set * 6144 + k0;
#pragma unroll
            for (int j = 0; j < 8; ++j) { a0 += wf[j] * s0[j]; a1 += wf[j] * s0[2048 + j]; a2 += wf[j] * s0[4096 + j]; } }
        a0 = wave_sum(a0); a1 = wave_sum(a1); a2 = wave_sum(a2);
        if (lane == 0) { outp[0] = a0; outp[ncols] = a1; outp[2 * ncols] = a2; }
    }
}
__device__ void phase_ctxfix(int tid_, int bid_, const P& p) {
    const int lane = tid_ & 63, wid = tid_ >> 6;
    float* XC = (float*)(p.ws + WS_XC); const float* PART = (const float*)(p.ws + WS_ABUF2); bf16_t* A = (bf16_t*)(p.ws + WS_ABUF); float* SSQ = (float*)(p.ws + WS_SSQ) + NTOK;
    const float* MOD = (const float*)(p.ws + WS_MOD);
    const float* ga2 = MOD + (size_t)2 * 12288 + 5 * DM;
    const float* sc1 = MOD + (size_t)(3 + 2) * 12288 + 1 * DM;
    const float* g1 = p.n1g + DM;
    for (int idx = bid_ * 8 + wid; idx < NCTX * 4; idx += gridDim.x * 8) {
        const int r = idx >> 2, c0 = (idx & 3) * 512 + lane * 8;
        f32x4 s0 = {0.f, 0.f, 0.f, 0.f}, s1 = {0.f, 0.f, 0.f, 0.f};
#pragma unroll
        for (int sl = 0; sl < 16; ++sl) { const float* pp = PART + ((size_t)sl * NCTX + r) * DM + c0; s0 += *(const f32x4*)pp; s1 += *(const f32x4*)(pp + 4); }
        float* xp = XC + (size_t)r * DM + c0;
        const f32x4 x0 = *(const f32x4*)xp + *(const f32x4*)(ga2 + c0) * s0, x1 = *(const f32x4*)(xp + 4) + *(const f32x4*)(ga2 + c0 + 4) * s1;
        *(f32x4*)xp = x0; *(f32x4*)(xp + 4) = x1;
        float ss = x0[0] * x0[0] + x0[1] * x0[1] + x0[2] * x0[2] + x0[3] * x0[3] + x1[0] * x1[0] + x1[1] * x1[1] + x1[2] * x1[2] + x1[3] * x1[3];
        const f32x4 a0 = x0 * (*(const f32x4*)(g1 + c0)) * (*(const f32x4*)(sc1 + c0) + 1.f), a1 = x1 * (*(const f32x4*)(g1 + c0 + 4)) * (*(const f32x4*)(sc1 + c0 + 4) + 1.f);
        u32x4 w; w.x = cvt_pk_bf16(a0[0], a0[1]); w.y = cvt_pk_bf16(a0[2], a0[3]); w.z = cvt_pk_bf16(a1[0], a1[1]); w.w = cvt_pk_bf16(a1[2], a1[3]);
        *(u32x4*)(A + (size_t)(NLAT + r) * DM + c0) = w;
        ss = wave_sum(ss); if (lane == 0) atomicAdd(SSQ + NLAT + r, ss);
    }
}
__device__ void phase_final(int tid_, int bid_, const P& p) {
    const int lane = tid_ & 63, wid = tid_ >> 6;
    for (int row = bid_ * 8 + wid; row < NLAT; row += gridDim.x * 8) {
        float* xr = p.out + (size_t)row * DM;
        f32x4 v[8]; float ss = 0.f;
#pragma unroll
        for (int i = 0; i < 8; ++i) { v[i] = ((const f32x4*)xr)[lane + 64 * i]; ss += v[i][0] * v[i][0] + v[i][1] * v[i][1] + v[i][2] * v[i][2] + v[i][3] * v[i][3]; }
        ss = wave_sum(ss);
        const float rstd = rsqrtf(ss * (1.f / DM) + 1e-6f);
#pragma unroll
        for (int i = 0; i < 8; ++i) { const int c = 4 * (lane + 64 * i); const f32x4 g4 = *(const f32x4*)(p.fng + c); ((f32x4*)xr)[lane + 64 * i] = v[i] * rstd * g4; }
    }
}

__device__ void attn_simple(int tid_, int bid_, const P& p, int l, bool with_ctx, LAS unsigned char* lds) {
    const int lane = tid_ & 63, wid = tid_ >> 6;
    const bf16_t* Z = (const bf16_t*)(p.ws + WS_H);
    bf16_t* Y = (bf16_t*)(p.ws + WS_ABUF);
    LAS float* sc = (LAS float*)lds + wid * 576;
    const int nq_lat = NLAT * 12; const int nq = nq_lat + (with_ctx ? NCTX * 12 : 0);
    const int gw = bid_ * 8 + wid, nw = gridDim.x * 8;
    for (int it = gw; it < nq; it += nw) {
        int tok, hs; bool isctx;
        if (it < nq_lat) { tok = it / 12; hs = it - tok * 12; isctx = false; } else { const int r = it - nq_lat; tok = NLAT + r / 12; hs = r % 12; isctx = true; }
        const int b = isctx ? ((tok - NLAT) >> 8) : (tok >> 14);
        const bool na = hs < 4;
        int qcol, kcol, vcol, ycol;
        if (na) { qcol = C_NAQ + hs * 128; kcol = C_NAK + hs * 128; vcol = C_NAV + hs * 128; ycol = hs * 128; }
        else { const int h = hs - 4; qcol = C_SQ + h * 128; kcol = C_SK + (h >> 2) * 128; vcol = C_SV + (h >> 2) * 128; ycol = 1024 + h * 128; }
        int nloc = 0, lo = 0, rs = 0, cs = 0, r = 0, cpos = 0;
        if (!isctx) { const int t = tok & (LSEQ - 1);
            if (na) { r = t >> 6; cpos = t & 63; rs = min(max(r - 4, 0), 248); cs = min(max(cpos - 8, 0), 48); nloc = 128; }
            else { lo = max(t - 128, 0); const int hi = min(t + 128, LSEQ - 1); nloc = hi - lo + 1; } }
        const int nk = nloc + 256; const int ctxbase = NLAT + b * 256, latbase = b * LSEQ;
        u32x4 q[16]; { const u32x4* qp = (const u32x4*)(Z + (size_t)tok * ZLD + qcol);
#pragma unroll
            for (int i = 0; i < 16; ++i) q[i] = qp[i]; }
        const float* rp = p.rpb + (size_t)l * 4 * 465 + (na ? hs : 0) * 465;
        float mx = -3.0e38f;
        for (int j = lane; j < nk; j += 64) {
            int kt; float bias = 0.f;
            if (j < nloc) { if (na) { const int kr = rs + (j >> 4), kc = cs + (j & 15); kt = latbase + kr * 64 + kc; bias = rp[(kr - r + 7) * 31 + (kc - cpos + 15)] * LOG2E; } else kt = latbase + lo + j; }
            else kt = ctxbase + (j - nloc);
            const u32x4* kp = (const u32x4*)(Z + (size_t)kt * ZLD + kcol);
            float s = 0.f;
#pragma unroll
            for (int i = 0; i < 16; ++i) s += dot8(q[i], kp[i]);
            s += bias; sc[j] = s; mx = fmaxf(mx, s);
        }
        mx = wave_max(mx);
        float snk = 0.f; if (!na) { snk = p.sink[l * 8 + (hs - 4)] * LOG2E; mx = fmaxf(mx, snk); }
        float sum = 0.f;
        for (int j = lane; j < nk; j += 64) { const float pj = exp2f(sc[j] - mx); sc[j] = pj; sum += pj; }
        sum = wave_sum(sum); if (!na) sum += exp2f(snk - mx);
        float o0 = 0.f, o1 = 0.f;
#pragma unroll 4
        for (int j = 0; j < nk; ++j) {
            int kt;
            if (j < nloc) { if (na) kt = latbase + (rs + (j >> 4)) * 64 + cs + (j & 15); else kt = latbase + lo + j; } else kt = ctxbase + (j - nloc);
            const float pj = sc[j]; const unsigned vv = *(const unsigned*)(Z + (size_t)kt * ZLD + vcol + 2 * lane);
            o0 += pj * bflo(vv); o1 += pj * bfhi(vv);
        }
        const float inv = 1.f / sum;
        *(unsigned*)(Y + (size_t)tok * DM + ycol + 2 * lane) = cvt_pk_bf16(o0 * inv, o1 * inv);
    }
}

__device__ __forceinline__ float grp_max4(float v) {
    unsigned a = __float_as_uint(v); auto r = __builtin_amdgcn_permlane16_swap(a, a, false, false); v = fmaxf(__uint_as_float(r[0]), __uint_as_float(r[1]));
    a = __float_as_uint(v); auto r2 = __builtin_amdgcn_permlane32_swap(a, a, false, false); return fmaxf(__uint_as_float(r2[0]), __uint_as_float(r2[1]));
}
__device__ __forceinline__ float grp_sum4(float v) {
    unsigned a = __float_as_uint(v); auto r = __builtin_amdgcn_permlane16_swap(a, a, false, false); v = __uint_as_float(r[0]) + __uint_as_float(r[1]);
    a = __float_as_uint(v); auto r2 = __builtin_amdgcn_permlane32_swap(a, a, false, false); return __uint_as_float(r2[0]) + __uint_as_float(r2[1]);
}
typedef short s16x4 __attribute__((ext_vector_type(4)));
__device__ __forceinline__ unsigned att_koff(int row, int ch) { return (unsigned)(row * 256 + ((ch ^ ((row & 3) | (((row >> 3) & 3) << 2))) << 4)); }
__device__ __forceinline__ unsigned att_voff(int row, int ch) { return (unsigned)(row * 256 + ((ch ^ (((row & 3) << 2) | ((row >> 2) & 3))) << 4)); }
constexpr float ATT_MASKED = -1.0e30f, ATT_MINIT = -5.0e29f;
__device__ void attn_mfma(int tid_, int bid_, const P& p, int l, bool with_ctx, LAS unsigned char* lds) {
    const int lane = tid_ & 63, wid = __builtin_amdgcn_readfirstlane(tid_ >> 6), l15 = lane & 15, lg = lane >> 4;
    const bf16_t* Z = (const bf16_t*)(p.ws + WS_H);
    bf16_t* Y = (bf16_t*)(p.ws + WS_ABUF);
    LAS float* rpbs = (LAS float*)(lds + 65536);
    const int n_swa = 1024, n_na = 512, n_ctx = with_ctx ? 24 : 0;
    unsigned kx[4];
#pragma unroll
    for (int kk = 0; kk < 4; ++kk) kx[kk] = (unsigned)((8 * (l15 >> 2) + (l15 & 3)) * 256 + (((4 * kk + lg) ^ l15) << 4));
    const int vq = l15 >> 2, vp = lane & 3;
    unsigned vrow[2], vx[2];
#pragma unroll
    for (int t = 0; t < 2; ++t) { vrow[t] = (unsigned)((8 * lg + 4 * t + vq) * 256 + 8 * (vp & 1)); vx[t] = (unsigned)((vq << 2) | ((2 * lg + t) & 3)); }
    int st_row[2], st_ch[2];
#pragma unroll
    for (int i = 0; i < 2; ++i) { const int idx = tid_ + 512 * i; st_row[i] = idx >> 4; st_ch[i] = idx & 15; }

    for (int item = bid_; item < n_swa + n_na + n_ctx; item += gridDim.x) {
        int type, b, kcol, vcol, nloc = 0, loc_tok0 = 0, loc_pos0 = 0, qtok0, qcol, ycol, qpos0 = 0, r_na = 0, rs_lo = 0, rsr = 0, hbias = 0;
        bool has_sink = false; float sinkv = 0.f;
        if (item < n_swa) {
            type = 0; b = item >> 9; const int g = (item >> 8) & 1, m = item & 255; const int h = 4 * g + (wid >> 1);
            qpos0 = 64 * m + 32 * (wid & 1); qtok0 = b * LSEQ + qpos0; qcol = C_SQ + h * 128; ycol = 1024 + h * 128; kcol = C_SK + g * 128; vcol = C_SV + g * 128;
            const int c_lo = max(0, 2 - m), c_hi = min(4, 257 - m); nloc = c_hi - c_lo + 1; loc_pos0 = 64 * (m - 2 + c_lo); loc_tok0 = b * LSEQ + loc_pos0;
            has_sink = true; sinkv = p.sink[l * 8 + h] * LOG2E;
        } else if (item < n_swa + n_na) {
            type = 1; const int it = item - n_swa; b = it >> 8; const int h = (it >> 6) & 3, R4 = it & 63; r_na = 4 * R4 + (wid >> 1); qpos0 = 32 * (wid & 1);
            qtok0 = b * LSEQ + r_na * 64 + qpos0; qcol = C_NAQ + h * 128; ycol = h * 128; kcol = C_NAK + h * 128; vcol = C_NAV + h * 128; hbias = h;
            rs_lo = min(max(4 * R4 - 4, 0), 248); const int rs_hi = min(max(4 * R4 - 1, 0), 248) + 7; nloc = rs_hi - rs_lo + 1; loc_tok0 = b * LSEQ + rs_lo * 64;
            rsr = min(max(r_na - 4, 0), 248);
        } else {
            type = 2; int it = item - n_swa - n_na;
            if (it < 8) { b = it >> 2; const int h = it & 3; qcol = C_NAQ + h * 128; ycol = h * 128; kcol = C_NAK + h * 128; vcol = C_NAV + h * 128; }
            else { it -= 8; b = it >> 3; const int h = it & 7; qcol = C_SQ + h * 128; ycol = 1024 + h * 128; kcol = C_SK + (h >> 2) * 128; vcol = C_SV + (h >> 2) * 128; has_sink = true; sinkv = p.sink[l * 8 + h] * LOG2E; }
            qtok0 = NLAT + b * 256 + 32 * wid;
        }
        const int nch = nloc + 4; const int ctx_tok0 = NLAT + b * 256;
        if (type == 1) { for (int i = tid_; i < 465; i += 512) rpbs[i] = p.rpb[(size_t)(l * 4 + hbias) * 465 + i] * LOG2E; }
        bf16x8 Qf[2][4];
#pragma unroll
        for (int qt = 0; qt < 2; ++qt)
#pragma unroll
            for (int kk = 0; kk < 4; ++kk) Qf[qt][kk] = *(const bf16x8*)(Z + (size_t)(qtok0 + 16 * qt + l15) * ZLD + qcol + 32 * kk + 8 * lg);
        f32x4 O[8][2];
#pragma unroll
        for (int dt = 0; dt < 8; ++dt) { O[dt][0] = (f32x4){0.f, 0.f, 0.f, 0.f}; O[dt][1] = (f32x4){0.f, 0.f, 0.f, 0.f}; }
        float mrun[2] = {ATT_MINIT, ATT_MINIT}, lsum[2] = {0.f, 0.f};
        u32x4 kr[2], vr[2];
#define ATT_LOAD(tokb) do { _Pragma("unroll") for (int i = 0; i < 2; ++i) { const bf16_t* src = Z + (size_t)((tokb) + st_row[i]) * ZLD + st_ch[i] * 8; kr[i] = *(const u32x4*)(src + kcol); vr[i] = *(const u32x4*)(src + vcol); } } while (0)
#define ATT_STORE(buf) do { _Pragma("unroll") for (int i = 0; i < 2; ++i) { *(LAS u32x4*)(lds + (buf) * 16384 + att_koff(st_row[i], st_ch[i])) = kr[i]; *(LAS u32x4*)(lds + 32768 + (buf) * 16384 + att_voff(st_row[i], st_ch[i])) = vr[i]; } } while (0)
#define ATT_TOK(c) ((c) < nloc ? loc_tok0 + 64 * (c) : ctx_tok0 + 64 * ((c) - nloc))
        ATT_LOAD(ATT_TOK(0)); ATT_STORE(0); __syncthreads();
        for (int c = 0; c < nch; ++c) {
            if (c + 1 < nch) ATT_LOAD(ATT_TOK(c + 1));
            const bool is_loc = c < nloc;
            LAS unsigned char* Kb = lds + (c & 1) * 16384; LAS unsigned char* Vb = lds + 32768 + (c & 1) * 16384;
#pragma unroll 1
            for (int blk = 0; blk < 2; ++blk) {
                bool rel = true; int kb = 0, kr_na = 0;
                if (is_loc) { if (type == 0) { kb = loc_pos0 + 64 * c + 32 * blk; rel = (kb + 31 >= qpos0 - 128) && (kb <= qpos0 + 159); } else { kr_na = rs_lo + c; rel = (kr_na >= rsr) && (kr_na <= rsr + 7); } }
                if (!rel) continue;
                f32x4 s[2][2];
#pragma unroll
                for (int kt = 0; kt < 2; ++kt) { s[kt][0] = (f32x4){0.f, 0.f, 0.f, 0.f}; s[kt][1] = (f32x4){0.f, 0.f, 0.f, 0.f}; }
#pragma unroll
                for (int kk = 0; kk < 4; ++kk)
#pragma unroll
                    for (int kt = 0; kt < 2; ++kt) { const bf16x8 kf = *(const LAS bf16x8*)(Kb + kx[kk] + (32 * blk + 4 * kt) * 256);
                        s[kt][0] = __builtin_amdgcn_mfma_f32_16x16x32_bf16(kf, Qf[0][kk], s[kt][0], 0, 0, 0); s[kt][1] = __builtin_amdgcn_mfma_f32_16x16x32_bf16(kf, Qf[1][kk], s[kt][1], 0, 0, 0); }
                if (is_loc) {
                    if (type == 0) { if (!((kb >= qpos0 - 97) && (kb <= qpos0 + 97))) { const int dq = kb + 8 * lg - qpos0 - l15;
#pragma unroll
                        for (int kt = 0; kt < 2; ++kt)
#pragma unroll
                            for (int qt = 0; qt < 2; ++qt)
#pragma unroll
                                for (int j = 0; j < 4; ++j) { const int d = dq + 4 * kt + j - 16 * qt; s[kt][qt][j] = (d <= 128 && d >= -128) ? s[kt][qt][j] : ATT_MASKED; } }
                    } else { const int rowoff = (kr_na - r_na + 7) * 31;
#pragma unroll
                        for (int qt = 0; qt < 2; ++qt) { const int qc = qpos0 + 16 * qt + l15; const int cs = min(max(qc - 8, 0), 48);
#pragma unroll
                            for (int kt = 0; kt < 2; ++kt)
#pragma unroll
                                for (int j = 0; j < 4; ++j) { const int kc = 32 * blk + 8 * lg + 4 * kt + j; const bool valid = (kc >= cs) && (kc < cs + 16);
                                    const int bi = min(max(kc - qc + 15, 0), 30); const float bias = rpbs[rowoff + bi]; s[kt][qt][j] = valid ? s[kt][qt][j] + bias : ATT_MASKED; } }
                    }
                }
                bf16x8 pk[2];
#pragma unroll
                for (int qt = 0; qt < 2; ++qt) {
                    float ml = fmaxf(fmaxf(fmaxf(s[0][qt][0], s[0][qt][1]), fmaxf(s[0][qt][2], s[0][qt][3])), fmaxf(fmaxf(s[1][qt][0], s[1][qt][1]), fmaxf(s[1][qt][2], s[1][qt][3])));
                    ml = grp_max4(ml);
                    const float mn = fmaxf(mrun[qt], ml); const float alpha = __builtin_amdgcn_exp2f(mrun[qt] - mn); mrun[qt] = mn;
                    float ps = 0.f; float pv[8];
#pragma unroll
                    for (int kt = 0; kt < 2; ++kt)
#pragma unroll
                        for (int j = 0; j < 4; ++j) { const float e = __builtin_amdgcn_exp2f(s[kt][qt][j] - mn); pv[4 * kt + j] = e; ps += e; }
                    lsum[qt] = lsum[qt] * alpha + ps;
                    if (__any(alpha != 1.f)) {
#pragma unroll
                        for (int dt = 0; dt < 8; ++dt) O[dt][qt] *= alpha; }
                    u32x4 w; w.x = cvt_pk_bf16(pv[0], pv[1]); w.y = cvt_pk_bf16(pv[2], pv[3]); w.z = cvt_pk_bf16(pv[4], pv[5]); w.w = cvt_pk_bf16(pv[6], pv[7]);
                    pk[qt] = __builtin_bit_cast(bf16x8, w);
                }
#pragma unroll
                for (int dt = 0; dt < 8; ++dt) {
                    const s16x4 v0 = __builtin_amdgcn_ds_read_tr16_b64_v4i16((LAS s16x4*)(Vb + vrow[0] + blk * 8192 + ((((unsigned)(2 * dt + (vp >> 1))) ^ vx[0]) << 4)));
                    const s16x4 v1 = __builtin_amdgcn_ds_read_tr16_b64_v4i16((LAS s16x4*)(Vb + vrow[1] + blk * 8192 + ((((unsigned)(2 * dt + (vp >> 1))) ^ vx[1]) << 4)));
                    const bf16x8 vf = {v0[0], v0[1], v0[2], v0[3], v1[0], v1[1], v1[2], v1[3]};
                    O[dt][0] = __builtin_amdgcn_mfma_f32_16x16x32_bf16(vf, pk[0], O[dt][0], 0, 0, 0); O[dt][1] = __builtin_amdgcn_mfma_f32_16x16x32_bf16(vf, pk[1], O[dt][1], 0, 0, 0);
                }
            }
            if (c + 1 < nch) ATT_STORE((c + 1) & 1);
            __syncthreads();
        }
#undef ATT_LOAD
#undef ATT_STORE
#undef ATT_TOK
#pragma unroll
        for (int qt = 0; qt < 2; ++qt) {
            float lt = grp_sum4(lsum[qt]);
            if (has_sink) lt += exp2f(fminf(sinkv - mrun[qt], 126.f));
            const float inv = 1.f / lt;
            LAS unsigned char* ob = lds + LDS_OUTB + wid * 8192 + (16 * qt + l15) * 256;
#pragma unroll
            for (int dt = 0; dt < 8; ++dt) { u32x2v w; w.x = cvt_pk_bf16(O[dt][qt][0] * inv, O[dt][qt][1] * inv); w.y = cvt_pk_bf16(O[dt][qt][2] * inv, O[dt][qt][3] * inv);
                *(LAS u32x2v*)(ob + ((((2 * dt + (lg >> 1)) ^ l15)) << 4) + 8 * (lg & 1)) = w; }
        }
        {
            const LAS unsigned char* ow = lds + LDS_OUTB + wid * 8192;
#pragma unroll
            for (int k = 0; k < 8; ++k) { const int row = 4 * k + lg, ch = l15; const u32x4 w = *(const LAS u32x4*)(ow + row * 256 + ((ch ^ (row & 15)) << 4));
                *(u32x4*)(Y + (size_t)(qtok0 + row) * DM + ycol + 8 * ch) = w; }
        }
    }
}

__device__ __forceinline__ int gla_tokbase(int b, int s) { return s < 4 ? NLAT + b * 256 + s * 64 : b * LSEQ + (s - 4) * 64; }
constexpr int GLD = 68;
__device__ void gla_gates(int tid_, int bid_, const P& p, int l, int h, int tokbase, LAS float* B, LAS float* gl, LAS float* tot) {
    const int t = tid_; const bf16_t* Z = (const bf16_t*)(p.ws + WS_H);
    for (int i = t; i < 64 * 32; i += 512) { const int j = i >> 5, r = i & 31; gl[i] = bf2f(Z[(size_t)(tokbase + j) * ZLD + C_GFL + r]); }
    __syncthreads();
    const int dir = t >> 8, seg = (t >> 6) & 3, k = t & 63;
    const float* wg = (dir ? p.wgb : p.wgf) + l * 16 * 256 + h * 64 + k; float w[16];
#pragma unroll
    for (int r = 0; r < 16; ++r) w[r] = wg[r * 256];
    const float bg = (dir ? p.bgb : p.bgf)[l * 256 + h * 64 + k];
    float run = 0.f;
    for (int jj = 0; jj < 16; ++jj) { const int j = dir ? (seg * 16 + 15 - jj) : (seg * 16 + jj); float u = bg;
#pragma unroll
        for (int r = 0; r < 16; ++r) u += gl[j * 32 + dir * 16 + r] * w[r];
        const float g = -(fmaxf(-u, 0.f) + log1pf(__expf(-fabsf(u)))) * (1.f / 16.f); run += g; B[(dir * 64 + j) * GLD + k] = run; }
    tot[(dir * 4 + seg) * 64 + k] = run;
    __syncthreads();
}
__device__ __forceinline__ float gla_off(LAS const float* tot, int dir, int j, int k) {
    const int seg = j >> 4; float o = 0.f;
    if (!dir) { for (int s = 0; s < 3; ++s) if (s < seg) o += tot[s * 64 + k]; } else { for (int s = 1; s < 4; ++s) if (s > seg) o += tot[(4 + s) * 64 + k]; }
    return o;
}
__device__ void gla_g1(int tid_, int bid_, const P& p, int l, LAS unsigned char* lds) {
    LAS float* B = (LAS float*)lds;
    LAS float* V = (LAS float*)(lds + 36864);
    LAS float* gl = (LAS float*)(lds + 36864 + 32768);
    LAS float* tot = (LAS float*)(lds + 36864 + 32768 + 8192);
    const bf16_t* Z = (const bf16_t*)(p.ws + WS_H); float* ST = (float*)(p.ws + WS_ST); float* DEC = (float*)(p.ws + WS_DEC);
    const int t = tid_;
    for (int item = bid_; item < 520 * 4; item += gridDim.x) {
        const int h = item & 3, cs = item >> 2, b = cs / 260, s = cs - b * 260; const int tb = gla_tokbase(b, s);
        gla_gates(tid_, bid_, p, l, h, tb, B, gl, tot);
        for (int i = t; i < 64 * 16; i += 512) { const int j = i >> 4, c8 = (i & 15) * 8; const u32x4 u = *(const u32x4*)(Z + (size_t)(tb + j) * ZLD + C_GV + h * 128 + c8);
            LAS float* d = V + j * 128 + c8; d[0] = bflo(u.x); d[1] = bfhi(u.x); d[2] = bflo(u.y); d[3] = bfhi(u.y); d[4] = bflo(u.z); d[5] = bfhi(u.z); d[6] = bflo(u.w); d[7] = bfhi(u.w); }
        for (int e = t; e < 2 * 4096; e += 512) { const int dir = e >> 12, j = (e >> 6) & 63, k = e & 63;
            const float total = tot[(dir * 4 + 0) * 64 + k] + tot[(dir * 4 + 1) * 64 + k] + tot[(dir * 4 + 2) * 64 + k] + tot[(dir * 4 + 3) * 64 + k];
            const float bb = B[(dir * 64 + j) * GLD + k] + gla_off(tot, dir, j, k);
            const float kv = bf2f(Z[(size_t)(tb + j) * ZLD + C_GK + h * 64 + k]);
            B[(dir * 64 + j) * GLD + k] = kv * __expf(total - bb);
            if (j == 0) DEC[(size_t)(((dir * 2 + b) * 260 + s) * 4 + h) * 64 + k] = __expf(total); }
        __syncthreads();
        { const int vq = t & 31, kk = t >> 5; float af[4][4], ab[4][4];
#pragma unroll
            for (int a = 0; a < 4; ++a)
#pragma unroll
                for (int c = 0; c < 4; ++c) { af[a][c] = 0.f; ab[a][c] = 0.f; }
            for (int j = 0; j < 64; ++j) { const f32x4 v4 = *(const LAS f32x4*)(V + j * 128 + 4 * vq); const f32x4 kf = *(const LAS f32x4*)(B + j * GLD + 4 * kk), kb = *(const LAS f32x4*)(B + (64 + j) * GLD + 4 * kk);
#pragma unroll
                for (int a = 0; a < 4; ++a)
#pragma unroll
                    for (int c = 0; c < 4; ++c) { af[a][c] += kf[a] * v4[c]; ab[a][c] += kb[a] * v4[c]; } }
            float* sf = ST + (size_t)(((0 * 2 + b) * 260 + s) * 4 + h) * 8192; float* sb = ST + (size_t)(((1 * 2 + b) * 260 + s) * 4 + h) * 8192;
#pragma unroll
            for (int a = 0; a < 4; ++a) { *(f32x4*)(sf + (4 * kk + a) * 128 + 4 * vq) = (f32x4){af[a][0], af[a][1], af[a][2], af[a][3]}; *(f32x4*)(sb + (4 * kk + a) * 128 + 4 * vq) = (f32x4){ab[a][0], ab[a][1], ab[a][2], ab[a][3]}; } }
        __syncthreads();
    }
}
__device__ void gla_scan(int tid_, int bid_, const P& p) {
    const float* ST = (const float*)(p.ws + WS_ST); const float* DEC = (const float*)(p.ws + WS_DEC); bf16_t* SB = (bf16_t*)(p.ws + WS_SBF);
    for (int e = bid_ * 512 + tid_; e < 131072; e += gridDim.x * 512) {
        const int dir = e >> 16, b = (e >> 15) & 1, h = (e >> 13) & 3, kv = e & 8191, k = kv >> 7;
        const size_t sboff = (att_voff(k, (kv & 127) >> 3) >> 1) + (kv & 7);
        float S = 0.f;
        for (int st0 = 0; st0 < 260; st0 += 10) {
            float kvv[10], dd[10]; size_t idx[10];
#pragma unroll
            for (int u = 0; u < 10; ++u) { const int step = st0 + u; const int s = step < 4 ? (dir ? 3 - step : step) : (dir ? 263 - step : step);
                idx[u] = (size_t)(((dir * 2 + b) * 260 + s) * 4 + h); kvv[u] = ST[idx[u] * 8192 + kv]; dd[u] = DEC[idx[u] * 64 + k]; }
#pragma unroll
            for (int u = 0; u < 10; ++u) { SB[idx[u] * 8192 + sboff] = (bf16_t)(cvt_pk_bf16(S, 0.f) & 0xffffu); S = dd[u] * S + kvv[u]; }
        }
    }
}
__device__ void gla_g3(int tid_, int bid_, const P& p, int l, bool with_ctx, LAS unsigned char* lds) {
    LAS float* B = (LAS float*)lds;
    LAS float* Q = (LAS float*)(lds + 34816);
    LAS float* V = (LAS float*)(lds + 69632);
    LAS float* A = (LAS float*)(lds + 102400);
    LAS float* gl = (LAS float*)(lds + 119040);
    LAS float* tot = (LAS float*)(lds + 127232);
    const bf16_t* Z = (const bf16_t*)(p.ws + WS_H); const float* ST = (const float*)(p.ws + WS_ST); bf16_t* Y = (bf16_t*)(p.ws + WS_ABUF);
    const int t = tid_;
    for (int item = bid_; item < 520 * 4; item += gridDim.x) {
        const int h = item & 3, cs = item >> 2, b = cs / 260, s = cs - b * 260; if (s < 4 && !with_ctx) continue;
        const int tb = gla_tokbase(b, s);
        gla_gates(tid_, bid_, p, l, h, tb, B, gl, tot);
        for (int i = t; i < 64 * 16; i += 512) { const int j = i >> 4, c8 = (i & 15) * 8; const u32x4 u = *(const u32x4*)(Z + (size_t)(tb + j) * ZLD + C_GV + h * 128 + c8);
            LAS float* d = V + j * 128 + c8; d[0] = bflo(u.x); d[1] = bfhi(u.x); d[2] = bflo(u.y); d[3] = bfhi(u.y); d[4] = bflo(u.z); d[5] = bfhi(u.z); d[6] = bflo(u.w); d[7] = bfhi(u.w); }
        for (int e = t; e < 2 * 4096; e += 512) { const int dir = e >> 12, j = (e >> 6) & 63, k = e & 63;
            const float bb = B[(dir * 64 + j) * GLD + k] + gla_off(tot, dir, j, k);
            const float qv = bf2f(Z[(size_t)(tb + j) * ZLD + C_GQ + h * 64 + k]), kv = bf2f(Z[(size_t)(tb + j) * ZLD + C_GK + h * 64 + k]);
            Q[(dir * 64 + j) * GLD + k] = qv * __expf(bb); B[(dir * 64 + j) * GLD + k] = kv * __expf(-bb); }
        __syncthreads();
        { const int i = t >> 3, jg = t & 7; float af[8], ab[8];
#pragma unroll
            for (int jj = 0; jj < 8; ++jj) { af[jj] = 0.f; ab[jj] = 0.f; }
            for (int k4 = 0; k4 < 16; ++k4) { const f32x4 qf = *(const LAS f32x4*)(Q + i * GLD + 4 * k4), qb = *(const LAS f32x4*)(Q + (64 + i) * GLD + 4 * k4);
#pragma unroll
                for (int jj = 0; jj < 8; ++jj) { const int j = jg + 8 * jj; const f32x4 kf = *(const LAS f32x4*)(B + j * GLD + 4 * k4), kb = *(const LAS f32x4*)(B + (64 + j) * GLD + 4 * k4);
                    af[jj] += qf[0] * kf[0] + qf[1] * kf[1] + qf[2] * kf[2] + qf[3] * kf[3]; ab[jj] += qb[0] * kb[0] + qb[1] * kb[1] + qb[2] * kb[2] + qb[3] * kb[3]; } }
#pragma unroll
            for (int jj = 0; jj < 8; ++jj) { const int j = jg + 8 * jj; A[i * 65 + j] = (j <= i ? af[jj] : 0.f) + (j >= i ? ab[jj] : 0.f); } }
        __syncthreads();
        { const int i = t >> 3, vg = t & 7; f32x4 o[4];
#pragma unroll
            for (int c = 0; c < 4; ++c) o[c] = (f32x4){0.f, 0.f, 0.f, 0.f};
            for (int j = 0; j < 64; ++j) { const float a = A[i * 65 + j];
#pragma unroll
                for (int c = 0; c < 4; ++c) o[c] += a * *(const LAS f32x4*)(V + j * 128 + vg * 16 + 4 * c); }
            const float* sf = ST + (size_t)(((0 * 2 + b) * 260 + s) * 4 + h) * 8192 + vg * 16; const float* sb = ST + (size_t)(((1 * 2 + b) * 260 + s) * 4 + h) * 8192 + vg * 16;
#pragma unroll 4
            for (int k = 0; k < 64; ++k) { const float qf = Q[i * GLD + k], qb = Q[(64 + i) * GLD + k];
#pragma unroll
                for (int c = 0; c < 4; ++c) o[c] += qf * *(const f32x4*)(sf + k * 128 + 4 * c) + qb * *(const f32x4*)(sb + k * 128 + 4 * c); }
            float ss = 0.f;
#pragma unroll
            for (int c = 0; c < 4; ++c) ss += o[c][0] * o[c][0] + o[c][1] * o[c][1] + o[c][2] * o[c][2] + o[c][3] * o[c][3];
            ss += __shfl_xor(ss, 1); ss += __shfl_xor(ss, 2); ss += __shfl_xor(ss, 4);
            const float rstd = rsqrtf(ss * (1.f / 128.f) + 1e-6f);
            const int tok = tb + i; const bf16_t* rp = Z + (size_t)tok * ZLD + C_GR + h * 128 + vg * 16; const float* gg = p.glag + l * 128 + vg * 16;
            const u32x4 r0 = *(const u32x4*)rp, r1 = *(const u32x4*)(rp + 8);
            float rr[16] = {bflo(r0.x), bfhi(r0.x), bflo(r0.y), bfhi(r0.y), bflo(r0.z), bfhi(r0.z), bflo(r0.w), bfhi(r0.w), bflo(r1.x), bfhi(r1.x), bflo(r1.y), bfhi(r1.y), bflo(r1.z), bfhi(r1.z), bflo(r1.w), bfhi(r1.w)};
            float res[16];
#pragma unroll
            for (int c = 0; c < 4; ++c)
#pragma unroll
                for (int jx = 0; jx < 4; ++jx) { const float r = rr[4 * c + jx]; res[4 * c + jx] = o[c][jx] * rstd * gg[4 * c + jx] * (r / (1.f + __expf(-r))); }
            u32x4 w0, w1; w0.x = cvt_pk_bf16(res[0], res[1]); w0.y = cvt_pk_bf16(res[2], res[3]); w0.z = cvt_pk_bf16(res[4], res[5]); w0.w = cvt_pk_bf16(res[6], res[7]);
            w1.x = cvt_pk_bf16(res[8], res[9]); w1.y = cvt_pk_bf16(res[10], res[11]); w1.z = cvt_pk_bf16(res[12], res[13]); w1.w = cvt_pk_bf16(res[14], res[15]);
            bf16_t* yp = Y + (size_t)tok * DM + 512 + h * 128 + vg * 16; *(u32x4*)yp = w0; *(u32x4*)(yp + 8) = w1; }
        __syncthreads();
    }
}

__device__ void gla_gates2(int tid_, const P& p, int l, int h, int tokbase, LAS float* B, LAS float* gl, LAS float* tot) {
    const int t = tid_; const bf16_t* Z = (const bf16_t*)(p.ws + WS_H);
    { const int j = t >> 3, c4 = (t & 7) * 4; const uint2 u = *(const uint2*)(Z + (size_t)(tokbase + j) * ZLD + C_GFL + c4);
        LAS float* d = gl + j * 32 + c4; d[0] = bflo(u.x); d[1] = bfhi(u.x); d[2] = bflo(u.y); d[3] = bfhi(u.y); }
    const int dir = t >> 8, seg = (t >> 6) & 3, k = t & 63;
    const float* wg = (dir ? p.wgb : p.wgf) + l * 16 * 256 + h * 64 + k; float w[16];
#pragma unroll
    for (int r = 0; r < 16; ++r) w[r] = wg[r * 256];
    const float bg = (dir ? p.bgb : p.bgf)[l * 256 + h * 64 + k];
    __syncthreads();
    float run = 0.f;
    for (int jj = 0; jj < 16; ++jj) { const int j = dir ? (seg * 16 + 15 - jj) : (seg * 16 + jj); float u = bg;
#pragma unroll
        for (int r4 = 0; r4 < 4; ++r4) { const f32x4 g4 = *(const LAS f32x4*)(gl + j * 32 + dir * 16 + 4 * r4); u += g4[0] * w[4 * r4] + g4[1] * w[4 * r4 + 1] + g4[2] * w[4 * r4 + 2] + g4[3] * w[4 * r4 + 3]; }
        const float g = -(fmaxf(-u, 0.f) + __logf(1.f + __expf(-fabsf(u)))) * (1.f / 16.f); run += g; B[(dir * 64 + j) * GLD + k] = run; }
    tot[(dir * 4 + seg) * 64 + k] = run;
    __syncthreads();
    float off = 0.f, total = 0.f;
#pragma unroll
    for (int s = 0; s < 4; ++s) { const float v = tot[(dir * 4 + s) * 64 + k]; total += v; if (dir ? (s > seg) : (s < seg)) off += v; }
    for (int jj = 0; jj < 16; ++jj) { const int j = seg * 16 + jj; B[(dir * 64 + j) * GLD + k] += off; }
    __syncthreads();
    if (seg == 0) tot[(dir * 4) * 64 + k] = total;
    __syncthreads();
}
__device__ __forceinline__ unsigned gl_off128tr(int row, int ch) { return (unsigned)(row * 128 + ((ch ^ (((((row >> 3) & 1) << 1) | ((row >> 1) & 1)) << 1)) << 4)); }
__device__ __forceinline__ unsigned gl_offQ(int row, int ch) { return (unsigned)(row * 128 + ((ch ^ ((row >> 1) & 7)) << 4)); }
__device__ __forceinline__ unsigned gl_offK(int row, int ch) { return (unsigned)(row * 128 + ((ch ^ (((row >> 1) & 1) | (((row >> 3) & 3) << 1))) << 4)); }
constexpr int GL_B = 0, GL_QT = 34816, GL_KT = 51200, GL_V = 67584, GL_S = 83968, GL_GL = 116736, GL_TOT = 124928, GL_SSQ = 126976;
__device__ void gla_g1m(int tid_, int bid_, const P& p, int l, LAS unsigned char* lds) {
    LAS float* B = (LAS float*)(lds + GL_B); LAS float* gl = (LAS float*)(lds + GL_GL); LAS float* tot = (LAS float*)(lds + GL_TOT);
    LAS unsigned char* KH = lds + GL_QT; LAS unsigned char* VB = lds + GL_V;
    const bf16_t* Z = (const bf16_t*)(p.ws + WS_H); float* ST = (float*)(p.ws + WS_ST); float* DEC = (float*)(p.ws + WS_DEC);
    const int t = tid_, lane = t & 63, wid = __builtin_amdgcn_readfirstlane(t >> 6), l15 = lane & 15, lg = lane >> 4, vq = l15 >> 2, vp = lane & 3;
    for (int item = bid_; item < 520 * 4; item += gridDim.x) {
        const int h = item & 3, cs = item >> 2, b = cs / 260, s = cs - b * 260; const int tb = gla_tokbase(b, s);
        u32x4 vreg[2], kreg, qreg;
#pragma unroll
        for (int i = 0; i < 2; ++i) { const int idx = t + 512 * i; vreg[i] = *(const u32x4*)(Z + (size_t)(tb + (idx >> 4)) * ZLD + C_GV + h * 128 + (idx & 15) * 8); }
        { const int j = (t >> 3) & 63, ch = t & 7; const bf16_t* zp = Z + (size_t)(tb + j) * ZLD + h * 64 + ch * 8; kreg = *(const u32x4*)(zp + C_GK); qreg = *(const u32x4*)(zp + C_GQ); }
        gla_gates2(t, p, l, h, tb, B, gl, tot);
        unsigned char* qki = p.ws + WS_QKI + (size_t)item * 32768;
#pragma unroll
        for (int i = 0; i < 2; ++i) { const int idx = t + 512 * i; *(LAS u32x4*)(VB + att_voff(idx >> 4, idx & 15)) = vreg[i];
            const int dir = i, j = (t >> 3) & 63, ch = t & 7;
            const LAS float* bp = B + (dir * 64 + j) * GLD + ch * 8; const LAS float* tp = tot + (dir * 4) * 64 + ch * 8;
            const f32x4 b0 = *(const LAS f32x4*)bp, b1 = *(const LAS f32x4*)(bp + 4), t0 = *(const LAS f32x4*)tp, t1 = *(const LAS f32x4*)(tp + 4);
            float e[8], ei[8], et[8];
#pragma unroll
            for (int x = 0; x < 4; ++x) { e[x] = __expf(b0[x]); e[4 + x] = __expf(b1[x]); ei[x] = __builtin_amdgcn_rcpf(e[x]); ei[4 + x] = __builtin_amdgcn_rcpf(e[4 + x]); et[x] = __expf(t0[x]) * ei[x]; et[4 + x] = __expf(t1[x]) * ei[4 + x]; }
            const float kf[8] = {bflo(kreg.x), bfhi(kreg.x), bflo(kreg.y), bfhi(kreg.y), bflo(kreg.z), bfhi(kreg.z), bflo(kreg.w), bfhi(kreg.w)};
            const float qf[8] = {bflo(qreg.x), bfhi(qreg.x), bflo(qreg.y), bfhi(qreg.y), bflo(qreg.z), bfhi(qreg.z), bflo(qreg.w), bfhi(qreg.w)};
            u32x4 w, wq, wk;
            w.x = cvt_pk_bf16(kf[0] * et[0], kf[1] * et[1]); w.y = cvt_pk_bf16(kf[2] * et[2], kf[3] * et[3]); w.z = cvt_pk_bf16(kf[4] * et[4], kf[5] * et[5]); w.w = cvt_pk_bf16(kf[6] * et[6], kf[7] * et[7]);
            wq.x = cvt_pk_bf16(qf[0] * e[0], qf[1] * e[1]); wq.y = cvt_pk_bf16(qf[2] * e[2], qf[3] * e[3]); wq.z = cvt_pk_bf16(qf[4] * e[4], qf[5] * e[5]); wq.w = cvt_pk_bf16(qf[6] * e[6], qf[7] * e[7]);
            wk.x = cvt_pk_bf16(kf[0] * ei[0], kf[1] * ei[1]); wk.y = cvt_pk_bf16(kf[2] * ei[2], kf[3] * ei[3]); wk.z = cvt_pk_bf16(kf[4] * ei[4], kf[5] * ei[5]); wk.w = cvt_pk_bf16(kf[6] * ei[6], kf[7] * ei[7]);
            *(LAS u32x4*)(KH + dir * 8192 + gl_off128tr(j, ch)) = w;
            *(u32x4*)(qki + dir * 8192 + gl_offQ(j, ch)) = wq; *(u32x4*)(qki + 16384 + dir * 8192 + gl_offK(j, ch)) = wk; }
        if (t < 128) { const int dir = t >> 6, k = t & 63; DEC[(size_t)(((dir * 2 + b) * 260 + s) * 4 + h) * 64 + k] = __expf(tot[(dir * 4) * 64 + k]); }
        __syncthreads();
        { const int dir = wid >> 2, kt = wid & 3; const int phi = ((lg & 1) << 1) | ((vq >> 1) & 1);
            bf16x8 af[2];
#pragma unroll
            for (int jj = 0; jj < 2; ++jj) { s16x4 a0, a1;
                a0 = __builtin_amdgcn_ds_read_tr16_b64_v4i16((LAS s16x4*)(KH + dir * 8192 + (32 * jj + 8 * lg + vq) * 128 + ((2 * (kt ^ phi) + (vp >> 1)) << 4) + 8 * (vp & 1)));
                a1 = __builtin_amdgcn_ds_read_tr16_b64_v4i16((LAS s16x4*)(KH + dir * 8192 + (32 * jj + 8 * lg + 4 + vq) * 128 + ((2 * (kt ^ phi) + (vp >> 1)) << 4) + 8 * (vp & 1)));
                af[jj] = (bf16x8){a0[0], a0[1], a0[2], a0[3], a1[0], a1[1], a1[2], a1[3]}; }
            float* sp = ST + (size_t)(((dir * 2 + b) * 260 + s) * 4 + h) * 8192 + (16 * kt + 4 * lg) * 128 + l15;
#pragma unroll
            for (int vt = 0; vt < 8; ++vt) { f32x4 acc = {0.f, 0.f, 0.f, 0.f};
#pragma unroll
                for (int jj = 0; jj < 2; ++jj) { s16x4 v0, v1; const int r0 = 32 * jj + 8 * lg + vq, r1 = r0 + 4;
                    v0 = __builtin_amdgcn_ds_read_tr16_b64_v4i16((LAS s16x4*)(VB + att_voff(r0, 2 * vt + (vp >> 1)) + 8 * (vp & 1)));
                    v1 = __builtin_amdgcn_ds_read_tr16_b64_v4i16((LAS s16x4*)(VB + att_voff(r1, 2 * vt + (vp >> 1)) + 8 * (vp & 1)));
                    const bf16x8 vf = {v0[0], v0[1], v0[2], v0[3], v1[0], v1[1], v1[2], v1[3]};
                    acc = __builtin_amdgcn_mfma_f32_16x16x32_bf16(af[jj], vf, acc, 0, 0, 0); }
#pragma unroll
                for (int j = 0; j < 4; ++j) sp[j * 128 + 16 * vt] = acc[j]; }
        }
        __syncthreads();
    }
}
__device__ void gla_g3m(int tid_, int bid_, const P& p, int l, bool with_ctx, LAS unsigned char* lds) {
    LAS float* B = (LAS float*)(lds + GL_B); LAS float* gl = (LAS float*)(lds + GL_GL); LAS float* tot = (LAS float*)(lds + GL_TOT); LAS float* ssq = (LAS float*)(lds + GL_SSQ);
    LAS unsigned char* QT = lds + GL_QT; LAS unsigned char* KT = lds + GL_KT; LAS unsigned char* VB = lds + GL_V; LAS unsigned char* SB = lds + GL_S;
    const bf16_t* Z = (const bf16_t*)(p.ws + WS_H); const float* ST = (const float*)(p.ws + WS_ST); bf16_t* Y = (bf16_t*)(p.ws + WS_ABUF);
    const int t = tid_, lane = t & 63, wid = __builtin_amdgcn_readfirstlane(t >> 6), l15 = lane & 15, lg = lane >> 4, vq = l15 >> 2, vp = lane & 3;
    const int it = wid >> 1, vh = wid & 1;
    for (int item = bid_; item < 520 * 4; item += gridDim.x) {
        const int h = item & 3, cs = item >> 2, b = cs / 260, s = cs - b * 260; if (s < 4 && !with_ctx) continue;
        const int tb = gla_tokbase(b, s);
        u32x4 vreg[2], qk[4], sreg[4];
        const unsigned char* qki = p.ws + WS_QKI + (size_t)item * 32768;
#pragma unroll
        for (int i = 0; i < 2; ++i) { const int idx = t + 512 * i; vreg[i] = *(const u32x4*)(Z + (size_t)(tb + (idx >> 4)) * ZLD + C_GV + h * 128 + (idx & 15) * 8); }
#pragma unroll
        for (int i = 0; i < 4; ++i) { const int idx = t + 512 * i; qk[i] = *(const u32x4*)(qki + (size_t)idx * 16);
            const int dir = idx >> 10; sreg[i] = *(const u32x4*)(p.ws + WS_SBF + (size_t)(((dir * 2 + b) * 260 + s) * 4 + h) * 16384 + (size_t)(idx & 1023) * 16); }
#pragma unroll
        for (int i = 0; i < 2; ++i) { const int idx = t + 512 * i; *(LAS u32x4*)(VB + att_voff(idx >> 4, idx & 15)) = vreg[i]; }
#pragma unroll
        for (int i = 0; i < 4; ++i) { const int idx = t + 512 * i; *(LAS u32x4*)(QT + idx * 16) = qk[i]; *(LAS u32x4*)(SB + idx * 16) = sreg[i]; }
        __syncthreads();
        f32x4 O[4];
        {
            bf16x8 Qf[2][2];
#pragma unroll
            for (int dir = 0; dir < 2; ++dir)
#pragma unroll
                for (int kk = 0; kk < 2; ++kk) Qf[dir][kk] = *(const LAS bf16x8*)(QT + dir * 8192 + gl_offQ(16 * it + l15, 4 * kk + lg));
#pragma unroll
            for (int vt = 0; vt < 4; ++vt) O[vt] = (f32x4){0.f, 0.f, 0.f, 0.f};
            const int qi = 16 * it + l15;
#pragma unroll
            for (int jb = 0; jb < 2; ++jb) {
                f32x4 a[2];
#pragma unroll
                for (int jt = 0; jt < 2; ++jt) { f32x4 af = {0.f, 0.f, 0.f, 0.f}, ab = {0.f, 0.f, 0.f, 0.f}; const int row = 32 * jb + 8 * (l15 >> 2) + 4 * jt + (l15 & 3);
#pragma unroll
                    for (int kk = 0; kk < 2; ++kk) { const bf16x8 kf = *(const LAS bf16x8*)(KT + gl_offK(row, 4 * kk + lg)), kb = *(const LAS bf16x8*)(KT + 8192 + gl_offK(row, 4 * kk + lg));
                        af = __builtin_amdgcn_mfma_f32_16x16x32_bf16(kf, Qf[0][kk], af, 0, 0, 0); ab = __builtin_amdgcn_mfma_f32_16x16x32_bf16(kb, Qf[1][kk], ab, 0, 0, 0); }
#pragma unroll
                    for (int jx = 0; jx < 4; ++jx) { const int j = 32 * jb + 8 * lg + 4 * jt + jx; a[jt][jx] = (j <= qi ? af[jx] : 0.f) + (j >= qi ? ab[jx] : 0.f); } }
                u32x4 w; w.x = cvt_pk_bf16(a[0][0], a[0][1]); w.y = cvt_pk_bf16(a[0][2], a[0][3]); w.z = cvt_pk_bf16(a[1][0], a[1][1]); w.w = cvt_pk_bf16(a[1][2], a[1][3]);
                const bf16x8 pk = __builtin_bit_cast(bf16x8, w);
#pragma unroll
                for (int vt = 0; vt < 4; ++vt) { const int r0 = 32 * jb + 8 * lg + vq, cch = 2 * (4 * vh + vt) + (vp >> 1);
                    const s16x4 v0 = __builtin_amdgcn_ds_read_tr16_b64_v4i16((LAS s16x4*)(VB + att_voff(r0, cch) + 8 * (vp & 1)));
                    const s16x4 v1 = __builtin_amdgcn_ds_read_tr16_b64_v4i16((LAS s16x4*)(VB + att_voff(r0 + 4, cch) + 8 * (vp & 1)));
                    const bf16x8 vf = {v0[0], v0[1], v0[2], v0[3], v1[0], v1[1], v1[2], v1[3]};
                    O[vt] = __builtin_amdgcn_mfma_f32_16x16x32_bf16(vf, pk, O[vt], 0, 0, 0); }
            }
#pragma unroll
            for (int dir = 0; dir < 2; ++dir)
#pragma unroll
                for (int kk = 0; kk < 2; ++kk)
#pragma unroll
                    for (int vt = 0; vt < 4; ++vt) { const int r0 = 32 * kk + 8 * lg + vq, cch = 2 * (4 * vh + vt) + (vp >> 1);
                        const s16x4 s0 = __builtin_amdgcn_ds_read_tr16_b64_v4i16((LAS s16x4*)(SB + dir * 16384 + att_voff(r0, cch) + 8 * (vp & 1)));
                        const s16x4 s1 = __builtin_amdgcn_ds_read_tr16_b64_v4i16((LAS s16x4*)(SB + dir * 16384 + att_voff(r0 + 4, cch) + 8 * (vp & 1)));
                        const bf16x8 sf = {s0[0], s0[1], s0[2], s0[3], s1[0], s1[1], s1[2], s1[3]};
                        O[vt] = __builtin_amdgcn_mfma_f32_16x16x32_bf16(sf, Qf[dir][kk], O[vt], 0, 0, 0); }
        }
        float ss = 0.f;
#pragma unroll
        for (int vt = 0; vt < 4; ++vt) ss += O[vt][0] * O[vt][0] + O[vt][1] * O[vt][1] + O[vt][2] * O[vt][2] + O[vt][3] * O[vt][3];
        ss += __shfl_xor(ss, 16); ss += __shfl_xor(ss, 32);
        if (lg == 0) ssq[wid * 16 + l15] = ss;
        __syncthreads();
        { const float tot2 = ssq[(2 * it) * 16 + l15] + ssq[(2 * it + 1) * 16 + l15]; const float rstd = rsqrtf(tot2 * (1.f / 128.f) + 1e-6f);
            const int tok = tb + 16 * it + l15;
#pragma unroll
            for (int vt = 0; vt < 4; ++vt) { const int v0 = 64 * vh + 16 * vt + 4 * lg; const uint2 ru = *(const uint2*)(Z + (size_t)tok * ZLD + C_GR + h * 128 + v0); const f32x4 g4 = *(const f32x4*)(p.glag + l * 128 + v0);
                const float r0 = bflo(ru.x), r1 = bfhi(ru.x), r2 = bflo(ru.y), r3 = bfhi(ru.y);
                const float o0 = O[vt][0] * rstd * g4[0] * (r0 / (1.f + __expf(-r0))), o1 = O[vt][1] * rstd * g4[1] * (r1 / (1.f + __expf(-r1)));
                const float o2 = O[vt][2] * rstd * g4[2] * (r2 / (1.f + __expf(-r2))), o3 = O[vt][3] * rstd * g4[3] * (r3 / (1.f + __expf(-r3)));
                uint2 w; w.x = cvt_pk_bf16(o0, o1); w.y = cvt_pk_bf16(o2, o3); *(uint2*)(Y + (size_t)tok * DM + 512 + h * 128 + v0) = w; } }
        __syncthreads();
    }
}

constexpr int N_PHASES = 18;
#ifndef REP_G
#define REP_G 1
#endif
#ifndef REP_A
#define REP_A 1
#endif
#ifndef REP_N
#define REP_N 1
#endif
__device__ __forceinline__ void run_phase(int tid_, int bid_, const P& p, int ph, LAS unsigned char* lds) {
    if (ph == N_PHASES - 1) { phase_final(tid_, bid_, p); return; }
    if (ph == 9) { phase_ctxfix(tid_, bid_, p); return; }
    const int l = ph < 9 ? 0 : 1;
    const int sp = l == 0 ? (ph <= 6 ? ph - 1 : ph) : (ph <= 14 ? ph - 9 : ph - 8);
    const bool with_ctx = (l == 0);
    float* XC = (float*)(p.ws + WS_XC);
    const float* lat_src = l == 0 ? p.x : p.out; const float* ctx_src = l == 0 ? p.ctx : XC;
    bf16_t* wb = (bf16_t*)(p.ws + WS_W + (size_t)l * SZ_WL);
    bf16_t* ABUF = (bf16_t*)(p.ws + WS_ABUF); bf16_t* ABUF2 = (bf16_t*)(p.ws + WS_ABUF2); bf16_t* HB = (bf16_t*)(p.ws + WS_H);
    const float* MODA = (const float*)(p.ws + WS_MOD);
    const float* mod = MODA + (size_t)l * 3 * 12288;
    float* SSQ = (float*)(p.ws + WS_SSQ); const float* CV = (const float*)(p.ws + WS_CVEC) + (size_t)l * CV_L;
    const int Mres = with_ctx ? NTOK : NLAT;
    if (sp == 0) {
#pragma unroll 1
        for (int rep = 0; rep < REP_N; ++rep) { phase_norm(tid_, bid_, p, l, 1, lat_src, ctx_src, NTOK); }
        phase_cvec(tid_, bid_, p, lds);
        return; }
    if (sp == 2) {
#pragma unroll 1
        for (int rep = 0; rep < REP_G; ++rep) { gla_g1m(tid_, bid_, p, l, lds); }
#pragma unroll 1
        for (int rep = 0; rep < REP_A; ++rep) { attn_mfma(tid_, bid_, p, l, with_ctx, lds); }
        return; }
    if (sp == 3) { gla_scan(tid_, bid_, p); return; }
    if (sp == 4) {
#pragma unroll 1
        for (int rep = 0; rep < REP_G; ++rep) { gla_g3m(tid_, bid_, p, l, with_ctx, lds); }
        return; }
    pg8::Gemm g; EpiAny E{};
    E.ws = p.ws; E.out = p.out; E.l = l; E.ssq_idx = -1;
    if (sp == 1) { g = pg8::Gemm{ABUF, wb, NTOK, ZN, DM}; E.mode = 0; E.perm = true; if (l == 1) E.ssq_idx = 1; }
    else if (sp == 5) { g = pg8::Gemm{ABUF, wb + (size_t)ZN * DM, Mres, DM, DM}; E.mode = 2; E.perm = true;
        E.rlat = lat_src; E.rctx = ctx_src; E.gate_idx = 2; E.ntfull = DM / 64; E.aout_sel = 2; E.ng = p.n2g + l * DM; E.nsc_off = l * 3 * 12288 + 4 * DM; E.ssq_idx = (l == 0 ? 0 : 2); }
    else if (sp == 7) { g = pg8::Gemm{ABUF2, wb + (size_t)ZN * DM + (size_t)DM * DM, Mres, DFF, DM}; E.mode = 1; E.perm = true; E.ssq_idx = (l == 0 ? 0 : 2); }
    else { g = pg8::Gemm{HB, wb + (size_t)ZN * DM + (size_t)DM * DM + (size_t)DFF * DM, NLAT, DM, DFF}; E.mode = 2; E.perm = true;
        E.rlat = p.out; E.rctx = XC; E.gate_idx = 5; E.ntfull = DFF / 64; E.aout_sel = (l == 0 ? 1 : 0); E.ng = p.n1g + DM; E.nsc_off = 3 * 12288 + 1 * DM; E.ssq_idx = 1; }
    pg8::StaticOrder S; S.init(g.M, g.N, g.K, gridDim.x, bid_);
    if (sp == 8 && l == 0) { S.nsplit = 256; S.ks = 16; S.nt_split = 8; S.pm_split0 = 128; }
    pg8::gemm_phase(tid_, lds, g, S, E);
}

#define XB_TMO      128
#define XB_XCNT(j)  (256  + 64 * (j))
#define XB_XSUB(j)  (1280 + 64 * (j))
#define XB_XGEN(j)  (2304 + 64 * (j))
#define XB_TOP      3328
#define XB_TOPGEN   3392
#define XCD_BAR_WORDS 3456
#define XB_SPIN_CAP (1u << 18)
__device__ __forceinline__ unsigned xb_ld(unsigned* p)              { return __hip_atomic_load(p, __ATOMIC_RELAXED, __HIP_MEMORY_SCOPE_AGENT); }
__device__ __forceinline__ unsigned xb_add(unsigned* p, unsigned v) { return __hip_atomic_fetch_add(p, v, __ATOMIC_RELAXED, __HIP_MEMORY_SCOPE_AGENT); }
__device__ __forceinline__ unsigned xb_xcc_id() { return (unsigned)__builtin_amdgcn_s_getreg((3 << 11) | 20) & 0xFu; }
#define XB_SPIN(cond, bar) do { unsigned _sp = 0; while (cond) { __builtin_amdgcn_s_sleep(1); \
    if ((++_sp & 255u) == 0u) { if (xb_ld(&(bar)[XB_TMO])) break; if (_sp > XB_SPIN_CAP) { atomicAdd(&(bar)[XB_TMO], 1u); break; } } } } while (0)
struct XcdBarrier { unsigned* bar; unsigned x; volatile LAS unsigned* st; };
__device__ __forceinline__ XcdBarrier xcd_barrier_post(unsigned* bar, volatile LAS unsigned* st) {
    XcdBarrier b; b.bar = bar; b.x = xb_xcc_id(); b.st = st;
    if (threadIdx.x == 0) (void)xb_add(&bar[XB_XCNT(b.x)], 1u);
    return b;
}
__device__ __forceinline__ void xcd_barrier_complete(unsigned* bar, unsigned x, unsigned& nloc, unsigned& nx) {
    const unsigned G = gridDim.x * gridDim.y * gridDim.z;
    unsigned sum, cnt, mine, sp = 0u;
    for (;;) {
        sum = 0u; cnt = 0u; mine = 0u;
#pragma unroll
        for (unsigned j = 0; j < 16; ++j) { const unsigned c = xb_ld(&bar[XB_XCNT(j)]); sum += c; cnt += (c > 0u) ? 1u : 0u; mine = (j == x) ? c : mine; }
        if (sum == G) break;
        __builtin_amdgcn_s_sleep(1);
        if ((++sp & 255u) == 0u) { if (xb_ld(&bar[XB_TMO])) break; if (sp > XB_SPIN_CAP) { atomicAdd(&bar[XB_TMO], 1u); break; } }
    }
    nloc = mine > 0u ? mine : 1u; nx = cnt > 0u ? cnt : 1u;
}
__device__ __forceinline__ void xcd_barrier(const XcdBarrier& b) {
    asm volatile("s_waitcnt vmcnt(0)" ::: "memory");
    __syncthreads();
    if (threadIdx.x == 0) {
        unsigned* bar = b.bar;
        __builtin_amdgcn_s_waitcnt(0);
        unsigned nloc = b.st[0], nx = b.st[1];
        if (nloc == 0u) { xcd_barrier_complete(bar, b.x, nloc, nx); b.st[0] = nloc; b.st[1] = nx; }
        const unsigned old = xb_add(&bar[XB_XSUB(b.x)], 1u);
        const unsigned gen = old / nloc;
        if (old + 1u == (gen + 1u) * nloc) {
            __builtin_amdgcn_fence(__ATOMIC_RELEASE, "agent");
            asm volatile("s_waitcnt vmcnt(0)" ::: "memory");
            const unsigned og = xb_add(&bar[XB_TOP], 1u);
            const unsigned tg = og / nx;
            if (og + 1u == (tg + 1u) * nx) xb_add(&bar[XB_TOPGEN], 1u);
            else XB_SPIN(xb_ld(&bar[XB_TOPGEN]) == tg, bar);
            __builtin_amdgcn_fence(__ATOMIC_ACQUIRE, "agent");
            xb_add(&bar[XB_XGEN(b.x)], 1u);
            asm volatile("s_waitcnt vmcnt(0)" ::: "memory");
        } else {
            XB_SPIN(xb_ld(&bar[XB_XGEN(b.x)]) == gen, bar);
            __builtin_amdgcn_fence(__ATOMIC_ACQUIRE, "agent");
            asm volatile("s_waitcnt vmcnt(0)" ::: "memory");
        }
    }
    __syncthreads();
}

__global__ void __launch_bounds__(512, 2) mk_fwd(P p) {
    extern __shared__ __attribute__((aligned(16))) unsigned char shm[];
    LAS unsigned char* lds = (LAS unsigned char*)shm;
    cg::grid_group grid = cg::this_grid();
    volatile LAS unsigned* xst = (volatile LAS unsigned*)(lds + LDS_XST);
    if (threadIdx.x == 0) { xst[0] = 0u; xst[1] = 0u; xst[2] = 0u; xst[3] = 0u; }
    __syncthreads();
    const XcdBarrier xb = xcd_barrier_post((unsigned*)(p.ws + WS_BAR), xst);
    int ph0 = (int)p.ph_lo;
    if (ph0 == 0) {
        int tid_ = threadIdx.x, bid_ = blockIdx.x;
        asm volatile("" : "+v"(tid_));
        asm volatile("" : "+s"(bid_));
        P q = p;
        { long zoff = 0; asm volatile("" : "+s"(zoff)); q.ws = p.ws + zoff; q.out = p.out + zoff; }
#pragma unroll 1
        for (int rep = 0; rep < REP_N; ++rep) { phase0(tid_, bid_, q, lds); __syncthreads(); }
        ph0 = 1;
        if (ph0 < (int)p.ph_hi) xcd_barrier(xb);
        if (p.ph_lo < 0) grid.sync();
    }
    for (int ph = ph0; ph < (int)p.ph_hi; ++ph) {
        int tid_ = threadIdx.x, bid_ = blockIdx.x;
        asm volatile("" : "+v"(tid_));
        asm volatile("" : "+s"(bid_));
        P q = p;
        { long zoff = 0; asm volatile("" : "+s"(zoff)); q.ws = p.ws + zoff; q.out = p.out + zoff; }
        run_phase(tid_, bid_, q, ph, lds);
        if (ph + 1 < (int)p.ph_hi) xcd_barrier(xb);
    }
}

#ifndef MK_MULTI
#define MK_MULTI 0
#endif
extern "C" void kernel_launch(void* const* d_in, const int* in_sizes, int n_in, void* d_out, int out_size, void* d_ws, size_t ws_size, hipStream_t stream) {
    static int grid = 0;
    if (grid == 0) {
        if (ws_size < WS_END) { fprintf(stderr, "kernel_launch: workspace too small: %zu < %zu\n", ws_size, (size_t)WS_END); grid = -1; return; }
        int dev = 0, cus = 0, per_cu = 0;
        hipGetDevice(&dev); hipDeviceGetAttribute(&cus, hipDeviceAttributeMultiprocessorCount, dev);
        if (hipFuncSetAttribute((const void*)mk_fwd, hipFuncAttributeMaxDynamicSharedMemorySize, LDS_BYTES) != hipSuccess) { fprintf(stderr, "kernel_launch: hipFuncSetAttribute failed\n"); grid = -1; return; }
        if (hipOccupancyMaxActiveBlocksPerMultiprocessor(&per_cu, (const void*)mk_fwd, 512, LDS_BYTES) != hipSuccess || per_cu < 1) { fprintf(stderr, "kernel_launch: occupancy query gave %d\n", per_cu); per_cu = 1; }
        (void)hipGetLastError();
        grid = cus * 1;
    }
    if (grid < 0) return;
    P p{};
    const float** pp = (const float**)&p;
    for (int i = 0; i < 20; ++i) pp[i] = (const float*)d_in[i];
    p.out = (float*)d_out; p.ws = (unsigned char*)d_ws;
#if MK_MULTI
    for (int ph = 0; ph < N_PHASES; ++ph) { p.ph_lo = ph; p.ph_hi = ph + 1; hipLaunchKernelGGL(mk_fwd, dim3(grid), dim3(512), LDS_BYTES, stream, p); }
#else
    p.ph_lo = 0; p.ph_hi = N_PHASES;
    if (hipMemsetAsync((char*)d_ws + WS_BAR, 0, 16384, stream) != hipSuccess) { fprintf(stderr, "kernel_launch: hipMemsetAsync failed\n"); return; }
    void* args[] = {&p};
    hipError_t e = hipLaunchCooperativeKernel((const void*)mk_fwd, dim3(grid), dim3(512), args, LDS_BYTES, stream);
    if (e != hipSuccess) fprintf(stderr, "cooperative launch failed: %s (grid %d)\n", hipGetErrorString(e), grid);
#endif
}
```

```cpp
#include <hip/hip_runtime.h>
#include <hip/hip_cooperative_groups.h>
#include <cstdio>
namespace cg = cooperative_groups;

#define LAS __attribute__((address_space(3)))
typedef unsigned short bf16_t;
typedef short bf16x8 __attribute__((ext_vector_type(8)));
typedef float f32x4 __attribute__((ext_vector_type(4)));
typedef unsigned u32x4 __attribute__((ext_vector_type(4)));
typedef unsigned u32x2v __attribute__((ext_vector_type(2)));

constexpr int DM = 2048, LSEQ = 16384, NLAT = 32768, NCTX = 512, NTOK = 33280, DFF = 8192;
constexpr int ZLD = 4640, ZN = 4864;
constexpr int C_NAQ = 0, C_NAK = 512, C_NAV = 1024, C_GQ = 1536, C_GK = 1792, C_GV = 2048, C_GR = 2560;
constexpr int C_SQ = 3072, C_SK = 4096, C_SV = 4352, C_GFL = 4608;
constexpr float LOG2E = 1.4426950408889634f;
constexpr float QSCALE = 0.08838834764831845f * 1.4426950408889634f;
constexpr int LDS_OUTB = 70144;
constexpr int LDS_XST = LDS_OUTB + 65536;
constexpr int LDS_BYTES = LDS_XST + 16;

constexpr size_t SZ_WIN = (size_t)ZN * DM * 2, SZ_WOUT = (size_t)DM * DM * 2, SZ_WFF = (size_t)DFF * DM * 2;
constexpr size_t SZ_WL = SZ_WIN + SZ_WOUT + 2 * SZ_WFF;
constexpr size_t WS_W = 0;
constexpr size_t WS_ABUF = WS_W + 2 * SZ_WL;
constexpr size_t WS_H = WS_ABUF + (size_t)NTOK * DM * 2;
constexpr size_t SZ_Z = (size_t)NTOK * ZLD * 2;
constexpr size_t WS_ST = WS_H + SZ_Z;
constexpr size_t SZ_ST = (size_t)2 * 2 * 260 * 4 * 8192 * 4;
constexpr size_t WS_DEC = WS_ST + SZ_ST;
constexpr size_t SZ_DEC = (size_t)2 * 2 * 260 * 4 * 64 * 4;
constexpr size_t WS_XC = WS_H + (size_t)NTOK * DFF * 2;
constexpr size_t WS_MOD = WS_XC + (size_t)NCTX * DM * 4;
constexpr size_t WS_ROPE = WS_MOD + (size_t)2 * 3 * 12288 * 4;
constexpr size_t WS_ABUF2 = WS_ROPE + 2 * 256 * 32 * 4;
constexpr size_t WS_QKI = WS_ABUF2;
constexpr size_t WS_SBF = WS_ABUF2 + (size_t)2080 * 32768;
static_assert((size_t)2080 * 32768 * 2 <= (size_t)NTOK * DM * 2, "gla overlay");
constexpr size_t WS_SSQ = WS_ABUF2 + (size_t)NTOK * DM * 2;
constexpr size_t WS_CVEC = WS_SSQ + (size_t)3 * NTOK * 4;
constexpr int CV_L = 3 * (ZN + DFF);
constexpr size_t WS_BAR = WS_CVEC + (size_t)2 * CV_L * 4;
constexpr size_t WS_END = WS_BAR + 16384;
static_assert(WS_DEC + SZ_DEC <= WS_XC, "overlay");

struct P {
    const float *x, *c, *ctx, *c_ctx, *w_mod, *b_mod, *n1g, *n2g, *w_in, *rpb, *wgf, *bgf, *wgb, *bgb, *glag, *sink, *w_out, *w_ff1, *w_ff2, *fng;
    float* out;
    unsigned char* ws;
    long ph_lo, ph_hi;
};

__device__ __forceinline__ unsigned cvt_pk_bf16(float lo, float hi) { unsigned r; asm volatile("v_cvt_pk_bf16_f32 %0, %1, %2" : "=v"(r) : "v"(lo), "v"(hi)); return r; }
__device__ __forceinline__ float bf2f(bf16_t b) { return __uint_as_float(((unsigned)b) << 16); }
__device__ __forceinline__ float bflo(unsigned u) { return __uint_as_float(u << 16); }
__device__ __forceinline__ float bfhi(unsigned u) { return __uint_as_float(u & 0xffff0000u); }
__device__ __forceinline__ float wave_sum(float v) { for (int o = 32; o > 0; o >>= 1) v += __shfl_xor(v, o); return v; }
__device__ __forceinline__ float wave_max(float v) { for (int o = 32; o > 0; o >>= 1) v = fmaxf(v, __shfl_xor(v, o)); return v; }
__device__ __forceinline__ float dot8(u32x4 a, u32x4 b) {
    float s = bflo(a.x) * bflo(b.x); s += bfhi(a.x) * bfhi(b.x); s += bflo(a.y) * bflo(b.y); s += bfhi(a.y) * bfhi(b.y);
    s += bflo(a.z) * bflo(b.z); s += bfhi(a.z) * bfhi(b.z); s += bflo(a.w) * bflo(b.w); s += bfhi(a.w) * bfhi(b.w); return s;
}

namespace pg8 {
constexpr int BM = 256, BK = 64, HALF = 128, HTB = HALF * BK * 2, NXCD = 8, WGM = 8;
__device__ __forceinline__ int lds_byte(int r, int c) { const int st = (r >> 4) * 2 + (c >> 5), rr = r & 15, cc = c & 31, ob = rr * 64 + cc * 2; return st * 1024 + (ob ^ (((ob >> 9) & 1) << 5)); }
__device__ __forceinline__ void stage_rc(int b, int& R, int& C) { const int st = b / 1024, sb = b % 1024, swz = sb ^ (((sb >> 9) & 1) << 5); R = (st >> 1) * 16 + swz / 64; C = (st & 1) * 32 + (swz % 64) / 2; }
__device__ __forceinline__ int perm32(int rho) { const int n = rho >> 4, i = rho & 15; return 8 * (i >> 2) + 4 * n + (i & 3); }
struct Unit { int pm, pn, k0, nt; };
struct Gemm { const bf16_t* A; const bf16_t* Bt; int M, N, K; };
struct StaticOrder {
    int nM, nN, nwg, G, c;
    __device__ void init(int M, int N, int K, int G_, int c_) { nM = M / BM; nN = N / BM; nwg = nM * nN; G = G_; c = c_; ntfull = K / BK; nsplit = 0; ks = 1; nt_split = 0; pm_split0 = 0; }
    int ntfull, nsplit, ks, nt_split, pm_split0;
    __device__ __forceinline__ bool next(int i, Unit& u) const {
        const long L = (long)i * G + c;
        const bool full = L < nwg; const int sidx = (int)(L - nwg);
        if (!full && sidx >= nsplit) return false;
        int wgid = full ? (int)L : 0; { const int q = nwg / NXCD, r = nwg % NXCD, xcd = wgid % NXCD, off = wgid / NXCD; wgid = (xcd < r ? xcd * (q + 1) : r * (q + 1) + (xcd - r) * q) + off; }
        const int nig = WGM * nN, gid = wgid / nig, fm = gid * WGM, gsz = (nM - fm) < WGM ? (nM - fm) : WGM;
        const int fpm = fm + ((wgid % nig) % gsz), fpn = (wgid % nig) / gsz;
        const int tl = sidx / ks, spm = pm_split0 + tl / nN, spn = tl % nN, sk0 = (sidx % ks) * nt_split * BK;
        u.pm = full ? fpm : spm; u.pn = full ? fpn : spn; u.k0 = full ? 0 : sk0; u.nt = full ? ntfull : nt_split;
        return true;
    }
};

template <class Epi>
__device__ __forceinline__ void gemm_phase(int tid_, LAS unsigned char* lds, const Gemm g, const StaticOrder& S, const Epi& E) {
    const int tid = tid_, wid = __builtin_amdgcn_readfirstlane(tid >> 6), lane = tid & 63, wr = wid >> 2, wc = wid & 3, fr = lane & 15, fq = lane >> 4;
    const int K = g.K;
    unsigned voffA[2], voffB[2];
#pragma unroll
    for (int i = 0; i < 2; ++i) { int R, C; stage_rc(tid * 16 + i * 8192, R, C); const int Rb = E.perm ? (64 * (R >> 5) + perm32(R & 31)) : R;
        voffA[i] = (unsigned)(R * K + C) * 2u; voffB[i] = (unsigned)(Rb * K + C) * 2u; }
    const size_t kstep = (size_t)(BK * 2);
    const size_t hstep = (size_t)HALF * K * 2;
    const size_t hstepB = E.perm ? (size_t)32 * K * 2 : hstep;
    const size_t tstep = 2 * hstep;
    const unsigned ldsw = (unsigned)wid * 1024u;
    const int aoff = lds_byte(wr * 64 + fr, fq * 8), boff = lds_byte(wc * 32 + fr, fq * 8);
#define PG8_SA(b, h) (((b) * 2 + (h)) * HTB)
#define PG8_SB(b, h) ((4 + (b) * 2 + (h)) * HTB)
#define PG8_STAGE(bufoff, gbase, voff) do { _Pragma("unroll") for (int _i = 0; _i < 2; ++_i) \
        __builtin_amdgcn_global_load_lds((const unsigned*)((const char*)(gbase) + (voff)[_i]), (LAS unsigned*)(lds + (bufoff) + ldsw + _i * 8192), 16, 0, 0); } while (0)
#define PG8_LDA(dst, b, h) do { _Pragma("unroll") for (int m = 0; m < 4; ++m) _Pragma("unroll") for (int k = 0; k < 2; ++k) dst[m][k] = *(const LAS bf16x8*)(lds + PG8_SA(b, h) + aoff + m * 2048 + k * 1024); } while (0)
#define PG8_LDB(dst, b, h) do { _Pragma("unroll") for (int n = 0; n < 2; ++n) _Pragma("unroll") for (int k = 0; k < 2; ++k) dst[n][k] = *(const LAS bf16x8*)(lds + PG8_SB(b, h) + boff + n * 2048 + k * 1024); } while (0)
#define PG8_MMA(ai, bj, At, Bt) do { __builtin_amdgcn_s_setprio(1); _Pragma("unroll") for (int m = 0; m < 4; ++m) _Pragma("unroll") for (int n = 0; n < 2; ++n) _Pragma("unroll") for (int k = 0; k < 2; ++k) \
        acc[ai][bj][m][n] = __builtin_amdgcn_mfma_f32_16x16x32_bf16(Bt[n][k], At[m][k], acc[ai][bj][m][n], 0, 0, 0); __builtin_amdgcn_s_setprio(0); } while (0)
#define PG8_WAIT_V(n) asm volatile("s_waitcnt vmcnt(" #n ")" ::: "memory")
#define PG8_WAIT_L(n) asm volatile("s_waitcnt lgkmcnt(" #n ")" ::: "memory")
#define PG8_BAR __builtin_amdgcn_s_barrier()
#define PG8_SCHED __builtin_amdgcn_sched_barrier(0)
    Unit cur, nxt; int ui = 0;
    if (!S.next(0, cur)) return;
    f32x4 acc[2][2][4][2];
#pragma unroll
    for (int a = 0; a < 2; ++a)
#pragma unroll
        for (int b = 0; b < 2; ++b)
#pragma unroll
            for (int m = 0; m < 4; ++m)
#pragma unroll
                for (int n = 0; n < 2; ++n) acc[a][b][m][n] = (f32x4){0.f, 0.f, 0.f, 0.f};
    bf16x8 At[4][2], B0[2][2], B1[2][2];
    const char* cA = (const char*)g.A + (size_t)cur.pm * tstep + (size_t)cur.k0 * 2; const char* cB = (const char*)g.Bt + (size_t)cur.pn * tstep + (size_t)cur.k0 * 2;
    PG8_STAGE(PG8_SB(0, 0), cB, voffB); PG8_STAGE(PG8_SA(0, 0), cA, voffA); PG8_STAGE(PG8_SB(0, 1), cB + hstepB, voffB); PG8_STAGE(PG8_SA(0, 1), cA + hstep, voffA);
    if (wr == 1) PG8_BAR;
    PG8_WAIT_V(4); PG8_BAR;
    PG8_STAGE(PG8_SB(1, 0), cB + kstep, voffB); PG8_STAGE(PG8_SA(1, 0), cA + kstep, voffA); PG8_STAGE(PG8_SB(1, 1), cB + hstepB + kstep, voffB);
    PG8_WAIT_V(6); PG8_BAR;
    for (;;) {
        const bool has_next = S.next(ui + 1, nxt);
        const char* nA = has_next ? (const char*)g.A + (size_t)nxt.pm * tstep + (size_t)nxt.k0 * 2 : cA; const char* nB = has_next ? (const char*)g.Bt + (size_t)nxt.pn * tstep + (size_t)nxt.k0 * 2 : cB;
        const int nt = cur.nt;
        for (int t = 0; t < nt; t += 2) {
            const bool last = (t == nt - 2);
            const char* a1 = cA + (size_t)(t + 1) * kstep;
            const char* a2 = last ? nA : cA + (size_t)(t + 2) * kstep; const char* b2 = last ? nB : cB + (size_t)(t + 2) * kstep;
            const char* a3 = a2 + kstep; const char* b3 = b2 + kstep;
            PG8_LDB(B0, 0, 0); PG8_SCHED; PG8_LDA(At, 0, 0); PG8_STAGE(PG8_SA(1, 1), a1 + hstep, voffA);
            PG8_WAIT_L(8); PG8_BAR; PG8_WAIT_L(0); PG8_MMA(0, 0, At, B0); PG8_BAR; PG8_SCHED;
            PG8_LDB(B1, 0, 1); PG8_STAGE(PG8_SB(0, 0), b2, voffB);
            PG8_BAR; PG8_WAIT_L(0); PG8_MMA(0, 1, At, B1); PG8_BAR;
            PG8_LDA(At, 0, 1); PG8_STAGE(PG8_SA(0, 0), a2, voffA);
            PG8_BAR; PG8_WAIT_L(0); PG8_MMA(1, 0, At, B0); PG8_BAR; PG8_SCHED;
            PG8_STAGE(PG8_SB(0, 1), b2 + hstepB, voffB);
            PG8_WAIT_V(6); PG8_BAR; PG8_MMA(1, 1, At, B1); PG8_BAR;
            PG8_LDB(B0, 1, 0); PG8_SCHED; PG8_LDA(At, 1, 0); PG8_STAGE(PG8_SA(0, 1), a2 + hstep, voffA);
            PG8_WAIT_L(8); PG8_BAR; PG8_WAIT_L(0); PG8_MMA(0, 0, At, B0); PG8_BAR; PG8_SCHED;
            PG8_LDB(B1, 1, 1); PG8_STAGE(PG8_SB(1, 0), b3, voffB);
            PG8_BAR; PG8_WAIT_L(0); PG8_MMA(0, 1, At, B1); PG8_BAR;
            PG8_LDA(At, 1, 1); PG8_STAGE(PG8_SA(1, 0), a3, voffA);
            PG8_BAR; PG8_WAIT_L(0); PG8_MMA(1, 0, At, B0); PG8_BAR; PG8_SCHED;
            PG8_STAGE(PG8_SB(1, 1), b3 + hstepB, voffB);
            PG8_WAIT_V(6); PG8_BAR; PG8_MMA(1, 1, At, B1); PG8_BAR;
        }
        E(acc, cur, wr, wc, fr, fq);
        if (!has_next) break;
#pragma unroll
        for (int a = 0; a < 2; ++a)
#pragma unroll
            for (int b = 0; b < 2; ++b)
#pragma unroll
                for (int m = 0; m < 4; ++m)
#pragma unroll
                    for (int n = 0; n < 2; ++n) acc[a][b][m][n] = (f32x4){0.f, 0.f, 0.f, 0.f};
        cur = nxt; cA = nA; cB = nB; ++ui;
    }
    PG8_WAIT_V(0);
    if (wr == 0) PG8_BAR;
    PG8_BAR;
#undef PG8_SA
#undef PG8_SB
#undef PG8_STAGE
#undef PG8_LDA
#undef PG8_LDB
#undef PG8_MMA
#undef PG8_WAIT_V
#undef PG8_WAIT_L
#undef PG8_BAR
#undef PG8_SCHED
}
}

struct EpiIn {
    static constexpr bool PERM = true;
    bf16_t* Z; const float* rcos; const float* rsin; const float* ssq; const float* cvec;
    __device__ __forceinline__ void operator()(const f32x4 (&acc)[2][2][4][2], const pg8::Unit& u, int wr, int wc, int fr, int fq) const {
        const int row0 = u.pm * 256 + wr * 64 + fr, col0 = u.pn * 256 + wc * 64 + 8 * fq;
        const bool rope = (u.pn >= 12) && (u.pn <= 16) && (u.pm < 128);
        const int modsel = u.pm < 64 ? 0 : (u.pm < 128 ? 1 : 2);
        f32x4 cv[2][2];
#pragma unroll
        for (int bj = 0; bj < 2; ++bj) { cv[bj][0] = (f32x4){0.f, 0.f, 0.f, 0.f}; cv[bj][1] = (f32x4){0.f, 0.f, 0.f, 0.f};
            if (ssq) { cv[bj][0] = *(const f32x4*)(cvec + modsel * ZN + col0 + bj * 32); cv[bj][1] = *(const f32x4*)(cvec + modsel * ZN + col0 + bj * 32 + 4); } }
#pragma unroll
        for (int ai = 0; ai < 2; ++ai)
#pragma unroll
            for (int m = 0; m < 4; ++m) {
                const int row = row0 + ai * 128 + m * 16;
                const float rs = ssq ? rsqrtf(ssq[row] * (1.f / DM) + 1e-6f) : 1.f;
#pragma unroll
                for (int bj = 0; bj < 2; ++bj) {
                    f32x4 cs = {1.f, 1.f, 1.f, 1.f}, sn = {0.f, 0.f, 0.f, 0.f};
                    if (rope) { const int tok = row & (LSEQ - 1); const int pos = ((wc & 1) == 0) ? (tok >> 6) : (tok & 63); const int f0 = 16 * bj + 4 * fq;
                        cs = *(const f32x4*)(rcos + pos * 32 + f0); sn = *(const f32x4*)(rsin + pos * 32 + f0); }
                    const int c = col0 + bj * 32;
                    if (c < ZLD) {
                        f32x4 v0 = acc[ai][bj][m][0] * rs + cv[bj][0], v1 = acc[ai][bj][m][1] * rs + cv[bj][1];
                        if (rope) { const f32x4 n0 = v0 * cs - v1 * sn, n1 = v1 * cs + v0 * sn; v0 = n0; v1 = n1; }
                        u32x4 w; w.x = cvt_pk_bf16(v0[0], v0[1]); w.y = cvt_pk_bf16(v0[2], v0[3]); w.z = cvt_pk_bf16(v1[0], v1[1]); w.w = cvt_pk_bf16(v1[2], v1[3]);
                        *(u32x4*)(Z + (size_t)row * ZLD + c) = w;
                    }
                }
            }
    }
};
struct EpiSq {
    static constexpr bool PERM = true;
    bf16_t* O; int ldc; const float* ssq; const float* cvec;
    __device__ __forceinline__ void operator()(const f32x4 (&acc)[2][2][4][2], const pg8::Unit& u, int wr, int wc, int fr, int fq) const {
        const int row0 = u.pm * 256 + wr * 64 + fr, col0 = u.pn * 256 + wc * 64 + 8 * fq;
        const int modsel = u.pm < 64 ? 0 : (u.pm < 128 ? 1 : 2);
        f32x4 cv[2][2];
#pragma unroll
        for (int bj = 0; bj < 2; ++bj) { cv[bj][0] = *(const f32x4*)(cvec + modsel * DFF + col0 + bj * 32); cv[bj][1] = *(const f32x4*)(cvec + modsel * DFF + col0 + bj * 32 + 4); }
#pragma unroll
        for (int ai = 0; ai < 2; ++ai)
#pragma unroll
            for (int m = 0; m < 4; ++m) { const int row = row0 + ai * 128 + m * 16; bf16_t* rowp = O + (size_t)row * ldc + col0;
                const float rs = rsqrtf(ssq[row] * (1.f / DM) + 1e-6f);
#pragma unroll
                for (int bj = 0; bj < 2; ++bj) { f32x4 v0 = acc[ai][bj][m][0] * rs + cv[bj][0], v1 = acc[ai][bj][m][1] * rs + cv[bj][1];
#pragma unroll
                    for (int j = 0; j < 4; ++j) { float a = fmaxf(v0[j], 0.f), b = fmaxf(v1[j], 0.f); v0[j] = a * a; v1[j] = b * b; }
                    u32x4 w; w.x = cvt_pk_bf16(v0[0], v0[1]); w.y = cvt_pk_bf16(v0[2], v0[3]); w.z = cvt_pk_bf16(v1[0], v1[1]); w.w = cvt_pk_bf16(v1[2], v1[3]);
                    *(u32x4*)(rowp + bj * 32) = w; } }
    }
};
struct EpiRes {
    static constexpr bool PERM = true;
    const float* lat_res; const float* ctx_res; float* lat_out; float* ctx_out; const float* gate;
    float* part; int ntfull;
    bf16_t* aout; const float* ng; const float* nsc; float* ssq;
    __device__ __forceinline__ void operator()(const f32x4 (&acc)[2][2][4][2], const pg8::Unit& u, int wr, int wc, int fr, int fq) const {
        const int row0 = u.pm * 256 + wr * 64 + fr, col0 = u.pn * 256 + wc * 64 + 8 * fq;
        if (u.nt != ntfull) {
            float* pp = part + (size_t)(u.k0 / (u.nt * 64)) * NCTX * DM;
#pragma unroll
            for (int ai = 0; ai < 2; ++ai)
#pragma unroll
                for (int m = 0; m < 4; ++m) { float* op = pp + (size_t)(row0 + ai * 128 + m * 16 - NLAT) * DM;
#pragma unroll
                    for (int bj = 0; bj < 2; ++bj)
#pragma unroll
                        for (int n = 0; n < 2; ++n) *(f32x4*)(op + col0 + bj * 32 + n * 4) = acc[ai][bj][m][n]; }
            return;
        }
        const int modsel = u.pm < 64 ? 0 : (u.pm < 128 ? 1 : 2);
        f32x4 gv[2][2];
#pragma unroll
        for (int bj = 0; bj < 2; ++bj)
#pragma unroll
            for (int n = 0; n < 2; ++n) gv[bj][n] = *(const f32x4*)(gate + modsel * 12288 + col0 + bj * 32 + n * 4);
        f32x4 gm[2][2];
        if (aout) {
#pragma unroll
            for (int bj = 0; bj < 2; ++bj)
#pragma unroll
                for (int n = 0; n < 2; ++n) { const int c = col0 + bj * 32 + n * 4; gm[bj][n] = *(const f32x4*)(ng + c) * (*(const f32x4*)(nsc + modsel * 12288 + c) + 1.f); }
        }
#pragma unroll
        for (int ai = 0; ai < 2; ++ai)
#pragma unroll
            for (int m = 0; m < 4; ++m) {
                const int row = row0 + ai * 128 + m * 16;
                const float* rp; float* op;
                if (row < NLAT) { rp = lat_res + (size_t)row * DM; op = lat_out + (size_t)row * DM; } else { rp = ctx_res + (size_t)(row - NLAT) * DM; op = ctx_out + (size_t)(row - NLAT) * DM; }
                float ss = 0.f;
#pragma unroll
                for (int bj = 0; bj < 2; ++bj) { const int c = col0 + bj * 32;
                    const f32x4 o0 = *(const f32x4*)(rp + c) + gv[bj][0] * acc[ai][bj][m][0], o1 = *(const f32x4*)(rp + c + 4) + gv[bj][1] * acc[ai][bj][m][1];
                    *(f32x4*)(op + c) = o0; *(f32x4*)(op + c + 4) = o1;
                    if (aout) { ss += o0[0] * o0[0] + o0[1] * o0[1] + o0[2] * o0[2] + o0[3] * o0[3] + o1[0] * o1[0] + o1[1] * o1[1] + o1[2] * o1[2] + o1[3] * o1[3];
                        const f32x4 a0 = o0 * gm[bj][0], a1 = o1 * gm[bj][1];
                        u32x4 w; w.x = cvt_pk_bf16(a0[0], a0[1]); w.y = cvt_pk_bf16(a0[2], a0[3]); w.z = cvt_pk_bf16(a1[0], a1[1]); w.w = cvt_pk_bf16(a1[2], a1[3]);
                        *(u32x4*)(aout + (size_t)row * DM + c) = w; } }
                if (aout) { ss += __shfl_xor(ss, 16); ss += __shfl_xor(ss, 32); if (fq == 0) atomicAdd(ssq + row, ss); }
                __builtin_amdgcn_sched_barrier(0);
            }
    }
};

struct EpiAny {
    unsigned char* ws; float* out; const float* rlat; const float* rctx; const float* ng;
    int mode, l, ssq_idx, gate_idx, aout_sel, nsc_off, ntfull; bool perm;
    __device__ __forceinline__ void operator()(const f32x4 (&acc)[2][2][4][2], const pg8::Unit& u, int wr, int wc, int fr, int fq) const {
        const float* rope = (const float*)(ws + WS_ROPE); const float* CV = (const float*)(ws + WS_CVEC) + (size_t)l * CV_L;
        float* SSQ = (float*)(ws + WS_SSQ); const float* MODA = (const float*)(ws + WS_MOD);
        if (mode == 0) { const EpiIn e{(bf16_t*)(ws + WS_H), rope, rope + 8192, ssq_idx >= 0 ? SSQ + (size_t)ssq_idx * NTOK : nullptr, CV}; e(acc, u, wr, wc, fr, fq); }
        else if (mode == 1) { const EpiSq e{(bf16_t*)(ws + WS_H), DFF, SSQ + (size_t)ssq_idx * NTOK, CV + 3 * ZN}; e(acc, u, wr, wc, fr, fq); }
        else { const EpiRes e{rlat, rctx, out, (float*)(ws + WS_XC), MODA + (size_t)l * 3 * 12288 + gate_idx * DM, (float*)(ws + WS_ABUF2), ntfull,
                              aout_sel == 0 ? nullptr : (bf16_t*)(ws + (aout_sel == 1 ? WS_ABUF : WS_ABUF2)), ng, MODA + nsc_off, SSQ + (size_t)ssq_idx * NTOK}; e(acc, u, wr, wc, fr, fq); }
    }
};

__device__ __forceinline__ void map_col_in(int n, int& src, float& scale) {
    if (n < 3072) { src = n; scale = (n < 512) ? QSCALE : ((n >= 1536 && n < 1792) ? 0.125f : 1.f); }
    else if (n < 4352) { const bool isq = n < 4096; const int base = isq ? 3072 : 4096, sbase = isq ? 3104 : 4128; const int hh = (n - base) >> 7, pp = (n - base) & 127;
        const int i = 4 * (pp >> 3) + (pp & 3), half = (pp >> 2) & 1; const int od = (i < 32 ? i : i + 32) + 32 * half; src = sbase + hh * 128 + od; scale = isq ? QSCALE : 1.f; }
    else if (n < 4608) { src = 4384 + (n - 4352); scale = 1.f; }
    else if (n < 4640) { src = 3072 + (n - 4608); scale = 1.f; }
    else { src = -1; scale = 0.f; }
}
__device__ void conv_tile(int tid_, int bid_, const float* __restrict__ w, int Nsrc, int K, bf16_t* __restrict__ Bt, int n0, int k0, int mode, LAS float* tile) {
    const int t = tid_;
    { const int n = t & 127, kq = t >> 7; int src = n0 + n; float scale = 1.f; if (mode) map_col_in(n0 + n, src, scale);
        float v[32];
#pragma unroll
        for (int i = 0; i < 32; ++i) v[i] = (src >= 0) ? w[(size_t)(k0 + kq + 4 * i) * Nsrc + src] : 0.f;
#pragma unroll
        for (int i = 0; i < 32; ++i) tile[(kq + 4 * i) * 129 + n] = v[i] * scale; }
    __syncthreads();
    { const int n2 = t >> 2, kc = t & 3;
#pragma unroll
        for (int u = 0; u < 4; ++u) { float v[8];
#pragma unroll
            for (int j = 0; j < 8; ++j) v[j] = tile[(32 * kc + 8 * u + j) * 129 + n2];
            u32x4 pk; pk.x = cvt_pk_bf16(v[0], v[1]); pk.y = cvt_pk_bf16(v[2], v[3]); pk.z = cvt_pk_bf16(v[4], v[5]); pk.w = cvt_pk_bf16(v[6], v[7]);
            *(u32x4*)(Bt + (size_t)(n0 + n2) * K + k0 + 32 * kc + 8 * u) = pk; } }
    __syncthreads();
}
__device__ void phase0(int tid_, int bid_, const P& p, LAS unsigned char* lds) {
    LAS float* tile = (LAS float*)lds;
    LAS float* act = (LAS float*)(lds + 66560);
    LAS float* red = (LAS float*)(lds + 66560 + 24576);
    const int t = tid_;
    for (int i = t; i < 3 * 2048; i += 512) { const int v = i >> 11, k = i & 2047; const float xv = v < 2 ? p.c[v * 2048 + k] : p.c_ctx[k]; act[i] = xv / (1.f + __expf(-xv)); }
    { const int idx = bid_ * 512 + t; if (idx < 8192) { const int pos = idx >> 5, f = idx & 31; const double inv = pow(10000.0, -(double)f / 32.0); const double a = (double)pos * inv;
            float* rc = (float*)(p.ws + WS_ROPE); rc[idx] = (float)cos(a); rc[8192 + idx] = (float)sin(a); } }
    { float* sq = (float*)(p.ws + WS_SSQ); for (int i = bid_ * 512 + t; i < 3 * NTOK; i += gridDim.x * 512) sq[i] = 0.f; }
    __syncthreads();
    const int NGEMV = 768, NCONV = 2912;
    for (int it = bid_; it < NGEMV + 2 * NCONV; it += gridDim.x) {
        if (it < NGEMV) {
            const int l = it / 384, c0 = (it % 384) * 32; const int cq = t & 7, kg = t >> 3;
            float a0[4] = {0, 0, 0, 0}, a1[4] = {0, 0, 0, 0}, a2[4] = {0, 0, 0, 0};
            const float* wp = p.w_mod + (size_t)l * 2048 * 12288 + c0 + 4 * cq;
#pragma unroll 8
            for (int kk = 0; kk < 32; ++kk) { const int k = kg * 32 + kk; const f32x4 w4 = *(const f32x4*)(wp + (size_t)k * 12288); const float x0 = act[k], x1 = act[2048 + k], x2 = act[4096 + k];
#pragma unroll
                for (int j = 0; j < 4; ++j) { a0[j] += x0 * w4[j]; a1[j] += x1 * w4[j]; a2[j] += x2 * w4[j]; } }
#pragma unroll
            for (int j = 0; j < 4; ++j) { red[(kg * 3 + 0) * 32 + 4 * cq + j] = a0[j]; red[(kg * 3 + 1) * 32 + 4 * cq + j] = a1[j]; red[(kg * 3 + 2) * 32 + 4 * cq + j] = a2[j]; }
            __syncthreads();
            if (t < 96) { const int v = t >> 5, cc = t & 31; float s = 0.f; for (int g = 0; g < 64; ++g) s += red[(g * 3 + v) * 32 + cc];
                ((float*)(p.ws + WS_MOD))[(size_t)(l * 3 + v) * 12288 + c0 + cc] = s + p.b_mod[l * 12288 + c0 + cc]; }
            __syncthreads();
        } else {
            int r = it - NGEMV; const int l = r / NCONV; r -= l * NCONV;
            bf16_t* wb = (bf16_t*)(p.ws + WS_W + (size_t)l * SZ_WL);
            if (r < 608) { conv_tile(tid_, bid_, p.w_in + (size_t)l * DM * ZLD, ZLD, DM, wb, (r / 16) * 128, (r % 16) * 128, 1, tile); }
            else if (r < 864) { r -= 608; conv_tile(tid_, bid_, p.w_out + (size_t)l * DM * DM, DM, DM, wb + (size_t)ZN * DM, (r / 16) * 128, (r % 16) * 128, 0, tile); }
            else if (r < 1888) { r -= 864; conv_tile(tid_, bid_, p.w_ff1 + (size_t)l * DM * DFF, DFF, DM, wb + (size_t)ZN * DM + (size_t)DM * DM, (r / 16) * 128, (r % 16) * 128, 0, tile); }
            else { r -= 1888; conv_tile(tid_, bid_, p.w_ff2 + (size_t)l * DFF * DM, DM, DFF, wb + (size_t)ZN * DM + (size_t)DM * DM + (size_t)DFF * DM, (r / 64) * 128, (r % 64) * 128, 0, tile); }
        }
    }
}

__device__ void phase_norm(int tid_, int bid_, const P& p, int l, int which, const float* lat_src, const float* ctx_src, int nrows) {
    const int lane = tid_ & 63, wid = tid_ >> 6;
    bf16_t* A = (bf16_t*)(p.ws + WS_ABUF);
    const float* g = (which == 1 ? p.n1g : p.n2g) + l * DM;
    const float* mod = (const float*)(p.ws + WS_MOD) + (size_t)l * 3 * 12288;
    for (int row = bid_ * 8 + wid; row < nrows; row += gridDim.x * 8) {
        const float* xr = row < NLAT ? lat_src + (size_t)row * DM : ctx_src + (size_t)(row - NLAT) * DM;
        f32x4 v[8]; float ss = 0.f;
#pragma unroll
        for (int i = 0; i < 8; ++i) { v[i] = ((const f32x4*)xr)[lane + 64 * i]; ss += v[i][0] * v[i][0] + v[i][1] * v[i][1] + v[i][2] * v[i][2] + v[i][3] * v[i][3]; }
        ss = wave_sum(ss);
        const float rstd = rsqrtf(ss * (1.f / DM) + 1e-6f);
        const int modsel = row < LSEQ ? 0 : (row < NLAT ? 1 : 2);
        const float* sh = mod + modsel * 12288 + (which == 1 ? 0 : 3) * DM; const float* sc = sh + DM;
#pragma unroll
        for (int i = 0; i < 8; ++i) { const int c = 4 * (lane + 64 * i); const f32x4 g4 = *(const f32x4*)(g + c), s4 = *(const f32x4*)(sh + c), c4 = *(const f32x4*)(sc + c);
            float o[4];
#pragma unroll
            for (int j = 0; j < 4; ++j) o[j] = v[i][j] * rstd * g4[j] * (1.f + c4[j]) + s4[j];
            uint2 w; w.x = cvt_pk_bf16(o[0], o[1]); w.y = cvt_pk_bf16(o[2], o[3]); *(uint2*)(A + (size_t)row * DM + c) = w; }
    }
}
__device__ void phase_cvec(int tid_, int bid_, const P& p, LAS unsigned char* lds) {
    const int lane = tid_ & 63, wid = tid_ >> 6;
    LAS float* shv = (LAS float*)lds;
    const float* MOD = (const float*)(p.ws + WS_MOD);
    for (int i = tid_; i < 9 * 2048; i += 512) { const int set = i / 6144, r = i - set * 6144, v = r >> 11, k = r & 2047; const int l = set == 0 ? 0 : 1, idx = set == 1 ? 0 : 3;
        shv[i] = MOD[(size_t)(l * 3 + v) * 12288 + idx * 2048 + k]; }
    __syncthreads();
    float* CV = (float*)(p.ws + WS_CVEC);
    const int NR = DFF + ZN + DFF;
    for (int rr = bid_ * 8 + wid; rr < NR; rr += gridDim.x * 8) {
        int set, n, l, ncols; const bf16_t* wrow; float* outp;
        const bf16_t* wb0 = (const bf16_t*)(p.ws + WS_W); const bf16_t* wb1 = (const bf16_t*)(p.ws + WS_W + SZ_WL);
        if (rr < DFF) { set = 0; n = rr; l = 0; wrow = wb0 + (size_t)ZN * DM + (size_t)DM * DM + (size_t)n * DM; outp = CV + 3 * ZN + n; ncols = DFF; }
        else if (rr < DFF + ZN) { set = 1; n = rr - DFF; l = 1; wrow = wb1 + (size_t)n * DM; outp = CV + CV_L + n; ncols = ZN; }
        else { set = 2; n = rr - DFF - ZN; l = 1; wrow = wb1 + (size_t)ZN * DM + (size_t)DM * DM + (size_t)n * DM; outp = CV + CV_L + 3 * ZN + n; ncols = DFF; }
        float a0 = 0.f, a1 = 0.f, a2 = 0.f;
#pragma unroll
        for (int i = 0; i < 4; ++i) { const int k0 = lane * 8 + 512 * i; const u32x4 w = *(const u32x4*)(wrow + k0);
            const float wf[8] = {bflo(w.x), bfhi(w.x), bflo(w.y), bfhi(w.y), bflo(w.z), bfhi(w.z), bflo(w.w), bfhi(w.w)};
            const LAS float* s0 = shv + set * 6144 + k0;
#pragma unroll
            for (int j = 0; j < 8; ++j) { a0 += wf[j] * s0[j]; a1 += wf[j] * s0[2048 + j]; a2 += wf[j] * s0[4096 + j]; } }
        a0 = wave_sum(a0); a1 = wave_sum(a1); a2 = wave_sum(a2);
        if (lane == 0) { outp[0] = a0; outp[ncols] = a1; outp[2 * ncols] = a2; }
    }
}
__device__ void phase_ctxfix(int tid_, int bid_, const P& p) {
    const int lane = tid_ & 63, wid = tid_ >> 6;
    float* XC = (float*)(p.ws + WS_XC); const float* PART = (const float*)(p.ws + WS_ABUF2); bf16_t* A = (bf16_t*)(p.ws + WS_ABUF); float* SSQ = (float*)(p.ws + WS_SSQ) + NTOK;
    const float* MOD = (const float*)(p.ws + WS_MOD);
    const float* ga2 = MOD + (size_t)2 * 12288 + 5 * DM;
    const float* sc1 = MOD + (size_t)(3 + 2) * 12288 + 1 * DM;
    const float* g1 = p.n1g + DM;
    for (int idx = bid_ * 8 + wid; idx < NCTX * 4; idx += gridDim.x * 8) {
        const int r = idx >> 2, c0 = (idx & 3) * 512 + lane * 8;
        f32x4 s0 = {0.f, 0.f, 0.f, 0.f}, s1 = {0.f, 0.f, 0.f, 0.f};
#pragma unroll
        for (int sl = 0; sl < 16; ++sl) { const float* pp = PART + ((size_t)sl * NCTX + r) * DM + c0; s0 += *(const f32x4*)pp; s1 += *(const f32x4*)(pp + 4); }
        float* xp = XC + (size_t)r * DM + c0;
        const f32x4 x0 = *(const f32x4*)xp + *(const f32x4*)(ga2 + c0) * s0, x1 = *(const f32x4*)(xp + 4) + *(const f32x4*)(ga2 + c0 + 4) * s1;
        *(f32x4*)xp = x0; *(f32x4*)(xp + 4) = x1;
        float ss = x0[0] * x0[0] + x0[1] * x0[1] + x0[2] * x0[2] + x0[3] * x0[3] + x1[0] * x1[0] + x1[1] * x1[1] + x1[2] * x1[2] + x1[3] * x1[3];
        const f32x4 a0 = x0 * (*(const f32x4*)(g1 + c0)) * (*(const f32x4*)(sc1 + c0) + 1.f), a1 = x1 * (*(const f32x4*)(g1 + c0 + 4)) * (*(const f32x4*)(sc1 + c0 + 4) + 1.f);
        u32x4 w; w.x = cvt_pk_bf16(a0[0], a0[1]); w.y = cvt_pk_bf16(a0[2], a0[3]); w.z = cvt_pk_bf16(a1[0], a1[1]); w.w = cvt_pk_bf16(a1[2], a1[3]);
        *(u32x4*)(A + (size_t)(NLAT + r) * DM + c0) = w;
        ss = wave_sum(ss); if (lane == 0) atomicAdd(SSQ + NLAT + r, ss);
    }
}
__device__ void phase_final(int tid_, int bid_, const P& p) {
    const int lane = tid_ & 63, wid = tid_ >> 6;
    for (int row = bid_ * 8 + wid; row < NLAT; row += gridDim.x * 8) {
        float* xr = p.out + (size_t)row * DM;
        f32x4 v[8]; float ss = 0.f;
#pragma unroll
        for (int i = 0; i < 8; ++i) { v[i] = ((const f32x4*)xr)[lane + 64 * i]; ss += v[i][0] * v[i][0] + v[i][1] * v[i][1] + v[i][2] * v[i][2] + v[i][3] * v[i][3]; }
        ss = wave_sum(ss);
        const float rstd = rsqrtf(ss * (1.f / DM) + 1e-6f);
#pragma unroll
        for (int i = 0; i < 8; ++i) { const int c = 4 * (lane + 64 * i); const f32x4 g4 = *(const f32x4*)(p.fng + c); ((f32x4*)xr)[lane + 64 * i] = v[i] * rstd * g4; }
    }
}

__device__ void attn_simple(int tid_, int bid_, const P& p, int l, bool with_ctx, LAS unsigned char* lds) {
    const int lane = tid_ & 63, wid = tid_ >> 6;
    const bf16_t* Z = (const bf16_t*)(p.ws + WS_H);
    bf16_t* Y = (bf16_t*)(p.ws + WS_ABUF);
    LAS float* sc = (LAS float*)lds + wid * 576;
    const int nq_lat = NLAT * 12; const int nq = nq_lat + (with_ctx ? NCTX * 12 : 0);
    const int gw = bid_ * 8 + wid, nw = gridDim.x * 8;
    for (int it = gw; it < nq; it += nw) {
        int tok, hs; bool isctx;
        if (it < nq_lat) { tok = it / 12; hs = it - tok * 12; isctx = false; } else { const int r = it - nq_lat; tok = NLAT + r / 12; hs = r % 12; isctx = true; }
        const int b = isctx ? ((tok - NLAT) >> 8) : (tok >> 14);
        const bool na = hs < 4;
        int qcol, kcol, vcol, ycol;
        if (na) { qcol = C_NAQ + hs * 128; kcol = C_NAK + hs * 128; vcol = C_NAV + hs * 128; ycol = hs * 128; }
        else { const int h = hs - 4; qcol = C_SQ + h * 128; kcol = C_SK + (h >> 2) * 128; vcol = C_SV + (h >> 2) * 128; ycol = 1024 + h * 128; }
        int nloc = 0, lo = 0, rs = 0, cs = 0, r = 0, cpos = 0;
        if (!isctx) { const int t = tok & (LSEQ - 1);
            if (na) { r = t >> 6; cpos = t & 63; rs = min(max(r - 4, 0), 248); cs = min(max(cpos - 8, 0), 48); nloc = 128; }
            else { lo = max(t - 128, 0); const int hi = min(t + 128, LSEQ - 1); nloc = hi - lo + 1; } }
        const int nk = nloc + 256; const int ctxbase = NLAT + b * 256, latbase = b * LSEQ;
        u32x4 q[16]; { const u32x4* qp = (const u32x4*)(Z + (size_t)tok * ZLD + qcol);
#pragma unroll
            for (int i = 0; i < 16; ++i) q[i] = qp[i]; }
        const float* rp = p.rpb + (size_t)l * 4 * 465 + (na ? hs : 0) * 465;
        float mx = -3.0e38f;
        for (int j = lane; j < nk; j += 64) {
            int kt; float bias = 0.f;
            if (j < nloc) { if (na) { const int kr = rs + (j >> 4), kc = cs + (j & 15); kt = latbase + kr * 64 + kc; bias = rp[(kr - r + 7) * 31 + (kc - cpos + 15)] * LOG2E; } else kt = latbase + lo + j; }
            else kt = ctxbase + (j - nloc);
            const u32x4* kp = (const u32x4*)(Z + (size_t)kt * ZLD + kcol);
            float s = 0.f;
#pragma unroll
            for (int i = 0; i < 16; ++i) s += dot8(q[i], kp[i]);
            s += bias; sc[j] = s; mx = fmaxf(mx, s);
        }
        mx = wave_max(mx);
        float snk = 0.f; if (!na) { snk = p.sink[l * 8 + (hs - 4)] * LOG2E; mx = fmaxf(mx, snk); }
        float sum = 0.f;
        for (int j = lane; j < nk; j += 64) { const float pj = exp2f(sc[j] - mx); sc[j] = pj; sum += pj; }
        sum = wave_sum(sum); if (!na) sum += exp2f(snk - mx);
        float o0 = 0.f, o1 = 0.f;
#pragma unroll 4
        for (int j = 0; j < nk; ++j) {
            int kt;
            if (j < nloc) { if (na) kt = latbase + (rs + (j >> 4)) * 64 + cs + (j & 15); else kt = latbase + lo + j; } else kt = ctxbase + (j - nloc);
            const float pj = sc[j]; const unsigned vv = *(const unsigned*)(Z + (size_t)kt * ZLD + vcol + 2 * lane);
            o0 += pj * bflo(vv); o1 += pj * bfhi(vv);
        }
        const float inv = 1.f / sum;
        *(unsigned*)(Y + (size_t)tok * DM + ycol + 2 * lane) = cvt_pk_bf16(o0 * inv, o1 * inv);
    }
}

__device__ __forceinline__ float grp_max4(float v) {
    unsigned a = __float_as_uint(v); auto r = __builtin_amdgcn_permlane16_swap(a, a, false, false); v = fmaxf(__uint_as_float(r[0]), __uint_as_float(r[1]));
    a = __float_as_uint(v); auto r2 = __builtin_amdgcn_permlane32_swap(a, a, false, false); return fmaxf(__uint_as_float(r2[0]), __uint_as_float(r2[1]));
}
__device__ __forceinline__ float grp_sum4(float v) {
    unsigned a = __float_as_uint(v); auto r = __builtin_amdgcn_permlane16_swap(a, a, false, false); v = __uint_as_float(r[0]) + __uint_as_float(r[1]);
    a = __float_as_uint(v); auto r2 = __builtin_amdgcn_permlane32_swap(a, a, false, false); return __uint_as_float(r2[0]) + __uint_as_float(r2[1]);
}
typedef short s16x4 __attribute__((ext_vector_type(4)));
__device__ __forceinline__ unsigned att_koff(int row, int ch) { return (unsigned)(row * 256 + ((ch ^ ((row & 3) | (((row >> 3) & 3) << 2))) << 4)); }
__device__ __forceinline__ unsigned att_voff(int row, int ch) { return (unsigned)(row * 256 + ((ch ^ (((row & 3) << 2) | ((row >> 2) & 3))) << 4)); }
constexpr float ATT_MASKED = -1.0e30f, ATT_MINIT = -5.0e29f;
__device__ void attn_mfma(int tid_, int bid_, const P& p, int l, bool with_ctx, LAS unsigned char* lds) {
    const int lane = tid_ & 63, wid = __builtin_amdgcn_readfirstlane(tid_ >> 6), l15 = lane & 15, lg = lane >> 4;
    const bf16_t* Z = (const bf16_t*)(p.ws + WS_H);
    bf16_t* Y = (bf16_t*)(p.ws + WS_ABUF);
    LAS float* rpbs = (LAS float*)(lds + 65536);
    const int n_swa = 1024, n_na = 512, n_ctx = with_ctx ? 24 : 0;
    unsigned kx[4];
#pragma unroll
    for (int kk = 0; kk < 4; ++kk) kx[kk] = (unsigned)((8 * (l15 >> 2) + (l15 & 3)) * 256 + (((4 * kk + lg) ^ l15) << 4));
    const int vq = l15 >> 2, vp = lane & 3;
    unsigned vrow[2], vx[2];
#pragma unroll
    for (int t = 0; t < 2; ++t) { vrow[t] = (unsigned)((8 * lg + 4 * t + vq) * 256 + 8 * (vp & 1)); vx[t] = (unsigned)((vq << 2) | ((2 * lg + t) & 3)); }
    int st_row[2], st_ch[2];
#pragma unroll
    for (int i = 0; i < 2; ++i) { const int idx = tid_ + 512 * i; st_row[i] = idx >> 4; st_ch[i] = idx & 15; }

    for (int item = bid_; item < n_swa + n_na + n_ctx; item += gridDim.x) {
        int type, b, kcol, vcol, nloc = 0, loc_tok0 = 0, loc_pos0 = 0, qtok0, qcol, ycol, qpos0 = 0, r_na = 0, rs_lo = 0, rsr = 0, hbias = 0;
        bool has_sink = false; float sinkv = 0.f;
        if (item < n_swa) {
            type = 0; b = item >> 9; const int g = (item >> 8) & 1, m = item & 255; const int h = 4 * g + (wid >> 1);
            qpos0 = 64 * m + 32 * (wid & 1); qtok0 = b * LSEQ + qpos0; qcol = C_SQ + h * 128; ycol = 1024 + h * 128; kcol = C_SK + g * 128; vcol = C_SV + g * 128;
            const int c_lo = max(0, 2 - m), c_hi = min(4, 257 - m); nloc = c_hi - c_lo + 1; loc_pos0 = 64 * (m - 2 + c_lo); loc_tok0 = b * LSEQ + loc_pos0;
            has_sink = true; sinkv = p.sink[l * 8 + h] * LOG2E;
        } else if (item < n_swa + n_na) {
            type = 1; const int it = item - n_swa; b = it >> 8; const int h = (it >> 6) & 3, R4 = it & 63; r_na = 4 * R4 + (wid >> 1); qpos0 = 32 * (wid & 1);
            qtok0 = b * LSEQ + r_na * 64 + qpos0; qcol = C_NAQ + h * 128; ycol = h * 128; kcol = C_NAK + h * 128; vcol = C_NAV + h * 128; hbias = h;
            rs_lo = min(max(4 * R4 - 4, 0), 248); const int rs_hi = min(max(4 * R4 - 1, 0), 248) + 7; nloc = rs_hi - rs_lo + 1; loc_tok0 = b * LSEQ + rs_lo * 64;
            rsr = min(max(r_na - 4, 0), 248);
        } else {
            type = 2; int it = item - n_swa - n_na;
            if (it < 8) { b = it >> 2; const int h = it & 3; qcol = C_NAQ + h * 128; ycol = h * 128; kcol = C_NAK + h * 128; vcol = C_NAV + h * 128; }
            else { it -= 8; b = it >> 3; const int h = it & 7; qcol = C_SQ + h * 128; ycol = 1024 + h * 128; kcol = C_SK + (h >> 2) * 128; vcol = C_SV + (h >> 2) * 128; has_sink = true; sinkv = p.sink[l * 8 + h] * LOG2E; }
            qtok0 = NLAT + b * 256 + 32 * wid;
        }
        const int nch = nloc + 4; const int ctx_tok0 = NLAT + b * 256;
        if (type == 1) { for (int i = tid_; i < 465; i += 512) rpbs[i] = p.rpb[(size_t)(l * 4 + hbias) * 465 + i] * LOG2E; }
        bf16x8 Qf[2][4];
#pragma unroll
        for (int qt = 0; qt < 2; ++qt)
#pragma unroll
            for (int kk = 0; kk < 4; ++kk) Qf[qt][kk] = *(const bf16x8*)(Z + (size_t)(qtok0 + 16 * qt + l15) * ZLD + qcol + 32 * kk + 8 * lg);
        f32x4 O[8][2];
#pragma unroll
        for (int dt = 0; dt < 8; ++dt) { O[dt][0] = (f32x4){0.f, 0.f, 0.f, 0.f}; O[dt][1] = (f32x4){0.f, 0.f, 0.f, 0.f}; }
        float mrun[2] = {ATT_MINIT, ATT_MINIT}, lsum[2] = {0.f, 0.f};
        u32x4 kr[2], vr[2];
#define ATT_LOAD(tokb) do { _Pragma("unroll") for (int i = 0; i < 2; ++i) { const bf16_t* src = Z + (size_t)((tokb) + st_row[i]) * ZLD + st_ch[i] * 8; kr[i] = *(const u32x4*)(src + kcol); vr[i] = *(const u32x4*)(src + vcol); } } while (0)
#define ATT_STORE(buf) do { _Pragma("unroll") for (int i = 0; i < 2; ++i) { *(LAS u32x4*)(lds + (buf) * 16384 + att_koff(st_row[i], st_ch[i])) = kr[i]; *(LAS u32x4*)(lds + 32768 + (buf) * 16384 + att_voff(st_row[i], st_ch[i])) = vr[i]; } } while (0)
#define ATT_TOK(c) ((c) < nloc ? loc_tok0 + 64 * (c) : ctx_tok0 + 64 * ((c) - nloc))
        ATT_LOAD(ATT_TOK(0)); ATT_STORE(0); __syncthreads();
        for (int c = 0; c < nch; ++c) {
            if (c + 1 < nch) ATT_LOAD(ATT_TOK(c + 1));
            const bool is_loc = c < nloc;
            LAS unsigned char* Kb = lds + (c & 1) * 16384; LAS unsigned char* Vb = lds + 32768 + (c & 1) * 16384;
#pragma unroll 1
            for (int blk = 0; blk < 2; ++blk) {
                bool rel = true; int kb = 0, kr_na = 0;
                if (is_loc) { if (type == 0) { kb = loc_pos0 + 64 * c + 32 * blk; rel = (kb + 31 >= qpos0 - 128) && (kb <= qpos0 + 159); } else { kr_na = rs_lo + c; rel = (kr_na >= rsr) && (kr_na <= rsr + 7); } }
                if (!rel) continue;
                f32x4 s[2][2];
#pragma unroll
                for (int kt = 0; kt < 2; ++kt) { s[kt][0] = (f32x4){0.f, 0.f, 0.f, 0.f}; s[kt][1] = (f32x4){0.f, 0.f, 0.f, 0.f}; }
#pragma unroll
                for (int kk = 0; kk < 4; ++kk)
#pragma unroll
                    for (int kt = 0; kt < 2; ++kt) { const bf16x8 kf = *(const LAS bf16x8*)(Kb + kx[kk] + (32 * blk + 4 * kt) * 256);
                        s[kt][0] = __builtin_amdgcn_mfma_f32_16x16x32_bf16(kf, Qf[0][kk], s[kt][0], 0, 0, 0); s[kt][1] = __builtin_amdgcn_mfma_f32_16x16x32_bf16(kf, Qf[1][kk], s[kt][1], 0, 0, 0); }
                if (is_loc) {
                    if (type == 0) { if (!((kb >= qpos0 - 97) && (kb <= qpos0 + 97))) { const int dq = kb + 8 * lg - qpos0 - l15;
#pragma unroll
                        for (int kt = 0; kt < 2; ++kt)
#pragma unroll
                            for (int qt = 0; qt < 2; ++qt)
#pragma unroll
                                for (int j = 0; j < 4; ++j) { const int d = dq + 4 * kt + j - 16 * qt; s[kt][qt][j] = (d <= 128 && d >= -128) ? s[kt][qt][j] : ATT_MASKED; } }
                    } else { const int rowoff = (kr_na - r_na + 7) * 31;
#pragma unroll
                        for (int qt = 0; qt < 2; ++qt) { const int qc = qpos0 + 16 * qt + l15; const int cs = min(max(qc - 8, 0), 48);
#pragma unroll
                            for (int kt = 0; kt < 2; ++kt)
#pragma unroll
                                for (int j = 0; j < 4; ++j) { const int kc = 32 * blk + 8 * lg + 4 * kt + j; const bool valid = (kc >= cs) && (kc < cs + 16);
                                    const int bi = min(max(kc - qc + 15, 0), 30); const float bias = rpbs[rowoff + bi]; s[kt][qt][j] = valid ? s[kt][qt][j] + bias : ATT_MASKED; } }
                    }
                }
                bf16x8 pk[2];
#pragma unroll
                for (int qt = 0; qt < 2; ++qt) {
                    float ml = fmaxf(fmaxf(fmaxf(s[0][qt][0], s[0][qt][1]), fmaxf(s[0][qt][2], s[0][qt][3])), fmaxf(fmaxf(s[1][qt][0], s[1][qt][1]), fmaxf(s[1][qt][2], s[1][qt][3])));
                    ml = grp_max4(ml);
                    const float mn = fmaxf(mrun[qt], ml); const float alpha = __builtin_amdgcn_exp2f(mrun[qt] - mn); mrun[qt] = mn;
                    float ps = 0.f; float pv[8];
#pragma unroll
                    for (int kt = 0; kt < 2; ++kt)
#pragma unroll
                        for (int j = 0; j < 4; ++j) { const float e = __builtin_amdgcn_exp2f(s[kt][qt][j] - mn); pv[4 * kt + j] = e; ps += e; }
                    lsum[qt] = lsum[qt] * alpha + ps;
                    if (__any(alpha != 1.f)) {
#pragma unroll
                        for (int dt = 0; dt < 8; ++dt) O[dt][qt] *= alpha; }
                    u32x4 w; w.x = cvt_pk_bf16(pv[0], pv[1]); w.y = cvt_pk_bf16(pv[2], pv[3]); w.z = cvt_pk_bf16(pv[4], pv[5]); w.w = cvt_pk_bf16(pv[6], pv[7]);
                    pk[qt] = __builtin_bit_cast(bf16x8, w);
                }
#pragma unroll
                for (int dt = 0; dt < 8; ++dt) {
                    const s16x4 v0 = __builtin_amdgcn_ds_read_tr16_b64_v4i16((LAS s16x4*)(Vb + vrow[0] + blk * 8192 + ((((unsigned)(2 * dt + (vp >> 1))) ^ vx[0]) << 4)));
                    const s16x4 v1 = __builtin_amdgcn_ds_read_tr16_b64_v4i16((LAS s16x4*)(Vb + vrow[1] + blk * 8192 + ((((unsigned)(2 * dt + (vp >> 1))) ^ vx[1]) << 4)));
                    const bf16x8 vf = {v0[0], v0[1], v0[2], v0[3], v1[0], v1[1], v1[2], v1[3]};
                    O[dt][0] = __builtin_amdgcn_mfma_f32_16x16x32_bf16(vf, pk[0], O[dt][0], 0, 0, 0); O[dt][1] = __builtin_amdgcn_mfma_f32_16x16x32_bf16(vf, pk[1], O[dt][1], 0, 0, 0);
                }
            }
            if (c + 1 < nch) ATT_STORE((c + 1) & 1);
            __syncthreads();
        }
#undef ATT_LOAD
#undef ATT_STORE
#undef ATT_TOK
#pragma unroll
        for (int qt = 0; qt < 2; ++qt) {
            float lt = grp_sum4(lsum[qt]);
            if (has_sink) lt += exp2f(fminf(sinkv - mrun[qt], 126.f));
            const float inv = 1.f / lt;
            LAS unsigned char* ob = lds + LDS_OUTB + wid * 8192 + (16 * qt + l15) * 256;
#pragma unroll
            for (int dt = 0; dt < 8; ++dt) { u32x2v w; w.x = cvt_pk_bf16(O[dt][qt][0] * inv, O[dt][qt][1] * inv); w.y = cvt_pk_bf16(O[dt][qt][2] * inv, O[dt][qt][3] * inv);
                *(LAS u32x2v*)(ob + ((((2 * dt + (lg >> 1)) ^ l15)) << 4) + 8 * (lg & 1)) = w; }
        }
        {
            const LAS unsigned char* ow = lds + LDS_OUTB + wid * 8192;
#pragma unroll
            for (int k = 0; k < 8; ++k) { const int row = 4 * k + lg, ch = l15; const u32x4 w = *(const LAS u32x4*)(ow + row * 256 + ((ch ^ (row & 15)) << 4));
                *(u32x4*)(Y + (size_t)(qtok0 + row) * DM + ycol + 8 * ch) = w; }
        }
    }
}

__device__ __forceinline__ int gla_tokbase(int b, int s) { return s < 4 ? NLAT + b * 256 + s * 64 : b * LSEQ + (s - 4) * 64; }
constexpr int GLD = 68;
__device__ void gla_gates(int tid_, int bid_, const P& p, int l, int h, int tokbase, LAS float* B, LAS float* gl, LAS float* tot) {
    const int t = tid_; const bf16_t* Z = (const bf16_t*)(p.ws + WS_H);
    for (int i = t; i < 64 * 32; i += 512) { const int j = i >> 5, r = i & 31; gl[i] = bf2f(Z[(size_t)(tokbase + j) * ZLD + C_GFL + r]); }
    __syncthreads();
    const int dir = t >> 8, seg = (t >> 6) & 3, k = t & 63;
    const float* wg = (dir ? p.wgb : p.wgf) + l * 16 * 256 + h * 64 + k; float w[16];
#pragma unroll
    for (int r = 0; r < 16; ++r) w[r] = wg[r * 256];
    const float bg = (dir ? p.bgb : p.bgf)[l * 256 + h * 64 + k];
    float run = 0.f;
    for (int jj = 0; jj < 16; ++jj) { const int j = dir ? (seg * 16 + 15 - jj) : (seg * 16 + jj); float u = bg;
#pragma unroll
        for (int r = 0; r < 16; ++r) u += gl[j * 32 + dir * 16 + r] * w[r];
        const float g = -(fmaxf(-u, 0.f) + log1pf(__expf(-fabsf(u)))) * (1.f / 16.f); run += g; B[(dir * 64 + j) * GLD + k] = run; }
    tot[(dir * 4 + seg) * 64 + k] = run;
    __syncthreads();
}
__device__ __forceinline__ float gla_off(LAS const float* tot, int dir, int j, int k) {
    const int seg = j >> 4; float o = 0.f;
    if (!dir) { for (int s = 0; s < 3; ++s) if (s < seg) o += tot[s * 64 + k]; } else { for (int s = 1; s < 4; ++s) if (s > seg) o += tot[(4 + s) * 64 + k]; }
    return o;
}
__device__ void gla_g1(int tid_, int bid_, const P& p, int l, LAS unsigned char* lds) {
    LAS float* B = (LAS float*)lds;
    LAS float* V = (LAS float*)(lds + 36864);
    LAS float* gl = (LAS float*)(lds + 36864 + 32768);
    LAS float* tot = (LAS float*)(lds + 36864 + 32768 + 8192);
    const bf16_t* Z = (const bf16_t*)(p.ws + WS_H); float* ST = (float*)(p.ws + WS_ST); float* DEC = (float*)(p.ws + WS_DEC);
    const int t = tid_;
    for (int item = bid_; item < 520 * 4; item += gridDim.x) {
        const int h = item & 3, cs = item >> 2, b = cs / 260, s = cs - b * 260; const int tb = gla_tokbase(b, s);
        gla_gates(tid_, bid_, p, l, h, tb, B, gl, tot);
        for (int i = t; i < 64 * 16; i += 512) { const int j = i >> 4, c8 = (i & 15) * 8; const u32x4 u = *(const u32x4*)(Z + (size_t)(tb + j) * ZLD + C_GV + h * 128 + c8);
            LAS float* d = V + j * 128 + c8; d[0] = bflo(u.x); d[1] = bfhi(u.x); d[2] = bflo(u.y); d[3] = bfhi(u.y); d[4] = bflo(u.z); d[5] = bfhi(u.z); d[6] = bflo(u.w); d[7] = bfhi(u.w); }
        for (int e = t; e < 2 * 4096; e += 512) { const int dir = e >> 12, j = (e >> 6) & 63, k = e & 63;
            const float total = tot[(dir * 4 + 0) * 64 + k] + tot[(dir * 4 + 1) * 64 + k] + tot[(dir * 4 + 2) * 64 + k] + tot[(dir * 4 + 3) * 64 + k];
            const float bb = B[(dir * 64 + j) * GLD + k] + gla_off(tot, dir, j, k);
            const float kv = bf2f(Z[(size_t)(tb + j) * ZLD + C_GK + h * 64 + k]);
            B[(dir * 64 + j) * GLD + k] = kv * __expf(total - bb);
            if (j == 0) DEC[(size_t)(((dir * 2 + b) * 260 + s) * 4 + h) * 64 + k] = __expf(total); }
        __syncthreads();
        { const int vq = t & 31, kk = t >> 5; float af[4][4], ab[4][4];
#pragma unroll
            for (int a = 0; a < 4; ++a)
#pragma unroll
                for (int c = 0; c < 4; ++c) { af[a][c] = 0.f; ab[a][c] = 0.f; }
            for (int j = 0; j < 64; ++j) { const f32x4 v4 = *(const LAS f32x4*)(V + j * 128 + 4 * vq); const f32x4 kf = *(const LAS f32x4*)(B + j * GLD + 4 * kk), kb = *(const LAS f32x4*)(B + (64 + j) * GLD + 4 * kk);
#pragma unroll
                for (int a = 0; a < 4; ++a)
#pragma unroll
                    for (int c = 0; c < 4; ++c) { af[a][c] += kf[a] * v4[c]; ab[a][c] += kb[a] * v4[c]; } }
            float* sf = ST + (size_t)(((0 * 2 + b) * 260 + s) * 4 + h) * 8192; float* sb = ST + (size_t)(((1 * 2 + b) * 260 + s) * 4 + h) * 8192;
#pragma unroll
            for (int a = 0; a < 4; ++a) { *(f32x4*)(sf + (4 * kk + a) * 128 + 4 * vq) = (f32x4){af[a][0], af[a][1], af[a][2], af[a][3]}; *(f32x4*)(sb + (4 * kk + a) * 128 + 4 * vq) = (f32x4){ab[a][0], ab[a][1], ab[a][2], ab[a][3]}; } }
        __syncthreads();
    }
}
__device__ void gla_scan(int tid_, int bid_, const P& p) {
    const float* ST = (const float*)(p.ws + WS_ST); const float* DEC = (const float*)(p.ws + WS_DEC); bf16_t* SB = (bf16_t*)(p.ws + WS_SBF);
    for (int e = bid_ * 512 + tid_; e < 131072; e += gridDim.x * 512) {
        const int dir = e >> 16, b = (e >> 15) & 1, h = (e >> 13) & 3, kv = e & 8191, k = kv >> 7;
        const size_t sboff = (att_voff(k, (kv & 127) >> 3) >> 1) + (kv & 7);
        float S = 0.f;
        for (int st0 = 0; st0 < 260; st0 += 10) {
            float kvv[10], dd[10]; size_t idx[10];
#pragma unroll
            for (int u = 0; u < 10; ++u) { const int step = st0 + u; const int s = step < 4 ? (dir ? 3 - step : step) : (dir ? 263 - step : step);
                idx[u] = (size_t)(((dir * 2 + b) * 260 + s) * 4 + h); kvv[u] = ST[idx[u] * 8192 + kv]; dd[u] = DEC[idx[u] * 64 + k]; }
#pragma unroll
            for (int u = 0; u < 10; ++u) { SB[idx[u] * 8192 + sboff] = (bf16_t)(cvt_pk_bf16(S, 0.f) & 0xffffu); S = dd[u] * S + kvv[u]; }
        }
    }
}
__device__ void gla_g3(int tid_, int bid_, const P& p, int l, bool with_ctx, LAS unsigned char* lds) {
    LAS float* B = (LAS float*)lds;
    LAS float* Q = (LAS float*)(lds + 34816);
    LAS float* V = (LAS float*)(lds + 69632);
    LAS float* A = (LAS float*)(lds + 102400);
    LAS float* gl = (LAS float*)(lds + 119040);
    LAS float* tot = (LAS float*)(lds + 127232);
    const bf16_t* Z = (const bf16_t*)(p.ws + WS_H); const float* ST = (const float*)(p.ws + WS_ST); bf16_t* Y = (bf16_t*)(p.ws + WS_ABUF);
    const int t = tid_;
    for (int item = bid_; item < 520 * 4; item += gridDim.x) {
        const int h = item & 3, cs = item >> 2, b = cs / 260, s = cs - b * 260; if (s < 4 && !with_ctx) continue;
        const int tb = gla_tokbase(b, s);
        gla_gates(tid_, bid_, p, l, h, tb, B, gl, tot);
        for (int i = t; i < 64 * 16; i += 512) { const int j = i >> 4, c8 = (i & 15) * 8; const u32x4 u = *(const u32x4*)(Z + (size_t)(tb + j) * ZLD + C_GV + h * 128 + c8);
            LAS float* d = V + j * 128 + c8; d[0] = bflo(u.x); d[1] = bfhi(u.x); d[2] = bflo(u.y); d[3] = bfhi(u.y); d[4] = bflo(u.z); d[5] = bfhi(u.z); d[6] = bflo(u.w); d[7] = bfhi(u.w); }
        for (int e = t; e < 2 * 4096; e += 512) { const int dir = e >> 12, j = (e >> 6) & 63, k = e & 63;
            const float bb = B[(dir * 64 + j) * GLD + k] + gla_off(tot, dir, j, k);
            const float qv = bf2f(Z[(size_t)(tb + j) * ZLD + C_GQ + h * 64 + k]), kv = bf2f(Z[(size_t)(tb + j) * ZLD + C_GK + h * 64 + k]);
            Q[(dir * 64 + j) * GLD + k] = qv * __expf(bb); B[(dir * 64 + j) * GLD + k] = kv * __expf(-bb); }
        __syncthreads();
        { const int i = t >> 3, jg = t & 7; float af[8], ab[8];
#pragma unroll
            for (int jj = 0; jj < 8; ++jj) { af[jj] = 0.f; ab[jj] = 0.f; }
            for (int k4 = 0; k4 < 16; ++k4) { const f32x4 qf = *(const LAS f32x4*)(Q + i * GLD + 4 * k4), qb = *(const LAS f32x4*)(Q + (64 + i) * GLD + 4 * k4);
#pragma unroll
                for (int jj = 0; jj < 8; ++jj) { const int j = jg + 8 * jj; const f32x4 kf = *(const LAS f32x4*)(B + j * GLD + 4 * k4), kb = *(const LAS f32x4*)(B + (64 + j) * GLD + 4 * k4);
                    af[jj] += qf[0] * kf[0] + qf[1] * kf[1] + qf[2] * kf[2] + qf[3] * kf[3]; ab[jj] += qb[0] * kb[0] + qb[1] * kb[1] + qb[2] * kb[2] + qb[3] * kb[3]; } }
#pragma unroll
            for (int jj = 0; jj < 8; ++jj) { const int j = jg + 8 * jj; A[i * 65 + j] = (j <= i ? af[jj] : 0.f) + (j >= i ? ab[jj] : 0.f); } }
        __syncthreads();
        { const int i = t >> 3, vg = t & 7; f32x4 o[4];
#pragma unroll
            for (int c = 0; c < 4; ++c) o[c] = (f32x4){0.f, 0.f, 0.f, 0.f};
            for (int j = 0; j < 64; ++j) { const float a = A[i * 65 + j];
#pragma unroll
                for (int c = 0; c < 4; ++c) o[c] += a * *(const LAS f32x4*)(V + j * 128 + vg * 16 + 4 * c); }
            const float* sf = ST + (size_t)(((0 * 2 + b) * 260 + s) * 4 + h) * 8192 + vg * 16; const float* sb = ST + (size_t)(((1 * 2 + b) * 260 + s) * 4 + h) * 8192 + vg * 16;
#pragma unroll 4
            for (int k = 0; k < 64; ++k) { const float qf = Q[i * GLD + k], qb = Q[(64 + i) * GLD + k];
#pragma unroll
                for (int c = 0; c < 4; ++c) o[c] += qf * *(const f32x4*)(sf + k * 128 + 4 * c) + qb * *(const f32x4*)(sb + k * 128 + 4 * c); }
            float ss = 0.f;
#pragma unroll
            for (int c = 0; c < 4; ++c) ss += o[c][0] * o[c][0] + o[c][1] * o[c][1] + o[c][2] * o[c][2] + o[c][3] * o[c][3];
            ss += __shfl_xor(ss, 1); ss += __shfl_xor(ss, 2); ss += __shfl_xor(ss, 4);
            const float rstd = rsqrtf(ss * (1.f / 128.f) + 1e-6f);
            const int tok = tb + i; const bf16_t* rp = Z + (size_t)tok * ZLD + C_GR + h * 128 + vg * 16; const float* gg = p.glag + l * 128 + vg * 16;
            const u32x4 r0 = *(const u32x4*)rp, r1 = *(const u32x4*)(rp + 8);
            float rr[16] = {bflo(r0.x), bfhi(r0.x), bflo(r0.y), bfhi(r0.y), bflo(r0.z), bfhi(r0.z), bflo(r0.w), bfhi(r0.w), bflo(r1.x), bfhi(r1.x), bflo(r1.y), bfhi(r1.y), bflo(r1.z), bfhi(r1.z), bflo(r1.w), bfhi(r1.w)};
            float res[16];
#pragma unroll
            for (int c = 0; c < 4; ++c)
#pragma unroll
                for (int jx = 0; jx < 4; ++jx) { const float r = rr[4 * c + jx]; res[4 * c + jx] = o[c][jx] * rstd * gg[4 * c + jx] * (r / (1.f + __expf(-r))); }
            u32x4 w0, w1; w0.x = cvt_pk_bf16(res[0], res[1]); w0.y = cvt_pk_bf16(res[2], res[3]); w0.z = cvt_pk_bf16(res[4], res[5]); w0.w = cvt_pk_bf16(res[6], res[7]);
            w1.x = cvt_pk_bf16(res[8], res[9]); w1.y = cvt_pk_bf16(res[10], res[11]); w1.z = cvt_pk_bf16(res[12], res[13]); w1.w = cvt_pk_bf16(res[14], res[15]);
            bf16_t* yp = Y + (size_t)tok * DM + 512 + h * 128 + vg * 16; *(u32x4*)yp = w0; *(u32x4*)(yp + 8) = w1; }
        __syncthreads();
    }
}

__device__ void gla_gates2(int tid_, const P& p, int l, int h, int tokbase, LAS float* B, LAS float* gl, LAS float* tot) {
    const int t = tid_; const bf16_t* Z = (const bf16_t*)(p.ws + WS_H);
    { const int j = t >> 3, c4 = (t & 7) * 4; const uint2 u = *(const uint2*)(Z + (size_t)(tokbase + j) * ZLD + C_GFL + c4);
        LAS float* d = gl + j * 32 + c4; d[0] = bflo(u.x); d[1] = bfhi(u.x); d[2] = bflo(u.y); d[3] = bfhi(u.y); }
    const int dir = t >> 8, seg = (t >> 6) & 3, k = t & 63;
    const float* wg = (dir ? p.wgb : p.wgf) + l * 16 * 256 + h * 64 + k; float w[16];
#pragma unroll
    for (int r = 0; r < 16; ++r) w[r] = wg[r * 256];
    const float bg = (dir ? p.bgb : p.bgf)[l * 256 + h * 64 + k];
    __syncthreads();
    float run = 0.f;
    for (int jj = 0; jj < 16; ++jj) { const int j = dir ? (seg * 16 + 15 - jj) : (seg * 16 + jj); float u = bg;
#pragma unroll
        for (int r4 = 0; r4 < 4; ++r4) { const f32x4 g4 = *(const LAS f32x4*)(gl + j * 32 + dir * 16 + 4 * r4); u += g4[0] * w[4 * r4] + g4[1] * w[4 * r4 + 1] + g4[2] * w[4 * r4 + 2] + g4[3] * w[4 * r4 + 3]; }
        const float g = -(fmaxf(-u, 0.f) + __logf(1.f + __expf(-fabsf(u)))) * (1.f / 16.f); run += g; B[(dir * 64 + j) * GLD + k] = run; }
    tot[(dir * 4 + seg) * 64 + k] = run;
    __syncthreads();
    float off = 0.f, total = 0.f;
#pragma unroll
    for (int s = 0; s < 4; ++s) { const float v = tot[(dir * 4 + s) * 64 + k]; total += v; if (dir ? (s > seg) : (s < seg)) off += v; }
    for (int jj = 0; jj < 16; ++jj) { const int j = seg * 16 + jj; B[(dir * 64 + j) * GLD + k] += off; }
    __syncthreads();
    if (seg == 0) tot[(dir * 4) * 64 + k] = total;
    __syncthreads();
}
__device__ __forceinline__ unsigned gl_off128tr(int row, int ch) { return (unsigned)(row * 128 + ((ch ^ (((((row >> 3) & 1) << 1) | ((row >> 1) & 1)) << 1)) << 4)); }
__device__ __forceinline__ unsigned gl_offQ(int row, int ch) { return (unsigned)(row * 128 + ((ch ^ ((row >> 1) & 7)) << 4)); }
__device__ __forceinline__ unsigned gl_offK(int row, int ch) { return (unsigned)(row * 128 + ((ch ^ (((row >> 1) & 1) | (((row >> 3) & 3) << 1))) << 4)); }
constexpr int GL_B = 0, GL_QT = 34816, GL_KT = 51200, GL_V = 67584, GL_S = 83968, GL_GL = 116736, GL_TOT = 124928, GL_SSQ = 126976;
__device__ void gla_g1m(int tid_, int bid_, const P& p, int l, LAS unsigned char* lds) {
    LAS float* B = (LAS float*)(lds + GL_B); LAS float* gl = (LAS float*)(lds + GL_GL); LAS float* tot = (LAS float*)(lds + GL_TOT);
    LAS unsigned char* KH = lds + GL_QT; LAS unsigned char* VB = lds + GL_V;
    const bf16_t* Z = (const bf16_t*)(p.ws + WS_H); float* ST = (float*)(p.ws + WS_ST); float* DEC = (float*)(p.ws + WS_DEC);
    const int t = tid_, lane = t & 63, wid = __builtin_amdgcn_readfirstlane(t >> 6), l15 = lane & 15, lg = lane >> 4, vq = l15 >> 2, vp = lane & 3;
    for (int item = bid_; item < 520 * 4; item += gridDim.x) {
        const int h = item & 3, cs = item >> 2, b = cs / 260, s = cs - b * 260; const int tb = gla_tokbase(b, s);
        u32x4 vreg[2], kreg, qreg;
#pragma unroll
        for (int i = 0; i < 2; ++i) { const int idx = t + 512 * i; vreg[i] = *(const u32x4*)(Z + (size_t)(tb + (idx >> 4)) * ZLD + C_GV + h * 128 + (idx & 15) * 8); }
        { const int j = (t >> 3) & 63, ch = t & 7; const bf16_t* zp = Z + (size_t)(tb + j) * ZLD + h * 64 + ch * 8; kreg = *(const u32x4*)(zp + C_GK); qreg = *(const u32x4*)(zp + C_GQ); }
        gla_gates2(t, p, l, h, tb, B, gl, tot);
        unsigned char* qki = p.ws + WS_QKI + (size_t)item * 32768;
#pragma unroll
        for (int i = 0; i < 2; ++i) { const int idx = t + 512 * i; *(LAS u32x4*)(VB + att_voff(idx >> 4, idx & 15)) = vreg[i];
            const int dir = i, j = (t >> 3) & 63, ch = t & 7;
            const LAS float* bp = B + (dir * 64 + j) * GLD + ch * 8; const LAS float* tp = tot + (dir * 4) * 64 + ch * 8;
            const f32x4 b0 = *(const LAS f32x4*)bp, b1 = *(const LAS f32x4*)(bp + 4), t0 = *(const LAS f32x4*)tp, t1 = *(const LAS f32x4*)(tp + 4);
            float e[8], ei[8], et[8];
#pragma unroll
            for (int x = 0; x < 4; ++x) { e[x] = __expf(b0[x]); e[4 + x] = __expf(b1[x]); ei[x] = __builtin_amdgcn_rcpf(e[x]); ei[4 + x] = __builtin_amdgcn_rcpf(e[4 + x]); et[x] = __expf(t0[x]) * ei[x]; et[4 + x] = __expf(t1[x]) * ei[4 + x]; }
            const float kf[8] = {bflo(kreg.x), bfhi(kreg.x), bflo(kreg.y), bfhi(kreg.y), bflo(kreg.z), bfhi(kreg.z), bflo(kreg.w), bfhi(kreg.w)};
            const float qf[8] = {bflo(qreg.x), bfhi(qreg.x), bflo(qreg.y), bfhi(qreg.y), bflo(qreg.z), bfhi(qreg.z), bflo(qreg.w), bfhi(qreg.w)};
            u32x4 w, wq, wk;
            w.x = cvt_pk_bf16(kf[0] * et[0], kf[1] * et[1]); w.y = cvt_pk_bf16(kf[2] * et[2], kf[3] * et[3]); w.z = cvt_pk_bf16(kf[4] * et[4], kf[5] * et[5]); w.w = cvt_pk_bf16(kf[6] * et[6], kf[7] * et[7]);
            wq.x = cvt_pk_bf16(qf[0] * e[0], qf[1] * e[1]); wq.y = cvt_pk_bf16(qf[2] * e[2], qf[3] * e[3]); wq.z = cvt_pk_bf16(qf[4] * e[4], qf[5] * e[5]); wq.w = cvt_pk_bf16(qf[6] * e[6], qf[7] * e[7]);
            wk.x = cvt_pk_bf16(kf[0] * ei[0], kf[1] * ei[1]); wk.y = cvt_pk_bf16(kf[2] * ei[2], kf[3] * ei[3]); wk.z = cvt_pk_bf16(kf[4] * ei[4], kf[5] * ei[5]); wk.w = cvt_pk_bf16(kf[6] * ei[6], kf[7] * ei[7]);
            *(LAS u32x4*)(KH + dir * 8192 + gl_off128tr(j, ch)) = w;
            *(u32x4*)(qki + dir * 8192 + gl_offQ(j, ch)) = wq; *(u32x4*)(qki + 16384 + dir * 8192 + gl_offK(j, ch)) = wk; }
        if (t < 128) { const int dir = t >> 6, k = t & 63; DEC[(size_t)(((dir * 2 + b) * 260 + s) * 4 + h) * 64 + k] = __expf(tot[(dir * 4) * 64 + k]); }
        __syncthreads();
        { const int dir = wid >> 2, kt = wid & 3; const int phi = ((lg & 1) << 1) | ((vq >> 1) & 1);
            bf16x8 af[2];
#pragma unroll
            for (int jj = 0; jj < 2; ++jj) { s16x4 a0, a1;
                a0 = __builtin_amdgcn_ds_read_tr16_b64_v4i16((LAS s16x4*)(KH + dir * 8192 + (32 * jj + 8 * lg + vq) * 128 + ((2 * (kt ^ phi) + (vp >> 1)) << 4) + 8 * (vp & 1)));
                a1 = __builtin_amdgcn_ds_read_tr16_b64_v4i16((LAS s16x4*)(KH + dir * 8192 + (32 * jj + 8 * lg + 4 + vq) * 128 + ((2 * (kt ^ phi) + (vp >> 1)) << 4) + 8 * (vp & 1)));
                af[jj] = (bf16x8){a0[0], a0[1], a0[2], a0[3], a1[0], a1[1], a1[2], a1[3]}; }
            float* sp = ST + (size_t)(((dir * 2 + b) * 260 + s) * 4 + h) * 8192 + (16 * kt + 4 * lg) * 128 + l15;
#pragma unroll
            for (int vt = 0; vt < 8; ++vt) { f32x4 acc = {0.f, 0.f, 0.f, 0.f};
#pragma unroll
                for (int jj = 0; jj < 2; ++jj) { s16x4 v0, v1; const int r0 = 32 * jj + 8 * lg + vq, r1 = r0 + 4;
                    v0 = __builtin_amdgcn_ds_read_tr16_b64_v4i16((LAS s16x4*)(VB + att_voff(r0, 2 * vt + (vp >> 1)) + 8 * (vp & 1)));
                    v1 = __builtin_amdgcn_ds_read_tr16_b64_v4i16((LAS s16x4*)(VB + att_voff(r1, 2 * vt + (vp >> 1)) + 8 * (vp & 1)));
                    const bf16x8 vf = {v0[0], v0[1], v0[2], v0[3], v1[0], v1[1], v1[2], v1[3]};
                    acc = __builtin_amdgcn_mfma_f32_16x16x32_bf16(af[jj], vf, acc, 0, 0, 0); }
#pragma unroll
                for (int j = 0; j < 4; ++j) sp[j * 128 + 16 * vt] = acc[j]; }
        }
        __syncthreads();
    }
}
__device__ void gla_g3m(int tid_, int bid_, const P& p, int l, bool with_ctx, LAS unsigned char* lds) {
    LAS float* B = (LAS float*)(lds + GL_B); LAS float* gl = (LAS float*)(lds + GL_GL); LAS float* tot = (LAS float*)(lds + GL_TOT); LAS float* ssq = (LAS float*)(lds + GL_SSQ);
    LAS unsigned char* QT = lds + GL_QT; LAS unsigned char* KT = lds + GL_KT; LAS unsigned char* VB = lds + GL_V; LAS unsigned char* SB = lds + GL_S;
    const bf16_t* Z = (const bf16_t*)(p.ws + WS_H); const float* ST = (const float*)(p.ws + WS_ST); bf16_t* Y = (bf16_t*)(p.ws + WS_ABUF);
    const int t = tid_, lane = t & 63, wid = __builtin_amdgcn_readfirstlane(t >> 6), l15 = lane & 15, lg = lane >> 4, vq = l15 >> 2, vp = lane & 3;
    const int it = wid >> 1, vh = wid & 1;
    for (int item = bid_; item < 520 * 4; item += gridDim.x) {
        const int h = item & 3, cs = item >> 2, b = cs / 260, s = cs - b * 260; if (s < 4 && !with_ctx) continue;
        const int tb = gla_tokbase(b, s);
        u32x4 vreg[2], qk[4], sreg[4];
        const unsigned char* qki = p.ws + WS_QKI + (size_t)item * 32768;
#pragma unroll
        for (int i = 0; i < 2; ++i) { const int idx = t + 512 * i; vreg[i] = *(const u32x4*)(Z + (size_t)(tb + (idx >> 4)) * ZLD + C_GV + h * 128 + (idx & 15) * 8); }
#pragma unroll
        for (int i = 0; i < 4; ++i) { const int idx = t + 512 * i; qk[i] = *(const u32x4*)(qki + (size_t)idx * 16);
            const int dir = idx >> 10; sreg[i] = *(const u32x4*)(p.ws + WS_SBF + (size_t)(((dir * 2 + b) * 260 + s) * 4 + h) * 16384 + (size_t)(idx & 1023) * 16); }
#pragma unroll
        for (int i = 0; i < 2; ++i) { const int idx = t + 512 * i; *(LAS u32x4*)(VB + att_voff(idx >> 4, idx & 15)) = vreg[i]; }
#pragma unroll
        for (int i = 0; i < 4; ++i) { const int idx = t + 512 * i; *(LAS u32x4*)(QT + idx * 16) = qk[i]; *(LAS u32x4*)(SB + idx * 16) = sreg[i]; }
        __syncthreads();
        f32x4 O[4];
        {
            bf16x8 Qf[2][2];
#pragma unroll
            for (int dir = 0; dir < 2; ++dir)
#pragma unroll
                for (int kk = 0; kk < 2; ++kk) Qf[dir][kk] = *(const LAS bf16x8*)(QT + dir * 8192 + gl_offQ(16 * it + l15, 4 * kk + lg));
#pragma unroll
            for (int vt = 0; vt < 4; ++vt) O[vt] = (f32x4){0.f, 0.f, 0.f, 0.f};
            const int qi = 16 * it + l15;
#pragma unroll
            for (int jb = 0; jb < 2; ++jb) {
                f32x4 a[2];
#pragma unroll
                for (int jt = 0; jt < 2; ++jt) { f32x4 af = {0.f, 0.f, 0.f, 0.f}, ab = {0.f, 0.f, 0.f, 0.f}; const int row = 32 * jb + 8 * (l15 >> 2) + 4 * jt + (l15 & 3);
#pragma unroll
                    for (int kk = 0; kk < 2; ++kk) { const bf16x8 kf = *(const LAS bf16x8*)(KT + gl_offK(row, 4 * kk + lg)), kb = *(const LAS bf16x8*)(KT + 8192 + gl_offK(row, 4 * kk + lg));
                        af = __builtin_amdgcn_mfma_f32_16x16x32_bf16(kf, Qf[0][kk], af, 0, 0, 0); ab = __builtin_amdgcn_mfma_f32_16x16x32_bf16(kb, Qf[1][kk], ab, 0, 0, 0); }
#pragma unroll
                    for (int jx = 0; jx < 4; ++jx) { const int j = 32 * jb + 8 * lg + 4 * jt + jx; a[jt][jx] = (j <= qi ? af[jx] : 0.f) + (j >= qi ? ab[jx] : 0.f); } }
                u32x4 w; w.x = cvt_pk_bf16(a[0][0], a[0][1]); w.y = cvt_pk_bf16(a[0][2], a[0][3]); w.z = cvt_pk_bf16(a[1][0], a[1][1]); w.w = cvt_pk_bf16(a[1][2], a[1][3]);
                const bf16x8 pk = __builtin_bit_cast(bf16x8, w);
#pragma unroll
                for (int vt = 0; vt < 4; ++vt) { const int r0 = 32 * jb + 8 * lg + vq, cch = 2 * (4 * vh + vt) + (vp >> 1);
                    const s16x4 v0 = __builtin_amdgcn_ds_read_tr16_b64_v4i16((LAS s16x4*)(VB + att_voff(r0, cch) + 8 * (vp & 1)));
                    const s16x4 v1 = __builtin_amdgcn_ds_read_tr16_b64_v4i16((LAS s16x4*)(VB + att_voff(r0 + 4, cch) + 8 * (vp & 1)));
                    const bf16x8 vf = {v0[0], v0[1], v0[2], v0[3], v1[0], v1[1], v1[2], v1[3]};
                    O[vt] = __builtin_amdgcn_mfma_f32_16x16x32_bf16(vf, pk, O[vt], 0, 0, 0); }
            }
#pragma unroll
            for (int dir = 0; dir < 2; ++dir)
#pragma unroll
                for (int kk = 0; kk < 2; ++kk)
#pragma unroll
                    for (int vt = 0; vt < 4; ++vt) { const int r0 = 32 * kk + 8 * lg + vq, cch = 2 * (4 * vh + vt) + (vp >> 1);
                        const s16x4 s0 = __builtin_amdgcn_ds_read_tr16_b64_v4i16((LAS s16x4*)(SB + dir * 16384 + att_voff(r0, cch) + 8 * (vp & 1)));
                        const s16x4 s1 = __builtin_amdgcn_ds_read_tr16_b64_v4i16((LAS s16x4*)(SB + dir * 16384 + att_voff(r0 + 4, cch) + 8 * (vp & 1)));
                        const bf16x8 sf = {s0[0], s0[1], s0[2], s0[3], s1[0], s1[1], s1[2], s1[3]};
                        O[vt] = __builtin_amdgcn_mfma_f32_16x16x32_bf16(sf, Qf[dir][kk], O[vt], 0, 0, 0); }
        }
        float ss = 0.f;
#pragma unroll
        for (int vt = 0; vt < 4; ++vt) ss += O[vt][0] * O[vt][0] + O[vt][1] * O[vt][1] + O[vt][2] * O[vt][2] + O[vt][3] * O[vt][3];
        ss += __shfl_xor(ss, 16); ss += __shfl_xor(ss, 32);
        if (lg == 0) ssq[wid * 16 + l15] = ss;
        __syncthreads();
        { const float tot2 = ssq[(2 * it) * 16 + l15] + ssq[(2 * it + 1) * 16 + l15]; const float rstd = rsqrtf(tot2 * (1.f / 128.f) + 1e-6f);
            const int tok = tb + 16 * it + l15;
#pragma unroll
            for (int vt = 0; vt < 4; ++vt) { const int v0 = 64 * vh + 16 * vt + 4 * lg; const uint2 ru = *(const uint2*)(Z + (size_t)tok * ZLD + C_GR + h * 128 + v0); const f32x4 g4 = *(const f32x4*)(p.glag + l * 128 + v0);
                const float r0 = bflo(ru.x), r1 = bfhi(ru.x), r2 = bflo(ru.y), r3 = bfhi(ru.y);
                const float o0 = O[vt][0] * rstd * g4[0] * (r0 / (1.f + __expf(-r0))), o1 = O[vt][1] * rstd * g4[1] * (r1 / (1.f + __expf(-r1)));
                const float o2 = O[vt][2] * rstd * g4[2] * (r2 / (1.f + __expf(-r2))), o3 = O[vt][3] * rstd * g4[3] * (r3 / (1.f + __expf(-r3)));
                uint2 w; w.x = cvt_pk_bf16(o0, o1); w.y = cvt_pk_bf16(o2, o3); *(uint2*)(Y + (size_t)tok * DM + 512 + h * 128 + v0) = w; } }
        __syncthreads();
    }
}

constexpr int N_PHASES = 18;
#ifndef REP_G
#define REP_G 1
#endif
#ifndef REP_A
#define REP_A 1
#endif
#ifndef REP_N
#define REP_N 1
#endif
__device__ __forceinline__ void run_phase(int tid_, int bid_, const P& p, int ph, LAS unsigned char* lds) {
    if (ph == N_PHASES - 1) { phase_final(tid_, bid_, p); return; }
    if (ph == 9) { phase_ctxfix(tid_, bid_, p); return; }
    const int l = ph < 9 ? 0 : 1;
    const int sp = l == 0 ? (ph <= 6 ? ph - 1 : ph) : (ph <= 14 ? ph - 9 : ph - 8);
    const bool with_ctx = (l == 0);
    float* XC = (float*)(p.ws + WS_XC);
    const float* lat_src = l == 0 ? p.x : p.out; const float* ctx_src = l == 0 ? p.ctx : XC;
    bf16_t* wb = (bf16_t*)(p.ws + WS_W + (size_t)l * SZ_WL);
    bf16_t* ABUF = (bf16_t*)(p.ws + WS_ABUF); bf16_t* ABUF2 = (bf16_t*)(p.ws + WS_ABUF2); bf16_t* HB = (bf16_t*)(p.ws + WS_H);
    const float* MODA = (const float*)(p.ws + WS_MOD);
    const float* mod = MODA + (size_t)l * 3 * 12288;
    float* SSQ = (float*)(p.ws + WS_SSQ); const float* CV = (const float*)(p.ws + WS_CVEC) + (size_t)l * CV_L;
    const int Mres = with_ctx ? NTOK : NLAT;
    if (sp == 0) {
#pragma unroll 1
        for (int rep = 0; rep < REP_N; ++rep) { phase_norm(tid_, bid_, p, l, 1, lat_src, ctx_src, NTOK); }
        phase_cvec(tid_, bid_, p, lds);
        return; }
    if (sp == 2) {
#pragma unroll 1
        for (int rep = 0; rep < REP_G; ++rep) { gla_g1m(tid_, bid_, p, l, lds); }
#pragma unroll 1
        for (int rep = 0; rep < REP_A; ++rep) { attn_mfma(tid_, bid_, p, l, with_ctx, lds); }
        return; }
    if (sp == 3) { gla_scan(tid_, bid_, p); return; }
    if (sp == 4) {
#pragma unroll 1
        for (int rep = 0; rep < REP_G; ++rep) { gla_g3m(tid_, bid_, p, l, with_ctx, lds); }
        return; }
    pg8::Gemm g; EpiAny E{};
    E.ws = p.ws; E.out = p.out; E.l = l; E.ssq_idx = -1;
    if (sp == 1) { g = pg8::Gemm{ABUF, wb, NTOK, ZN, DM}; E.mode = 0; E.perm = true; if (l == 1) E.ssq_idx = 1; }
    else if (sp == 5) { g = pg8::Gemm{ABUF, wb + (size_t)ZN * DM, Mres, DM, DM}; E.mode = 2; E.perm = true;
        E.rlat = lat_src; E.rctx = ctx_src; E.gate_idx = 2; E.ntfull = DM / 64; E.aout_sel = 2; E.ng = p.n2g + l * DM; E.nsc_off = l * 3 * 12288 + 4 * DM; E.ssq_idx = (l == 0 ? 0 : 2); }
    else if (sp == 7) { g = pg8::Gemm{ABUF2, wb + (size_t)ZN * DM + (size_t)DM * DM, Mres, DFF, DM}; E.mode = 1; E.perm = true; E.ssq_idx = (l == 0 ? 0 : 2); }
    else { g = pg8::Gemm{HB, wb + (size_t)ZN * DM + (size_t)DM * DM + (size_t)DFF * DM, NLAT, DM, DFF}; E.mode = 2; E.perm = true;
        E.rlat = p.out; E.rctx = XC; E.gate_idx = 5; E.ntfull = DFF / 64; E.aout_sel = (l == 0 ? 1 : 0); E.ng = p.n1g + DM; E.nsc_off = 3 * 12288 + 1 * DM; E.ssq_idx = 1; }
    pg8::StaticOrder S; S.init(g.M, g.N, g.K, gridDim.x, bid_);
    if (sp == 8 && l == 0) { S.nsplit = 256; S.ks = 16; S.nt_split = 8; S.pm_split0 = 128; }
    pg8::gemm_phase(tid_, lds, g, S, E);
}

#define XB_TMO      128
#define XB_XCNT(j)  (256  + 64 * (j))
#define XB_XSUB(j)  (1280 + 64 * (j))
#define XB_XGEN(j)  (2304 + 64 * (j))
#define XB_TOP      3328
#define XB_TOPGEN   3392
#define XCD_BAR_WORDS 3456
#define XB_SPIN_CAP (1u << 18)
__device__ __forceinline__ unsigned xb_ld(unsigned* p)              { return __hip_atomic_load(p, __ATOMIC_RELAXED, __HIP_MEMORY_SCOPE_AGENT); }
__device__ __forceinline__ unsigned xb_add(unsigned* p, unsigned v) { return __hip_atomic_fetch_add(p, v, __ATOMIC_RELAXED, __HIP_MEMORY_SCOPE_AGENT); }
__device__ __forceinline__ unsigned xb_xcc_id() { return (unsigned)__builtin_amdgcn_s_getreg((3 << 11) | 20) & 0xFu; }
#define XB_SPIN(cond, bar) do { unsigned _sp = 0; while (cond) { __builtin_amdgcn_s_sleep(1); \
    if ((++_sp & 255u) == 0u) { if (xb_ld(&(bar)[XB_TMO])) break; if (_sp > XB_SPIN_CAP) { atomicAdd(&(bar)[XB_TMO], 1u); break; } } } } while (0)
struct XcdBarrier { unsigned* bar; unsigned x; volatile LAS unsigned* st; };
__device__ __forceinline__ XcdBarrier xcd_barrier_post(unsigned* bar, volatile LAS unsigned* st) {
    XcdBarrier b; b.bar = bar; b.x = xb_xcc_id(); b.st = st;
    if (threadIdx.x == 0) (void)xb_add(&bar[XB_XCNT(b.x)], 1u);
    return b;
}
__device__ __forceinline__ void xcd_barrier_complete(unsigned* bar, unsigned x, unsigned& nloc, unsigned& nx) {
    const unsigned G = gridDim.x * gridDim.y * gridDim.z;
    unsigned sum, cnt, mine, sp = 0u;
    for (;;) {
        sum = 0u; cnt = 0u; mine = 0u;
#pragma unroll
        for (unsigned j = 0; j < 16; ++j) { const unsigned c = xb_ld(&bar[XB_XCNT(j)]); sum += c; cnt += (c > 0u) ? 1u : 0u; mine = (j == x) ? c : mine; }
        if (sum == G) break;
        __builtin_amdgcn_s_sleep(1);
        if ((++sp & 255u) == 0u) { if (xb_ld(&bar[XB_TMO])) break; if (sp > XB_SPIN_CAP) { atomicAdd(&bar[XB_TMO], 1u); break; } }
    }
    nloc = mine > 0u ? mine : 1u; nx = cnt > 0u ? cnt : 1u;
}
__device__ __forceinline__ void xcd_barrier(const XcdBarrier& b) {
    asm volatile("s_waitcnt vmcnt(0)" ::: "memory");
    __syncthreads();
    if (threadIdx.x == 0) {
        unsigned* bar = b.bar;
        __builtin_amdgcn_s_waitcnt(0);
        unsigned nloc = b.st[0], nx = b.st[1];
        if (nloc == 0u) { xcd_barrier_complete(bar, b.x, nloc, nx); b.st[0] = nloc; b.st[1] = nx; }
        const unsigned old = xb_add(&bar[XB_XSUB(b.x)], 1u);
        const unsigned gen = old / nloc;
        if (old + 1u == (gen + 1u) * nloc) {
            __builtin_amdgcn_fence(__ATOMIC_RELEASE, "agent");
            asm volatile("s_waitcnt vmcnt(0)" ::: "memory");
            const unsigned og = xb_add(&bar[XB_TOP], 1u);
            const unsigned tg = og / nx;
            if (og + 1u == (tg + 1u) * nx) xb_add(&bar[XB_TOPGEN], 1u);
            else XB_SPIN(xb_ld(&bar[XB_TOPGEN]) == tg, bar);
            __builtin_amdgcn_fence(__ATOMIC_ACQUIRE, "agent");
            xb_add(&bar[XB_XGEN(b.x)], 1u);
            asm volatile("s_waitcnt vmcnt(0)" ::: "memory");
        } else {
            XB_SPIN(xb_ld(&bar[XB_XGEN(b.x)]) == gen, bar);
            __builtin_amdgcn_fence(__ATOMIC_ACQUIRE, "agent");
            asm volatile("s_waitcnt vmcnt(0)" ::: "memory");
        }
    }
    __syncthreads();
}

__global__ void __launch_bounds__(512, 2) mk_fwd(P p) {
    extern __shared__ __attribute__((aligned(16))) unsigned char shm[];
    LAS unsigned char* lds = (LAS unsigned char*)shm;
    cg::grid_group grid = cg::this_grid();
    volatile LAS unsigned* xst = (volatile LAS unsigned*)(lds + LDS_XST);
    if (threadIdx.x == 0) { xst[0] = 0u; xst[1] = 0u; xst[2] = 0u; xst[3] = 0u; }
    __syncthreads();
    const XcdBarrier xb = xcd_barrier_post((unsigned*)(p.ws + WS_BAR), xst);
    int ph0 = (int)p.ph_lo;
    if (ph0 == 0) {
        int tid_ = threadIdx.x, bid_ = blockIdx.x;
        asm volatile("" : "+v"(tid_));
        asm volatile("" : "+s"(bid_));
        P q = p;
        { long zoff = 0; asm volatile("" : "+s"(zoff)); q.ws = p.ws + zoff; q.out = p.out + zoff; }
#pragma unroll 1
        for (int rep = 0; rep < REP_N; ++rep) { phase0(tid_, bid_, q, lds); __syncthreads(); }
        ph0 = 1;
        if (ph0 < (int)p.ph_hi) xcd_barrier(xb);
        if (p.ph_lo < 0) grid.sync();
    }
    for (int ph = ph0; ph < (int)p.ph_hi; ++ph) {
        int tid_ = threadIdx.x, bid_ = blockIdx.x;
        asm volatile("" : "+v"(tid_));
        asm volatile("" : "+s"(bid_));
        P q = p;
        { long zoff = 0; asm volatile("" : "+s"(zoff)); q.ws = p.ws + zoff; q.out = p.out + zoff; }
        run_phase(tid_, bid_, q, ph, lds);
        if (ph + 1 < (int)p.ph_hi) xcd_barrier(xb);
    }
}

#ifndef MK_MULTI
#define MK_MULTI 0
#endif
extern "C" void kernel_launch(void* const* d_in, const int* in_sizes, int n_in, void* d_out, int out_size, void* d_ws, size_t ws_size, hipStream_t stream) {
    static int grid = 0;
    if (grid == 0) {
        if (ws_size < WS_END) { fprintf(stderr, "kernel_launch: workspace too small: %zu < %zu\n", ws_size, (size_t)WS_END); grid = -1; return; }
        int dev = 0, cus = 0, per_cu = 0;
        hipGetDevice(&dev); hipDeviceGetAttribute(&cus, hipDeviceAttributeMultiprocessorCount, dev);
        if (hipFuncSetAttribute((const void*)mk_fwd, hipFuncAttributeMaxDynamicSharedMemorySize, LDS_BYTES) != hipSuccess) { fprintf(stderr, "kernel_launch: hipFuncSetAttribute failed\n"); grid = -1; return; }
        if (hipOccupancyMaxActiveBlocksPerMultiprocessor(&per_cu, (const void*)mk_fwd, 512, LDS_BYTES) != hipSuccess || per_cu < 1) { fprintf(stderr, "kernel_launch: occupancy query gave %d\n", per_cu); per_cu = 1; }
        (void)hipGetLastError();
        grid = cus * 1;
    }
    if (grid < 0) return;
    P p{};
    const float** pp = (const float**)&p;
    for (int i = 0; i < 20; ++i) pp[i] = (const float*)d_in[i];
    p.out = (float*)d_out; p.ws = (unsigned char*)d_ws;
#if MK_MULTI
    for (int ph = 0; ph < N_PHASES; ++ph) { p.ph_lo = ph; p.ph_hi = ph + 1; hipLaunchKernelGGL(mk_fwd, dim3(grid), dim3(512), LDS_BYTES, stream, p); }
#else
    p.ph_lo = 0; p.ph_hi = N_PHASES;
    if (hipMemsetAsync((char*)d_ws + WS_BAR, 0, 16384, stream) != hipSuccess) { fprintf(stderr, "kernel_launch: hipMemsetAsync failed\n"); return; }
    void* args[] = {&p};
    hipError_t e = hipLaunchCooperativeKernel((const void*)mk_fwd, dim3(grid), dim3(512), args, LDS_BYTES, stream);
    if (e != hipSuccess) fprintf(stderr, "cooperative launch failed: %s (grid %d)\n", hipGetErrorString(e), grid);
#endif
}
```
